# Optimizing an MI355X kernel written in HIP

```python
import jax, jax.numpy as jnp
from jax import lax
import numpy as np

D_MODEL = 1024
BATCH = 4
SEQ = 8192
DEPTH = 1

ATT_HEADS = 8
ATT_HEAD_DIM = 64
IDX_HEADS = 4
IDX_DIM = 64
IDX_TOPK_MAX = 256
Q_BLOCK = 128
ROPE_THETA = 10000.0
MLSTM_HEADS = 8
MLSTM_QK_DIM = 64
MLSTM_V_DIM = 128
MLSTM_CHUNK = 128
CONV_WIDTH = 4
N_GROUPS = 4
EXPERTS_PER_GROUP = 4
N_EXPERTS = N_GROUPS * EXPERTS_PER_GROUP
TOP_K_IN_GROUP = 2
EXPERT_DIM = 512
DEEPNORM_ALPHA = (2.0 * DEPTH) ** 0.25
DEEPNORM_BETA = (8.0 * DEPTH) ** -0.25
LN_EPS = 1e-5
GN_EPS = 1e-6

ATT_W = ATT_HEADS * ATT_HEAD_DIM
MLSTM_QK_W = MLSTM_HEADS * MLSTM_QK_DIM
MLSTM_V_W = MLSTM_HEADS * MLSTM_V_DIM
IN_SPLITS = (ATT_W, ATT_W, ATT_W, IDX_HEADS * IDX_DIM, IDX_DIM, IDX_HEADS,
             MLSTM_QK_W, MLSTM_QK_W, MLSTM_V_W, MLSTM_HEADS, MLSTM_HEADS, MLSTM_V_W,
             D_MODEL, D_MODEL)
IN_WIDTH = sum(IN_SPLITS)

kernel_name = 'hybrid_dsa_mlstm_hmoe_block'


def _layer_norm(x, gain, bias):
    xf = x.astype(jnp.float32)
    mu = xf.mean(-1, keepdims=True)
    var = jnp.square(xf - mu).mean(-1, keepdims=True)
    return (xf - mu) * lax.rsqrt(var + LN_EPS) * gain + bias


def _rope_tables(seq, dim):
    inv = ROPE_THETA ** (-jnp.arange(0, dim, 2, dtype=jnp.float32) / dim)
    ang = jnp.arange(seq, dtype=jnp.float32)[:, None] * inv[None, :]
    return jnp.cos(ang), jnp.sin(ang)


def _rope(x, cos, sin):
    x1, x2 = jnp.split(x, 2, axis=-1)
    c = cos[None, :, None, :]
    s = sin[None, :, None, :]
    return jnp.concatenate([x1 * c - x2 * s, x1 * s + x2 * c], axis=-1)


def _dsa_sparse_attention(q, k, v, q_idx, k_idx, w_idx):
    B, S, H, Dh = q.shape
    topk = min(IDX_TOPK_MAX, S // 4)
    nb = S // Q_BLOCK
    f32 = jnp.float32

    def to_blocks(a):
        return jnp.moveaxis(a.reshape((B, nb, Q_BLOCK) + a.shape[2:]), 1, 0)

    k_idx_f = k_idx.astype(f32)
    b_ix = jnp.arange(B)[:, None, None]
    key_pos = jnp.arange(S)

    def block_fn(args):
        qb, qib, wb, start = args
        t = start + jnp.arange(Q_BLOCK)
        rel = jax.nn.relu(jnp.einsum('bqhd,bsd->bqhs', qib.astype(f32), k_idx_f))
        score = jnp.einsum('bqhs,bqh->bqs', rel, wb.astype(f32))
        causal = key_pos[None, :] <= t[:, None]
        score = jnp.where(causal[None], score, -jnp.inf)
        _, sel = lax.top_k(score, topk)
        valid = sel <= t[None, :, None]
        k_sel = k[b_ix, sel]
        v_sel = v[b_ix, sel]
        logits = jnp.einsum('bqhd,bqkhd->bqhk', qb, k_sel).astype(f32) * (Dh ** -0.5)
        logits = jnp.where(valid[:, :, None, :], logits, -jnp.inf)
        p = jax.nn.softmax(logits, axis=-1).astype(v.dtype)
        return jnp.einsum('bqhk,bqkhd->bqhd', p, v_sel)

    starts = jnp.arange(nb, dtype=jnp.int32) * Q_BLOCK
    out = lax.map(block_fn, (to_blocks(q), to_blocks(q_idx), to_blocks(w_idx), starts))
    return jnp.moveaxis(out, 0, 1).reshape(B, S, H * Dh)


def _causal_depthwise_conv(x, w):
    C = x.shape[-1]
    return lax.conv_general_dilated(x, w[:, None, :].astype(x.dtype), window_strides=(1,),
                                    padding=[(CONV_WIDTH - 1, 0)],
                                    dimension_numbers=('NWC', 'WIO', 'NWC'),
                                    feature_group_count=C)


def _mlstm_chunkwise(q, k, v, i_pre, f_pre):
    B, S, H, Dk = q.shape
    Dv = v.shape[-1]
    L = MLSTM_CHUNK
    nc = S // L
    f32 = jnp.float32

    def chunks(a):
        a = a.astype(f32).reshape((B, nc, L, H) + a.shape[3:])
        return jnp.moveaxis(jnp.moveaxis(a, 1, 0), 3, 2)

    qc = chunks(q.astype(f32) * (Dk ** -0.5))
    kc = chunks(k)
    vc = chunks(v)
    ic = chunks(i_pre)
    lfc = chunks(jax.nn.log_sigmoid(f_pre.astype(f32)))
    causal = jnp.tril(jnp.ones((L, L), dtype=bool))

    def step(carry, xs):
        C, n, m = carry
        qb, kb, vb, ib, lfb = xs
        b = jnp.cumsum(lfb, axis=-1)
        dmat = jnp.where(causal, b[..., :, None] - b[..., None, :] + ib[..., None, :], -jnp.inf)
        inter = b + m[..., None]
        m_t = jnp.maximum(inter, dmat.max(-1))
        decay_in = jnp.exp(dmat - m_t[..., None])
        w_inter = jnp.exp(inter - m_t)
        s = jnp.einsum('bhjd,bhsd->bhjs', qb, kb) * decay_in
        num = (jnp.einsum('bhjs,bhsv->bhjv', s, vb)
               + w_inter[..., None] * jnp.einsum('bhjd,bhdv->bhjv', qb, C))
        den = s.sum(-1) + w_inter * jnp.einsum('bhjd,bhd->bhj', qb, n)
        h = num / jnp.maximum(jnp.abs(den), jnp.exp(-m_t))[..., None]
        b_last = b[..., -1]
        g = b_last[..., None] - b + ib
        m_new = jnp.maximum(b_last + m, g.max(-1))
        carry_decay = jnp.exp(b_last + m - m_new)
        wk = jnp.exp(g - m_new[..., None])[..., None] * kb
        C_new = carry_decay[..., None, None] * C + jnp.einsum('bhsd,bhsv->bhdv', wk, vb)
        n_new = carry_decay[..., None] * n + wk.sum(-2)
        return (C_new, n_new, m_new), h

    init = (jnp.zeros((B, H, Dk, Dv), f32), jnp.zeros((B, H, Dk), f32), jnp.zeros((B, H), f32))
    _, h = lax.scan(step, init, (qc, kc, vc, ic, lfc))
    return jnp.transpose(h, (1, 0, 3, 2, 4)).reshape(B, S, H, Dv)


def _hierarchical_moe(x, w_router_group, b_router_group, w_router_expert, b_router_expert,
                      w_exp_gate, w_exp_up, w_exp_down):
    B, S, D = x.shape
    f32 = jnp.float32
    t = x.reshape(B * S, D)
    g_logits = (t @ w_router_group + b_router_group).astype(f32)
    g_prob = jax.nn.softmax(g_logits, axis=-1)
    g_w, g_sel = lax.top_k(g_prob, 1)
    e_logits = (t @ w_router_expert + b_router_expert).astype(f32)
    e_logits = e_logits.reshape(-1, N_GROUPS, EXPERTS_PER_GROUP)
    e_logits = jnp.take_along_axis(e_logits, g_sel[:, :, None], axis=1)[:, 0]
    e_val, e_idx = lax.top_k(e_logits, TOP_K_IN_GROUP)
    e_w = jax.nn.softmax(e_val, axis=-1) * g_w
    expert_id = g_sel * EXPERTS_PER_GROUP + e_idx
    combine = jnp.einsum('tk,tke->te', e_w, jax.nn.one_hot(expert_id, N_EXPERTS, dtype=f32))
    out = jnp.zeros((B * S, D), f32)
    for e in range(N_EXPERTS):
        hdn = jax.nn.silu(t @ w_exp_gate[e]) * (t @ w_exp_up[e])
        out = out + combine[:, e:e + 1] * (hdn @ w_exp_down[e])
    return out.reshape(B, S, D)


def setup_inputs(seed: int = 0) -> dict:
    key = jax.random.key(seed)
    ks = jax.random.split(key, 20)
    f32 = jnp.float32

    def dense(k, shape, fan_in, scale=1.0):
        return jax.random.normal(k, shape, f32) * (scale * fan_in ** -0.5)

    x = jax.random.normal(ks[0], (BATCH, SEQ, D_MODEL), f32)
    w_in = dense(ks[1], (D_MODEL, IN_WIDTH), D_MODEL)
    f_off = sum(IN_SPLITS[:10])
    b_in = 0.02 * jax.random.normal(ks[2], (IN_WIDTH,), f32)
    b_in = b_in.at[f_off:f_off + MLSTM_HEADS].add(jnp.linspace(3.0, 6.0, MLSTM_HEADS, dtype=f32))
    conv_m = dense(ks[3], (CONV_WIDTH, 2 * MLSTM_QK_W), CONV_WIDTH)
    gn_m_gain = 1.0 + 0.02 * jax.random.normal(ks[4], (MLSTM_V_W,), f32)
    w_branch_attn = dense(ks[5], (ATT_W, D_MODEL), ATT_W)
    w_branch_mlstm = dense(ks[6], (MLSTM_V_W, D_MODEL), MLSTM_V_W)
    w_out = dense(ks[7], (D_MODEL, D_MODEL), D_MODEL, DEEPNORM_BETA)
    ln1_gain = 1.0 + 0.02 * jax.random.normal(ks[8], (D_MODEL,), f32)
    ln1_bias = 0.02 * jax.random.normal(ks[9], (D_MODEL,), f32)
    w_router_group = dense(ks[10], (D_MODEL, N_GROUPS), D_MODEL)
    b_router_group = 0.01 * jax.random.normal(ks[11], (N_GROUPS,), f32)
    w_router_expert = dense(ks[12], (D_MODEL, N_EXPERTS), D_MODEL)
    b_router_expert = 0.01 * jax.random.normal(ks[13], (N_EXPERTS,), f32)
    w_exp_gate = dense(ks[14], (N_EXPERTS, D_MODEL, EXPERT_DIM), D_MODEL)
    w_exp_up = dense(ks[15], (N_EXPERTS, D_MODEL, EXPERT_DIM), D_MODEL)
    w_exp_down = dense(ks[16], (N_EXPERTS, EXPERT_DIM, D_MODEL), EXPERT_DIM, DEEPNORM_BETA)
    ln2_gain = 1.0 + 0.02 * jax.random.normal(ks[17], (D_MODEL,), f32)
    ln2_bias = 0.02 * jax.random.normal(ks[18], (D_MODEL,), f32)
    return {'x': x, 'w_in': w_in, 'b_in': b_in, 'conv_m': conv_m, 'gn_m_gain': gn_m_gain,
            'w_branch_attn': w_branch_attn, 'w_branch_mlstm': w_branch_mlstm, 'w_out': w_out,
            'ln1_gain': ln1_gain, 'ln1_bias': ln1_bias,
            'w_router_group': w_router_group, 'b_router_group': b_router_group,
            'w_router_expert': w_router_expert, 'b_router_expert': b_router_expert,
            'w_exp_gate': w_exp_gate, 'w_exp_up': w_exp_up, 'w_exp_down': w_exp_down,
            'ln2_gain': ln2_gain, 'ln2_bias': ln2_bias}


def reference(x, w_in, b_in, conv_m, gn_m_gain, w_branch_attn, w_branch_mlstm, w_out,
              ln1_gain, ln1_bias, w_router_group, b_router_group, w_router_expert,
              b_router_expert, w_exp_gate, w_exp_up, w_exp_down, ln2_gain, ln2_bias):
    B, S, _ = x.shape
    splits = np.cumsum(IN_SPLITS)[:-1].tolist()
    for _layer in range(DEPTH):
        proj = jnp.einsum('bsd,de->bse', x, w_in) + b_in
        (a_q, a_k, a_v, i_q, i_k, i_w, m_q, m_k, m_v, m_i, m_f, m_o,
         g_attn, g_mlstm) = jnp.split(proj, splits, axis=-1)

        cos_a, sin_a = _rope_tables(S, ATT_HEAD_DIM)
        cos_i, sin_i = _rope_tables(S, IDX_DIM)
        q = _rope(a_q.reshape(B, S, ATT_HEADS, ATT_HEAD_DIM), cos_a, sin_a)
        k = _rope(a_k.reshape(B, S, ATT_HEADS, ATT_HEAD_DIM), cos_a, sin_a)
        v = a_v.reshape(B, S, ATT_HEADS, ATT_HEAD_DIM)
        qi = _rope(i_q.reshape(B, S, IDX_HEADS, IDX_DIM), cos_i, sin_i)
        ki = _rope(i_k.reshape(B, S, 1, IDX_DIM), cos_i, sin_i)[:, :, 0]
        wi = i_w * (IDX_HEADS ** -0.5 * IDX_DIM ** -0.5)
        y_attn = _dsa_sparse_attention(q, k, v, qi, ki, wi)

        qk_m = jax.nn.silu(_causal_depthwise_conv(jnp.concatenate([m_q, m_k], axis=-1), conv_m))
        mq, mk = jnp.split(qk_m, 2, axis=-1)
        h = _mlstm_chunkwise(mq.reshape(B, S, MLSTM_HEADS, MLSTM_QK_DIM),
                             mk.reshape(B, S, MLSTM_HEADS, MLSTM_QK_DIM),
                             m_v.reshape(B, S, MLSTM_HEADS, MLSTM_V_DIM), m_i, m_f)
        mu = h.mean(-1, keepdims=True)
        var = jnp.square(h - mu).mean(-1, keepdims=True)
        h = ((h - mu) * lax.rsqrt(var + GN_EPS)).reshape(B, S, MLSTM_V_W) * gn_m_gain
        y_mlstm = jax.nn.sigmoid(m_o) * h

        merged = (jax.nn.sigmoid(g_attn) * (y_attn @ w_branch_attn)
                  + jax.nn.sigmoid(g_mlstm) * (y_mlstm @ w_branch_mlstm))
        x = _layer_norm(DEEPNORM_ALPHA * x + merged @ w_out, ln1_gain, ln1_bias)

        moe = _hierarchical_moe(x, w_router_group, b_router_group, w_router_expert,
                                b_router_expert, w_exp_gate, w_exp_up, w_exp_down)
        x = _layer_norm(DEEPNORM_ALPHA * x + moe, ln2_gain, ln2_bias)
    return x
```

```cpp
#include <hip/hip_runtime.h>
#include <cstdio>
#include <cstdint>
#include <cmath>
namespace pg8 {
#define PG8_LAS __attribute__((address_space(3)))
typedef unsigned short bf16_t;
typedef short bf16x8 __attribute__((ext_vector_type(8)));
typedef float f32x4 __attribute__((ext_vector_type(4)));
typedef unsigned u32x4 __attribute__((ext_vector_type(4)));
constexpr int BM = 256, BK = 64, HALF = 128, HTB = HALF * BK * 2  , STAGE_BYTES = 8 * HTB, NXCD = 8, WGM = 8;

__host__ __device__ __forceinline__ int lds_byte(int r, int c) { const int st = (r >> 4) * 2 + (c >> 5), rr = r & 15, cc = c & 31, ob = rr * 64 + cc * 2; return st * 1024 + (ob ^ (((ob >> 9) & 1) << 5)); }
__host__ __device__ __forceinline__ void stage_rc(int b, int& R, int& C) { const int st = b / 1024, sb = b % 1024, swz = sb ^ (((sb >> 9) & 1) << 5); R = (st >> 1) * 16 + swz / 64; C = (st & 1) * 32 + (swz % 64) / 2; }
__host__ __device__ __forceinline__ int perm32(int rho) { const int n = rho >> 4, i = rho & 15; return 8 * (i >> 2) + 4 * n + (i & 3); }

struct Unit { int pm, pn; };
struct Gemm { const bf16_t* A; const bf16_t* Bt; int M, N, K; };

struct StaticOrder {
    int nM, nN, nwg, G, c;
    __host__ __device__ void init(int M, int N, int G_, int c_) { nM = M / BM; nN = N / BM; nwg = nM * nN; G = G_; c = c_; }
    __host__ __device__ bool next(int i, Unit& u) const {
        const long L = (long)i * G + c; if (L >= nwg) return false;
        int wgid = (int)L; { const int q = nwg / NXCD, r = nwg % NXCD, xcd = wgid % NXCD, off = wgid / NXCD; wgid = (xcd < r ? xcd * (q + 1) : r * (q + 1) + (xcd - r) * q) + off; }
        const int nig = WGM * nN, gid = wgid / nig, fm = gid * WGM, gsz = (nM - fm) < WGM ? (nM - fm) : WGM;
        u.pm = fm + ((wgid % nig) % gsz); u.pn = (wgid % nig) / gsz; return true;
    }
    __device__ __forceinline__ void a_ready(const Unit&) const {}
    __device__ __forceinline__ void done(const Unit&) const {}
};

__device__ __forceinline__ unsigned cvt_pk_bf16(float lo, float hi) { unsigned r; asm volatile("v_cvt_pk_bf16_f32 %0, %1, %2" : "=v"(r) : "v"(lo), "v"(hi)); return r; }
typedef float f32x2 __attribute__((ext_vector_type(2)));
template <class Epi, class Sched, bool ALIGN_EPI = false, bool SP2 = false>
__device__ __forceinline__ void gemm_phase(PG8_LAS unsigned char* lds, const Gemm g, const Sched& S, const Epi& E) {
    const int tid = threadIdx.x, wid = __builtin_amdgcn_readfirstlane(tid >> 6), lane = tid & 63, wr = wid >> 2, wc = wid & 3, fr = lane & 15, fq = lane >> 4;
    const int K = g.K, nt = K / BK;
    unsigned voffA[2], voffB[2];
#pragma unroll
    for (int i = 0; i < 2; ++i) { int R, C; stage_rc(tid * 16 + i * 8192, R, C); const int Rb = Epi::PERM ? ((R & ~31) + perm32(R & 31)) : R;
        voffA[i] = (unsigned)(R * K + C) * 2u; voffB[i] = (unsigned)(Rb * K + C) * 2u; }
    const size_t kstep = (size_t)(BK * 2);
    const size_t hstep = (size_t)HALF * K * 2;
    const size_t tstep = 2 * hstep;
    const unsigned ldsw = (unsigned)wid * 1024u;
    const int aoff = lds_byte(wr * 64 + fr, fq * 8), boff = lds_byte(wc * 32 + fr, fq * 8);
#define PG8_SA(b, h) (((b) * 2 + (h)) * HTB)
#define PG8_SB(b, h) ((4 + (b) * 2 + (h)) * HTB)
#define PG8_STAGE(bufoff, gbase, voff) do { _Pragma("unroll") for (int _i = 0; _i < 2; ++_i) \
        __builtin_amdgcn_global_load_lds((const unsigned*)((const char*)(gbase) + (voff)[_i]), (PG8_LAS unsigned*)(lds + (bufoff) + ldsw + _i * 8192), 16, 0, 0); } while (0)
#define PG8_LDA(dst, b, h) do { _Pragma("unroll") for (int m = 0; m < 4; ++m) _Pragma("unroll") for (int k = 0; k < 2; ++k) dst[m][k] = *(const PG8_LAS bf16x8*)(lds + PG8_SA(b, h) + aoff + m * 2048 + k * 1024); } while (0)
#define PG8_LDB(dst, b, h) do { _Pragma("unroll") for (int n = 0; n < 2; ++n) _Pragma("unroll") for (int k = 0; k < 2; ++k) dst[n][k] = *(const PG8_LAS bf16x8*)(lds + PG8_SB(b, h) + boff + n * 2048 + k * 1024); } while (0)
#define PG8_MMA(ai, bj, At, Bt) do { __builtin_amdgcn_s_setprio(1); _Pragma("unroll") for (int m = 0; m < 4; ++m) _Pragma("unroll") for (int n = 0; n < 2; ++n) _Pragma("unroll") for (int k = 0; k < 2; ++k) \
        acc[ai][bj][m][n] = __builtin_amdgcn_mfma_f32_16x16x32_bf16(Bt[n][k], At[m][k], acc[ai][bj][m][n], 0, 0, 0); __builtin_amdgcn_s_setprio(0); } while (0)
#define PG8_WAIT_V(n) asm volatile("s_waitcnt vmcnt(" #n ")" ::: "memory")
#define PG8_WAIT_L(n) asm volatile("s_waitcnt lgkmcnt(" #n ")" ::: "memory")
#define PG8_BAR __builtin_amdgcn_s_barrier()
#define PG8_SCHED __builtin_amdgcn_sched_barrier(0)
    Unit cur, nxt; int ui = 0;
    if (!S.next(0, cur)) return;
    f32x4 acc[2][2][4][2];
#pragma unroll
    for (int a = 0; a < 2; ++a)
#pragma unroll
        for (int b = 0; b < 2; ++b)
#pragma unroll
            for (int m = 0; m < 4; ++m)
#pragma unroll
                for (int n = 0; n < 2; ++n) acc[a][b][m][n] = (f32x4){0.f, 0.f, 0.f, 0.f};
    bf16x8 At[4][2], B0[2][2], B1[2][2];
    const char* cA = (const char*)g.A + (size_t)cur.pm * tstep; const char* cB = (const char*)g.Bt + (size_t)cur.pn * tstep;
    S.a_ready(cur);
    if constexpr (SP2) {
        PG8_STAGE(PG8_SB(0, 0), cB, voffB); PG8_STAGE(PG8_SB(0, 1), cB + hstep, voffB); PG8_STAGE(PG8_SA(0, 0), cA, voffA); PG8_STAGE(PG8_SA(0, 1), cA + hstep, voffA);
        if (wr == 1) PG8_BAR;
        PG8_WAIT_V(2); PG8_BAR;
        PG8_STAGE(PG8_SB(1, 0), cB + kstep, voffB); PG8_STAGE(PG8_SA(1, 0), cA + kstep, voffA); PG8_STAGE(PG8_SB(1, 1), cB + hstep + kstep, voffB);
        PG8_WAIT_V(6); PG8_BAR;
    } else {
        PG8_STAGE(PG8_SB(0, 0), cB, voffB); PG8_STAGE(PG8_SA(0, 0), cA, voffA); PG8_STAGE(PG8_SB(0, 1), cB + hstep, voffB); PG8_STAGE(PG8_SA(0, 1), cA + hstep, voffA);
        if (wr == 1) PG8_BAR;
        PG8_WAIT_V(4); PG8_BAR;
        PG8_STAGE(PG8_SB(1, 0), cB + kstep, voffB); PG8_STAGE(PG8_SA(1, 0), cA + kstep, voffA); PG8_STAGE(PG8_SB(1, 1), cB + hstep + kstep, voffB);
        PG8_WAIT_V(6); PG8_BAR;
    }
    for (;;) {
        const bool has_next = S.next(ui + 1, nxt);
        const char* nA = has_next ? (const char*)g.A + (size_t)nxt.pm * tstep : cA; const char* nB = has_next ? (const char*)g.Bt + (size_t)nxt.pn * tstep : cB;
        for (int t = 0; t < nt; t += 2) {
            const bool last = (t == nt - 2);
            const char* a1 = cA + (size_t)(t + 1) * kstep;
            const char* a2 = last ? nA : cA + (size_t)(t + 2) * kstep; const char* b2 = last ? nB : cB + (size_t)(t + 2) * kstep;
            const char* a3 = a2 + kstep; const char* b3 = b2 + kstep;
            if (last && has_next) S.a_ready(nxt);
            if constexpr (SP2) {
            PG8_LDB(B0, 0, 0); PG8_LDB(B1, 0, 1); PG8_SCHED; PG8_LDA(At, 0, 0); PG8_STAGE(PG8_SA(1, 1), a1 + hstep, voffA);
            PG8_WAIT_V(8); PG8_WAIT_L(0); PG8_BAR; PG8_MMA(0, 0, At, B0); PG8_MMA(0, 1, At, B1); PG8_BAR; PG8_SCHED;
            PG8_LDA(At, 0, 1); PG8_STAGE(PG8_SB(0, 0), b2, voffB); PG8_STAGE(PG8_SB(0, 1), b2 + hstep, voffB); PG8_STAGE(PG8_SA(0, 0), a2, voffA);
            PG8_WAIT_V(8); PG8_WAIT_L(0); PG8_BAR; PG8_MMA(1, 0, At, B0); PG8_MMA(1, 1, At, B1); PG8_BAR; PG8_SCHED;
            PG8_LDB(B0, 1, 0); PG8_LDB(B1, 1, 1); PG8_SCHED; PG8_LDA(At, 1, 0); PG8_STAGE(PG8_SA(0, 1), a2 + hstep, voffA);
            PG8_WAIT_V(8); PG8_WAIT_L(0); PG8_BAR; PG8_MMA(0, 0, At, B0); PG8_MMA(0, 1, At, B1); PG8_BAR; PG8_SCHED;
            PG8_LDA(At, 1, 1); PG8_STAGE(PG8_SB(1, 0), b3, voffB); PG8_STAGE(PG8_SB(1, 1), b3 + hstep, voffB); PG8_STAGE(PG8_SA(1, 0), a3, voffA);
            PG8_WAIT_V(8); PG8_WAIT_L(0); PG8_BAR; PG8_MMA(1, 0, At, B0); PG8_MMA(1, 1, At, B1); PG8_BAR; PG8_SCHED;
            } else {
            PG8_LDB(B0, 0, 0); PG8_SCHED; PG8_LDA(At, 0, 0); PG8_STAGE(PG8_SA(1, 1), a1 + hstep, voffA);
            PG8_WAIT_L(8); PG8_BAR; PG8_WAIT_L(0); PG8_MMA(0, 0, At, B0); PG8_BAR; PG8_SCHED;
            PG8_LDB(B1, 0, 1); PG8_STAGE(PG8_SB(0, 0), b2, voffB);
            PG8_BAR; PG8_WAIT_L(0); PG8_MMA(0, 1, At, B1); PG8_BAR;
            PG8_LDA(At, 0, 1); PG8_STAGE(PG8_SA(0, 0), a2, voffA);
            PG8_BAR; PG8_WAIT_L(0); PG8_MMA(1, 0, At, B0); PG8_BAR; PG8_SCHED;
            PG8_STAGE(PG8_SB(0, 1), b2 + hstep, voffB);
            PG8_WAIT_V(6); PG8_BAR; PG8_MMA(1, 1, At, B1); PG8_BAR;
            PG8_LDB(B0, 1, 0); PG8_SCHED; PG8_LDA(At, 1, 0); PG8_STAGE(PG8_SA(0, 1), a2 + hstep, voffA);
            PG8_WAIT_L(8); PG8_BAR; PG8_WAIT_L(0); PG8_MMA(0, 0, At, B0); PG8_BAR; PG8_SCHED;
            PG8_LDB(B1, 1, 1); PG8_STAGE(PG8_SB(1, 0), b3, voffB);
            PG8_BAR; PG8_WAIT_L(0); PG8_MMA(0, 1, At, B1); PG8_BAR;
            PG8_LDA(At, 1, 1); PG8_STAGE(PG8_SA(1, 0), a3, voffA);
            PG8_BAR; PG8_WAIT_L(0); PG8_MMA(1, 0, At, B0); PG8_BAR; PG8_SCHED;
            PG8_STAGE(PG8_SB(1, 1), b3 + hstep, voffB);
            PG8_WAIT_V(6); PG8_BAR; PG8_MMA(1, 1, At, B1); PG8_BAR;
            }
        }
        if constexpr (ALIGN_EPI) { if (wr == 0) PG8_BAR; }
        if constexpr (!Epi::AFTER_DRAIN) { E(acc, cur, wr, wc, fr, fq); S.done(cur); }
        if (!has_next) break;
#pragma unroll
        for (int a = 0; a < 2; ++a)
#pragma unroll
            for (int b = 0; b < 2; ++b)
#pragma unroll
                for (int m = 0; m < 4; ++m)
#pragma unroll
                    for (int n = 0; n < 2; ++n) acc[a][b][m][n] = (f32x4){0.f, 0.f, 0.f, 0.f};
        cur = nxt; cA = nA; cB = nB; ++ui;
        if constexpr (ALIGN_EPI) { if (wr == 1) PG8_BAR; }
    }
    PG8_WAIT_V(0);
    if constexpr (!ALIGN_EPI) { if (wr == 0) PG8_BAR; }
    PG8_BAR;
    if constexpr (Epi::AFTER_DRAIN) { E.fused(acc, cur, wr, wc, fr, fq, lds, wid, lane); S.done(cur); }
#undef PG8_SA
#undef PG8_SB
#undef PG8_STAGE
#undef PG8_LDA
#undef PG8_LDB
#undef PG8_MMA
#undef PG8_WAIT_V
#undef PG8_WAIT_L
#undef PG8_BAR
#undef PG8_SCHED
}
}

#define GAS __attribute__((address_space(1)))
#define LAS __attribute__((address_space(3)))
typedef unsigned short bf16;
typedef float f32x4 __attribute__((ext_vector_type(4)));
typedef float f32x2 __attribute__((ext_vector_type(2)));
typedef short bf16x8 __attribute__((ext_vector_type(8)));
typedef unsigned u32x4 __attribute__((ext_vector_type(4)));
typedef unsigned u32x2 __attribute__((ext_vector_type(2)));

constexpr int NB = 4, SEQ = 8192, T = NB * SEQ, DM = 1024;
constexpr int NW_IN = 7168;
constexpr int NCHUNK = 64, NUNIT_M = NB * 8 * NCHUNK;
constexpr float ALPHA = 1.189207115002721f;
constexpr float QSCALE2 = 0.125f * 1.4426950408889634f;
constexpr float LN_EPS = 1e-5f, GN_EPS = 1e-6f;
constexpr int MOE_MAXROWS = 65536 + 16 * 256;

constexpr size_t MiB = 1u << 20;
constexpr size_t WS_CTL = 0;
constexpr size_t WS_WIN = 1 * MiB;
constexpr size_t WS_WBA = 15 * MiB;
constexpr size_t WS_WBM = 16 * MiB;
constexpr size_t WS_WOUT = 18 * MiB;
constexpr size_t WS_COS = 20 * MiB, WS_SIN = 21 * MiB;
constexpr size_t WS_BIAS = 22 * MiB;
constexpr size_t WS_TE = 22 * MiB + 64 * 1024;
constexpr size_t WS_TW = WS_TE + (size_t)T * 16;
constexpr size_t WS_POS = WS_TW + (size_t)T * 8;
constexpr size_t WS_CST = 24 * MiB;
constexpr size_t WS_DSC = 60 * MiB;
constexpr size_t WS_MC = 60 * MiB + 64 * 1024;
constexpr size_t WS_DN = 61 * MiB;
constexpr size_t WS_WGU = 24 * MiB;
constexpr size_t WS_WD = 56 * MiB;
constexpr size_t WS_AQ = 72 * MiB, WS_AK = 104 * MiB, WS_AV = 136 * MiB;
constexpr size_t WS_IQ = 168 * MiB;
constexpr size_t WS_IK = 184 * MiB;
constexpr size_t WS_IW = 188 * MiB;
constexpr size_t WS_MI = 189 * MiB, WS_MF = 190 * MiB;
constexpr size_t WS_MQ = 192 * MiB, WS_MK = 224 * MiB;
constexpr size_t WS_MV = 256 * MiB;
constexpr size_t WS_MO = 320 * MiB;
constexpr size_t WS_GA = 384 * MiB;
constexpr size_t WS_MASK = 448 * MiB;
constexpr size_t WS_YA = 480 * MiB;
constexpr size_t WS_MERGED = 192 * MiB;
constexpr size_t WS_XS = 72 * MiB;
constexpr size_t WS_H = 208 * MiB;
constexpr size_t WS_Y = 276 * MiB;
constexpr size_t WS_END = 512 * MiB;
constexpr size_t DO_XN = 0;
constexpr size_t DO_GM = 64 * MiB;
constexpr size_t DO_DC = 0;
constexpr size_t DO_YM = 0;
constexpr int CW_CURSOR = 64;

struct Params { const float* in[19]; float* out; unsigned char* ws; };

__device__ __forceinline__ float bf2f(unsigned h) { return __uint_as_float(h << 16); }
__device__ __forceinline__ unsigned f2bf(float f) { unsigned u = __float_as_uint(f); return (u + 0x7fffu + ((u >> 16) & 1u)) >> 16; }
__device__ __forceinline__ unsigned pk2(float lo, float hi) { return f2bf(lo) | (f2bf(hi) << 16); }
__device__ __forceinline__ float sigmoidf_(float x) { return 1.0f / (1.0f + __expf(-x)); }
__device__ __forceinline__ float siluf_(float x) { return x / (1.0f + __expf(-x)); }
__device__ __forceinline__ float logsigmoidf_(float x) { return fminf(x, 0.f) - log1pf(__expf(-fabsf(x))); }
__device__ __forceinline__ float wave_sum(float v) {
#pragma unroll
    for (int o = 1; o < 64; o <<= 1) v += __shfl_xor(v, o);
    return v;
}
__device__ __forceinline__ float wave_max(float v) {
#pragma unroll
    for (int o = 1; o < 64; o <<= 1) v = fmaxf(v, __shfl_xor(v, o));
    return v;
}
__host__ __device__ __forceinline__ int ropeil(int d) { return d < 32 ? 2 * d : 2 * (d - 32) + 1; }
__host__ __device__ __forceinline__ int win_newcol(int c) {
    if (c < 1024) return (c & ~63) + ropeil(c & 63);
    if (c < 1536) return c;
    if (c < 1792) return (c & ~63) + ropeil(c & 63);
    if (c < 1856) return 1792 + ropeil(c - 1792);
    if (c < 1860) return 1792 + 64 + (c - 1856);
    if (c < 2372) return 2048 + (c - 1860);
    if (c < 2884) return 2560 + (c - 2372);
    if (c < 3908) return 3072 + (c - 2884);
    if (c < 3916) return 1792 + 72 + (c - 3908);
    if (c < 3924) return 1792 + 80 + (c - 3916);
    if (c < 4948) return 4096 + (c - 3924);
    if (c < 5972) return 5120 + (c - 4948);
    return 6144 + (c - 5972);
}

template <class F>
__device__ __forceinline__ void transpose_item(const float* W, int K, int N, bf16* WT, LAS float* scr, int item, int lane, F rowmap) {
    const int nblk = (N + 31) / 32, kb = item / nblk, nb = item % nblk, k0 = 64 * kb, n0 = 32 * nb;
    const int nsrc = n0 + (lane & 31);
#pragma unroll 8
    for (int i = 0; i < 32; ++i) { const int kk = 2 * i + (lane >> 5); scr[kk * 33 + (lane & 31)] = nsrc < N ? W[(size_t)(k0 + kk) * N + nsrc] : 0.f; }
    asm volatile("s_waitcnt lgkmcnt(0)" ::: "memory");
    const int c = lane & 7;
#pragma unroll
    for (int j = 0; j < 4; ++j) {
        const int nl = (lane >> 3) + 8 * j, n = n0 + nl;
        const LAS float* s = scr + (8 * c) * 33 + nl;
        u32x4 o; o.x = pk2(s[0 * 33], s[1 * 33]); o.y = pk2(s[2 * 33], s[3 * 33]); o.z = pk2(s[4 * 33], s[5 * 33]); o.w = pk2(s[6 * 33], s[7 * 33]);
        if (n < N) { const int dr = rowmap(n); *(u32x4*)(WT + (size_t)dr * K + k0 + 8 * c) = o; }
    }
    asm volatile("s_waitcnt lgkmcnt(0)" ::: "memory");
}

struct MapId { __device__ __forceinline__ int operator()(int n) const { return n; } };
struct MapWin { __device__ __forceinline__ int operator()(int n) const { return win_newcol(n); } };
struct MapGU { int off; __device__ __forceinline__ int operator()(int n) const { return (n >> 7) * 256 + off + (n & 127); } };

__device__ __forceinline__ void row_to_bf16(const float* xrow, bf16* orow, int lane) {
    const f32x4* xr = (const f32x4*)xrow + lane;
    unsigned long long* o8 = (unsigned long long*)orow + lane;
#pragma unroll
    for (int j = 0; j < 4; ++j) { const f32x4 v = xr[64 * j]; o8[64 * j] = (unsigned long long)pk2(v.x, v.y) | ((unsigned long long)pk2(v.z, v.w) << 32); }
}

__device__ __forceinline__ void phase_prologue(const Params& p, LAS unsigned char* lds) {
    const int tid = threadIdx.x, lane = tid & 63, wave = tid >> 6;
    const int gw = blockIdx.x * 8 + wave, NGW = gridDim.x * 8;
    LAS float* scr = (LAS float*)(lds + wave * 16384);
    unsigned char* ws = p.ws;
    constexpr int I_WIN = (1024 / 64) * 219, I_WBA = (512 / 64) * 32, I_WBM = 16 * 32, I_WOUT = 16 * 32;
    constexpr int NIT = I_WIN + I_WBA + I_WBM + I_WOUT;
    for (int it = gw; it < NIT; it += NGW) {
        int r = it;
        if (r < I_WIN) { transpose_item(p.in[1], 1024, 6996, (bf16*)(ws + WS_WIN), scr, r, lane, MapWin()); continue; } r -= I_WIN;
        if (r < I_WBA) { transpose_item(p.in[5], 512, 1024, (bf16*)(ws + WS_WBA), scr, r, lane, MapId()); continue; } r -= I_WBA;
        if (r < I_WBM) { transpose_item(p.in[6], 1024, 1024, (bf16*)(ws + WS_WBM), scr, r, lane, MapId()); continue; } r -= I_WBM;
        transpose_item(p.in[7], 1024, 1024, (bf16*)(ws + WS_WOUT), scr, r, lane, MapId());
    }
    {
        const int gt = blockIdx.x * 512 + tid, NGT = gridDim.x * 512;
        bf16* wt = (bf16*)(ws + WS_WIN); float* bp = (float*)(ws + WS_BIAS);
        for (int i = gt; i < 172 * 128; i += NGT) {
            const int pr = i / 128, ch = i % 128; const int row = pr < 4 ? 1860 + pr : 1880 + (pr - 4);
            *(u32x4*)(wt + (size_t)row * 1024 + ch * 8) = (u32x4){0u, 0u, 0u, 0u};
        }
        for (int i = gt; i < 172; i += NGT) { const int row = i < 4 ? 1860 + i : 1880 + (i - 4); bp[row] = 0.f; }
        for (int c = gt; c < 6996; c += NGT) bp[win_newcol(c)] = p.in[2][c];
        float* cosT = (float*)(ws + WS_COS); float* sinT = (float*)(ws + WS_SIN);
        for (int i = gt; i < SEQ * 32; i += NGT) {
            const int t = i >> 5, k = i & 31;
            const float inv = (float)pow(10000.0, -(double)k / 32.0);
            const float ang = (float)t * inv;
            cosT[i] = (float)cos((double)ang); sinT[i] = (float)sin((double)ang);
        }
    }
    bf16* xn = (bf16*)((unsigned char*)p.out + DO_XN);
    for (int m = gw; m < T; m += NGW) row_to_bf16(p.in[0] + (size_t)m * DM, xn + (size_t)m * DM, lane);
}

__device__ __forceinline__ void phase_expert_weights(const Params& p, LAS unsigned char* lds) {
    const int tid = threadIdx.x, lane = tid & 63, wave = tid >> 6;
    const int gw = blockIdx.x * 8 + wave, NGW = gridDim.x * 8;
    LAS float* scr = (LAS float*)(lds + wave * 16384);
    constexpr int I_G = 16 * 16, I_D = 8 * 32;
    constexpr int NIT = 16 * (2 * I_G + I_D);
    for (int it = gw; it < NIT; it += NGW) {
        const int e = it / (2 * I_G + I_D); int r = it % (2 * I_G + I_D);
        bf16* wgu = (bf16*)(p.ws + WS_WGU) + (size_t)e * 1024 * 1024;
        if (r < I_G) { transpose_item(p.in[14] + (size_t)e * 1024 * 512, 1024, 512, wgu, scr, r, lane, MapGU{0}); continue; } r -= I_G;
        if (r < I_G) { transpose_item(p.in[15] + (size_t)e * 1024 * 512, 1024, 512, wgu, scr, r, lane, MapGU{128}); continue; } r -= I_G;
        transpose_item(p.in[16] + (size_t)e * 512 * 1024, 512, 1024, (bf16*)(p.ws + WS_WD) + (size_t)e * 1024 * 512, scr, r, lane, MapId());
    }
}

struct EpiInProj {
    static constexpr bool PERM = true, AFTER_DRAIN = false;
    unsigned char* ws; unsigned char* dout; const float* bias; const float* cosT; const float* sinT;
    __device__ __forceinline__ void operator()(const f32x4 (&acc)[2][2][4][2], const pg8::Unit& u, int wr, int wc, int fr, int fq) const {
        const int pn = u.pn;
        const int row0 = u.pm * 256 + wr * 64 + fr;
        const int cl0 = wc * 32 + 8 * fq;
        f32x4 bv[2][2];
#pragma unroll
        for (int bj = 0; bj < 2; ++bj)
#pragma unroll
            for (int n = 0; n < 2; ++n) bv[bj][n] = *(const f32x4*)(bias + pn * 256 + cl0 + bj * 128 + 4 * n);
        int cat; bf16* dst = nullptr; int ld = 0, cb = 0; float sc = 1.f;
        if (pn < 2)       { cat = 0; dst = (bf16*)(ws + WS_AQ); ld = 512; cb = pn * 256; sc = QSCALE2; }
        else if (pn < 4)  { cat = 0; dst = (bf16*)(ws + WS_AK); ld = 512; cb = (pn - 2) * 256; }
        else if (pn < 6)  { cat = 1; dst = (bf16*)(ws + WS_AV); ld = 512; cb = (pn - 4) * 256; }
        else if (pn == 6) { cat = 0; dst = (bf16*)(ws + WS_IQ); ld = 256; cb = 0; }
        else if (pn == 7) { cat = 3; }
        else if (pn < 10) { cat = 1; dst = (bf16*)(ws + WS_MQ); ld = 512; cb = (pn - 8) * 256; }
        else if (pn < 12) { cat = 1; dst = (bf16*)(ws + WS_MK); ld = 512; cb = (pn - 10) * 256; }
        else if (pn < 16) { cat = 1; dst = (bf16*)(ws + WS_MV); ld = 1024; cb = (pn - 12) * 256; }
        else if (pn < 20) { cat = 2; dst = (bf16*)(ws + WS_MO); ld = 1024; cb = (pn - 16) * 256; }
        else if (pn < 24) { cat = 2; dst = (bf16*)(ws + WS_GA); ld = 1024; cb = (pn - 20) * 256; }
        else              { cat = 2; dst = (bf16*)(dout + DO_GM); ld = 1024; cb = (pn - 24) * 256; }
#pragma unroll
        for (int ai = 0; ai < 2; ++ai)
#pragma unroll
            for (int m = 0; m < 4; ++m) {
                const int row = row0 + ai * 128 + m * 16;
                const int t = row & (SEQ - 1);
#pragma unroll
                for (int bj = 0; bj < 2; ++bj) {
                    f32x4 v0 = acc[ai][bj][m][0] + bv[bj][0], v1 = acc[ai][bj][m][1] + bv[bj][1];
                    const int cl = cl0 + bj * 128;
                    if (cat == 3) {
                        if (cl < 64) {
                            const int d0 = cl >> 1;
                            const f32x4 c4 = *(const f32x4*)(cosT + t * 32 + d0), s4 = *(const f32x4*)(sinT + t * 32 + d0);
                            u32x4 w;
                            w.x = pk2(v0[0] * c4[0] - v0[1] * s4[0], v0[0] * s4[0] + v0[1] * c4[0]);
                            w.y = pk2(v0[2] * c4[1] - v0[3] * s4[1], v0[2] * s4[1] + v0[3] * c4[1]);
                            w.z = pk2(v1[0] * c4[2] - v1[1] * s4[2], v1[0] * s4[2] + v1[1] * c4[2]);
                            w.w = pk2(v1[2] * c4[3] - v1[3] * s4[3], v1[2] * s4[3] + v1[3] * c4[3]);
                            *(u32x4*)((bf16*)(ws + WS_IK) + (size_t)row * 64 + cl) = w;
                        } else if (cl == 64) {
                            *(f32x4*)((float*)(ws + WS_IW) + (size_t)row * 4) = v0 * 0.0625f;
                        } else if (cl == 72) {
                            float* d = (float*)(ws + WS_MI) + (size_t)row * 8; *(f32x4*)d = v0; *(f32x4*)(d + 4) = v1;
                        } else if (cl == 80) {
                            float* d = (float*)(ws + WS_MF) + (size_t)row * 8; *(f32x4*)d = v0; *(f32x4*)(d + 4) = v1;
                        }
                    } else {
                        u32x4 w;
                        if (cat == 0) {
                            const int d0 = (cl & 63) >> 1;
                            const f32x4 c4 = *(const f32x4*)(cosT + t * 32 + d0), s4 = *(const f32x4*)(sinT + t * 32 + d0);
                            w.x = pk2((v0[0] * c4[0] - v0[1] * s4[0]) * sc, (v0[0] * s4[0] + v0[1] * c4[0]) * sc);
                            w.y = pk2((v0[2] * c4[1] - v0[3] * s4[1]) * sc, (v0[2] * s4[1] + v0[3] * c4[1]) * sc);
                            w.z = pk2((v1[0] * c4[2] - v1[1] * s4[2]) * sc, (v1[0] * s4[2] + v1[1] * c4[2]) * sc);
                            w.w = pk2((v1[2] * c4[3] - v1[3] * s4[3]) * sc, (v1[2] * s4[3] + v1[3] * c4[3]) * sc);
                        } else if (cat == 1) {
                            w.x = pk2(v0[0], v0[1]); w.y = pk2(v0[2], v0[3]); w.z = pk2(v1[0], v1[1]); w.w = pk2(v1[2], v1[3]);
                        } else {
                            w.x = pk2(sigmoidf_(v0[0]), sigmoidf_(v0[1])); w.y = pk2(sigmoidf_(v0[2]), sigmoidf_(v0[3]));
                            w.z = pk2(sigmoidf_(v1[0]), sigmoidf_(v1[1])); w.w = pk2(sigmoidf_(v1[2]), sigmoidf_(v1[3]));
                        }
                        *(u32x4*)(dst + (size_t)row * ld + cb + cl) = w;
                    }
                }
            }
    }
};

__device__ __forceinline__ void phase_inproj(const Params& p, LAS unsigned char* lds) {
    pg8::Gemm g{(const bf16*)((unsigned char*)p.out + DO_XN), (const bf16*)(p.ws + WS_WIN), T, NW_IN, 1024};
    pg8::StaticOrder S; S.init(T, NW_IN, gridDim.x, (int)blockIdx.x);
    EpiInProj E{p.ws, (unsigned char*)p.out, (const float*)(p.ws + WS_BIAS), (const float*)(p.ws + WS_COS), (const float*)(p.ws + WS_SIN)};
    pg8::gemm_phase<EpiInProj, pg8::StaticOrder, true, true>(lds, g, S, E);
}

__device__ __forceinline__ unsigned sortable_u32(float s) { const unsigned b = __float_as_uint(s); return (b & 0x80000000u) ? ~b : (b | 0x80000000u); }

__global__ void __launch_bounds__(256) k_attn_simple(Params p) {
    extern __shared__ __attribute__((aligned(16))) unsigned char lds_raw[];
    const int tid = threadIdx.x, lane = tid & 63, wave = tid >> 6;
    unsigned* sc = (unsigned*)(lds_raw + wave * 32768);
    float* qs = (float*)(lds_raw + 131072 + wave * 1024);
    const bf16* IQ = (const bf16*)(p.ws + WS_IQ); const bf16* IK = (const bf16*)(p.ws + WS_IK); const float* IW = (const float*)(p.ws + WS_IW);
    const bf16* AQ = (const bf16*)(p.ws + WS_AQ); const bf16* AK = (const bf16*)(p.ws + WS_AK); const bf16* AV = (const bf16*)(p.ws + WS_AV);
    bf16* YA = (bf16*)(p.ws + WS_YA);
    const int nq = T;
    for (int qi = blockIdx.x * 4 + wave; qi < nq; qi += gridDim.x * 4) {
        const int b = qi >> 13; int t = qi & (SEQ - 1);
        t = (t & 1) ? (SEQ - 1 - (t >> 1)) : (t >> 1);
        const size_t tok = (size_t)b * SEQ + t; const int n = t + 1;
        for (int e = lane; e < 256; e += 64) { const int h = e >> 6, d = e & 63; qs[d * 4 + h] = bf2f(IQ[tok * 256 + e]); }
        const f32x4 w4 = *(const f32x4*)(IW + tok * 4);
        asm volatile("s_waitcnt lgkmcnt(0)" ::: "memory");
        for (int j0 = 0; j0 < n; j0 += 64) {
            const int s = j0 + lane;
            if (s < n) {
                const u32x4* kp = (const u32x4*)(IK + ((size_t)b * SEQ + s) * 64);
                float a0 = 0.f, a1 = 0.f, a2 = 0.f, a3 = 0.f;
#pragma unroll
                for (int c = 0; c < 8; ++c) {
                    const u32x4 kv = kp[c];
                    const unsigned kw[4] = {kv.x, kv.y, kv.z, kv.w};
#pragma unroll
                    for (int i = 0; i < 4; ++i) {
                        const float k0 = __uint_as_float(kw[i] << 16), k1 = __uint_as_float(kw[i] & 0xffff0000u);
                        const f32x4 q0 = *(const f32x4*)(qs + (c * 8 + 2 * i) * 4), q1 = *(const f32x4*)(qs + (c * 8 + 2 * i + 1) * 4);
                        a0 += q0[0] * k0 + q1[0] * k1; a1 += q0[1] * k0 + q1[1] * k1; a2 += q0[2] * k0 + q1[2] * k1; a3 += q0[3] * k0 + q1[3] * k1;
                    }
                }
                float score = w4[0] * fmaxf(a0, 0.f) + w4[1] * fmaxf(a1, 0.f) + w4[2] * fmaxf(a2, 0.f) + w4[3] * fmaxf(a3, 0.f);
                score += 0.0f;
                sc[s] = sortable_u32(score);
            }
        }
        asm volatile("s_waitcnt lgkmcnt(0)" ::: "memory");
        unsigned theta = 0u; int cut = SEQ;
        if (n > 256) {
            for (int bit = 31; bit >= 0; --bit) {
                const unsigned cand = theta | (1u << bit);
                int cnt = 0;
                for (int s = lane; s < n; s += 64) cnt += (sc[s] >= cand) ? 1 : 0;
                cnt = (int)wave_sum((float)cnt);
                if (cnt >= 256) theta = cand;
            }
            int cgt = 0;
            for (int s = lane; s < n; s += 64) cgt += (sc[s] > theta) ? 1 : 0;
            cgt = (int)wave_sum((float)cgt);
            const int r = 256 - cgt;
            int x = 0;
            for (int bit = 12; bit >= 0; --bit) {
                const int xc = x | (1 << bit);
                int cnt = 0;
                for (int s = lane; s < n; s += 64) cnt += (sc[s] == theta && s < xc) ? 1 : 0;
                cnt = (int)wave_sum((float)cnt);
                if (cnt < r) x = xc;
            }
            cut = x;
        }
        float q[8], o[8];
        { const u32x4 qv = *(const u32x4*)(AQ + tok * 512 + lane * 8); const unsigned qw[4] = {qv.x, qv.y, qv.z, qv.w};
#pragma unroll
          for (int i = 0; i < 4; ++i) { q[2 * i] = __uint_as_float(qw[i] << 16); q[2 * i + 1] = __uint_as_float(qw[i] & 0xffff0000u); } }
#pragma unroll
        for (int i = 0; i < 8; ++i) o[i] = 0.f;
        float mrun = -INFINITY, lsum = 0.f;
        for (int j0 = 0; j0 < n; j0 += 64) {
            const int s = j0 + lane;
            bool sel = false;
            if (s < n) { const unsigned u = sc[s]; sel = (u > theta) || (u == theta && s <= cut); }
            unsigned long long mask = __ballot(sel);
            while (mask) {
                const int bit = __builtin_ctzll(mask); mask &= mask - 1;
                const size_t kt = (size_t)b * SEQ + j0 + bit;
                const u32x4 kv = *(const u32x4*)(AK + kt * 512 + lane * 8);
                const u32x4 vv = *(const u32x4*)(AV + kt * 512 + lane * 8);
                const unsigned kw[4] = {kv.x, kv.y, kv.z, kv.w}, vw[4] = {vv.x, vv.y, vv.z, vv.w};
                float dot = 0.f;
#pragma unroll
                for (int i = 0; i < 4; ++i) dot += q[2 * i] * __uint_as_float(kw[i] << 16) + q[2 * i + 1] * __uint_as_float(kw[i] & 0xffff0000u);
                dot += __shfl_xor(dot, 1); dot += __shfl_xor(dot, 2); dot += __shfl_xor(dot, 4);
                const float mn = fmaxf(mrun, dot);
                const float scl = exp2f(mrun - mn), pr = exp2f(dot - mn);
                lsum = lsum * scl + pr;
#pragma unroll
                for (int i = 0; i < 4; ++i) {
                    o[2 * i] = o[2 * i] * scl + pr * __uint_as_float(vw[i] << 16);
                    o[2 * i + 1] = o[2 * i + 1] * scl + pr * __uint_as_float(vw[i] & 0xffff0000u);
                }
                mrun = mn;
            }
        }
        const float inv = 1.0f / lsum;
        u32x4 w; w.x = pk2(o[0] * inv, o[1] * inv); w.y = pk2(o[2] * inv, o[3] * inv); w.z = pk2(o[4] * inv, o[5] * inv); w.w = pk2(o[6] * inv, o[7] * inv);
        *(u32x4*)(YA + tok * 512 + lane * 8) = w;
    }
}

constexpr int LQ = 72, LS = 136;

__device__ __forceinline__ f32x4 mfma16(const LAS bf16* Arow, const LAS bf16* Brow, f32x4 acc) {
    const bf16x8 a = *(const LAS bf16x8*)Arow, b = *(const LAS bf16x8*)Brow;
    return __builtin_amdgcn_mfma_f32_16x16x32_bf16(a, b, acc, 0, 0, 0);
}

template <class F>
__device__ __forceinline__ void conv_silu_tile(int tid, const bf16* src, const float* convw, int chbase, int b, int c, int h, F emit) {
    const int col = tid & 63, r0 = (tid >> 6) * 16;
    const int ch = chbase + h * 64 + col;
    const float w0 = convw[0 * 1024 + ch], w1 = convw[1 * 1024 + ch], w2 = convw[2 * 1024 + ch], w3 = convw[3 * 1024 + ch];
    const int t0 = c * 128 + r0;
    const bf16* base = src + ((size_t)b * SEQ) * 512 + h * 64 + col;
    float xm3 = (t0 - 3 >= 0) ? bf2f(base[(size_t)(t0 - 3) * 512]) : 0.f;
    float xm2 = (t0 - 2 >= 0) ? bf2f(base[(size_t)(t0 - 2) * 512]) : 0.f;
    float xm1 = (t0 - 1 >= 0) ? bf2f(base[(size_t)(t0 - 1) * 512]) : 0.f;
#pragma unroll 4
    for (int r = 0; r < 16; ++r) {
        const float x0 = bf2f(base[(size_t)(t0 + r) * 512]);
        const float y = w0 * xm3 + w1 * xm2 + w2 * xm1 + w3 * x0;
        emit(r0 + r, col, siluf_(y));
        xm3 = xm2; xm2 = xm1; xm1 = x0;
    }
}

__device__ __forceinline__ void load_vt(int tid, const bf16* MV, LAS bf16* VT, int b, int c, int h) {
    const int v = tid & 127, s0 = (tid >> 7) * 32;
    const bf16* base = MV + ((size_t)b * SEQ + c * 128) * 1024 + h * 128 + v;
#pragma unroll 8
    for (int s = 0; s < 32; ++s) VT[v * LS + s0 + s] = base[(size_t)(s0 + s) * 1024];
    for (int i = tid; i < 16 * 128; i += 512) { const int r = 128 + (i >> 7), s = i & 127; VT[r * LS + s] = (r == 128) ? (bf16)0x3F80 : (bf16)0; }
}

__device__ __forceinline__ void mlstm_kv_unit(const Params& p, LAS unsigned char* lds, int u) {
    int tid_ = threadIdx.x; asm volatile("" : "+v"(tid_));
    const int tid = tid_, lane = tid & 63, wave = __builtin_amdgcn_readfirstlane(tid >> 6), fr = lane & 15, fq = lane >> 4;
    const int c = u & 63, h = (u >> 6) & 7, b = u >> 9;
    LAS bf16* VT = (LAS bf16*)lds;
    LAS bf16* WKT = VT + 144 * LS;
    LAS float* fs = (LAS float*)(WKT + 64 * LS);
    LAS float* lfs = fs, *is_ = fs + 128, *bs = fs + 256, *wg = fs + 384;
    const float* MI = (const float*)(p.ws + WS_MI); const float* MF = (const float*)(p.ws + WS_MF);
    const size_t tok0 = (size_t)b * SEQ + c * 128;
    if (tid < 128) { lfs[tid] = logsigmoidf_(MF[(tok0 + tid) * 8 + h]); is_[tid] = MI[(tok0 + tid) * 8 + h]; }
    __syncthreads();
    if (tid < 128) { float a = 0.f; for (int r = 0; r <= tid; ++r) a += lfs[r]; bs[tid] = a; }
    __syncthreads();
    const float blast = bs[127];
    float gmax = -INFINITY;
    for (int s = 0; s < 128; ++s) gmax = fmaxf(gmax, blast - bs[s] + is_[s]);
    if (tid < 128) wg[tid] = __expf(blast - bs[tid] + is_[tid] - gmax);
    __syncthreads();
    conv_silu_tile(tid, (const bf16*)(p.ws + WS_MK), p.in[3], 512, b, c, h, [&](int r, int col, float y) { WKT[col * LS + r] = (bf16)f2bf(y * wg[r]); });
    load_vt(tid, (const bf16*)(p.ws + WS_MV), VT, b, c, h);
    __syncthreads();
    float* DC = (float*)((unsigned char*)p.out + DO_DC) + (size_t)u * 128 * 64;
    float* DN = (float*)(p.ws + WS_DN) + (size_t)u * 64;
#pragma unroll
    for (int ct = 0; ct < 4; ++ct) {
        f32x4 acc = {0.f, 0.f, 0.f, 0.f};
#pragma unroll
        for (int kk = 0; kk < 4; ++kk) acc = mfma16(VT + (wave * 16 + fr) * LS + kk * 32 + 8 * fq, WKT + (ct * 16 + fr) * LS + kk * 32 + 8 * fq, acc);
#pragma unroll
        for (int r = 0; r < 4; ++r) DC[(size_t)(wave * 16 + 4 * fq + r) * 64 + ct * 16 + fr] = acc[r];
    }
    if (wave == 0) {
#pragma unroll
        for (int ct = 0; ct < 4; ++ct) {
            f32x4 acc = {0.f, 0.f, 0.f, 0.f};
#pragma unroll
            for (int kk = 0; kk < 4; ++kk) acc = mfma16(VT + (128 + fr) * LS + kk * 32 + 8 * fq, WKT + (ct * 16 + fr) * LS + kk * 32 + 8 * fq, acc);
            if (fq == 0) DN[ct * 16 + fr] = acc[0];
        }
    }
    if (tid == 0) { float* dsc = (float*)(p.ws + WS_DSC) + (size_t)u * 2; dsc[0] = blast; dsc[1] = gmax; }
    __syncthreads();
}

__device__ __forceinline__ void mlstm_scan(const Params& p) {
    const int tid = threadIdx.x;
    for (int w = blockIdx.x; w < NB * 8 * 8; w += gridDim.x) {
        const int bh = w >> 3, part = w & 7;
        const float* DC = (const float*)((unsigned char*)p.out + DO_DC);
        const float* DN = (const float*)(p.ws + WS_DN);
        const float* DSC = (const float*)(p.ws + WS_DSC);
        bf16* CST = (bf16*)(p.ws + WS_CST);
        float* MC = (float*)(p.ws + WS_MC);
        const int e0 = part * 1024 + tid, e1 = e0 + 512;
        const bool hasn = (part == 0 && tid < 64);
        float c0 = 0.f, c1 = 0.f, nn = 0.f, m = 0.f;
        for (int c = 0; c < NCHUNK; ++c) {
            const size_t u = (size_t)bh * 64 + c;
            bf16* cs = CST + u * 144 * 64;
            cs[e0] = (bf16)f2bf(c0); cs[e1] = (bf16)f2bf(c1);
            if (hasn) cs[128 * 64 + tid] = (bf16)f2bf(nn);
            if (part == 0 && tid == 0) MC[u] = m;
            const float bl = DSC[u * 2], gm = DSC[u * 2 + 1];
            const float mn = fmaxf(bl + m, gm);
            const float a = __expf(bl + m - mn), s = __expf(gm - mn);
            c0 = a * c0 + s * DC[u * 8192 + e0]; c1 = a * c1 + s * DC[u * 8192 + e1];
            if (hasn) nn = a * nn + s * DN[u * 64 + tid];
            m = mn;
        }
    }
}

__device__ __forceinline__ void mlstm_out_unit(const Params& p, LAS unsigned char* lds, int u) {
    int tid_ = threadIdx.x; asm volatile("" : "+v"(tid_));
    const int tid = tid_, lane = tid & 63, wave = __builtin_amdgcn_readfirstlane(tid >> 6), fr = lane & 15, fq = lane >> 4;
    const int c = u & 63, h = (u >> 6) & 7, b = u >> 9;
    LAS bf16* Qs = (LAS bf16*)lds;
    LAS bf16* Ks = Qs + 128 * LQ;
    LAS bf16* VT = Ks + 128 * LQ;
    LAS bf16* Pm = VT + 144 * LS;
    LAS bf16* CT = Pm + 128 * LS;
    LAS float* fs = (LAS float*)(CT + 144 * LQ);
    LAS float* lfs = fs, *is_ = fs + 128, *bs = fs + 256, *as_ = fs + 384, *bsm = fs + 512, *wint = fs + 640, *nfl = fs + 768;
    const float* MI = (const float*)(p.ws + WS_MI); const float* MF = (const float*)(p.ws + WS_MF);
    const size_t tok0 = (size_t)b * SEQ + c * 128;
    const float mc = ((const float*)(p.ws + WS_MC))[u];
    if (tid < 128) { lfs[tid] = logsigmoidf_(MF[(tok0 + tid) * 8 + h]); is_[tid] = MI[(tok0 + tid) * 8 + h]; }
    __syncthreads();
    if (tid < 128) { float a = 0.f; for (int r = 0; r <= tid; ++r) a += lfs[r]; bs[tid] = a; as_[tid] = is_[tid] - a; }
    __syncthreads();
    if (tid < 128) {
        float pm = -INFINITY; for (int r = 0; r <= tid; ++r) pm = fmaxf(pm, as_[r]);
        const float bj = bs[tid];
        const float mt = fmaxf(bj + mc, bj + pm);
        bsm[tid] = bj - mt; wint[tid] = __expf(bj + mc - mt); nfl[tid] = __expf(-mt);
    }
    conv_silu_tile(tid, (const bf16*)(p.ws + WS_MQ), p.in[3], 0, b, c, h, [&](int r, int col, float y) { Qs[r * LQ + col] = (bf16)f2bf(y * 0.125f); });
    conv_silu_tile(tid, (const bf16*)(p.ws + WS_MK), p.in[3], 512, b, c, h, [&](int r, int col, float y) { Ks[r * LQ + col] = (bf16)f2bf(y); });
    load_vt(tid, (const bf16*)(p.ws + WS_MV), VT, b, c, h);
    {
        const bf16* cs = (const bf16*)(p.ws + WS_CST) + (size_t)u * 144 * 64;
        for (int i = tid; i < 144 * 8; i += 512) { const int r = i >> 3, ch = i & 7;
            u32x4 v = {0u, 0u, 0u, 0u}; if (r < 129) v = *(const u32x4*)(cs + r * 64 + ch * 8);
            *(LAS u32x4*)(CT + r * LQ + ch * 8) = v; }
    }
    __syncthreads();
    const int jrow = wave * 16 + 4 * fq;
#pragma unroll 1
    for (int ct = 0; ct < 8; ++ct) {
        f32x4 acc = {0.f, 0.f, 0.f, 0.f};
        if (ct <= wave) {
#pragma unroll
            for (int kk = 0; kk < 2; ++kk) acc = mfma16(Qs + (wave * 16 + fr) * LQ + kk * 32 + 8 * fq, Ks + (ct * 16 + fr) * LQ + kk * 32 + 8 * fq, acc);
        }
        const int s = ct * 16 + fr; const float a_s = as_[s];
#pragma unroll
        for (int r = 0; r < 4; ++r) {
            const int j = jrow + r;
            const float val = (s <= j) ? acc[r] * __expf(bsm[j] + a_s) : 0.f;
            Pm[j * LS + s] = (bf16)f2bf(val);
        }
    }
    __syncthreads();
    f32x4 o[9];
#pragma unroll
    for (int ct = 0; ct < 9; ++ct) {
        f32x4 acc = {0.f, 0.f, 0.f, 0.f};
#pragma unroll
        for (int kk = 0; kk < 2; ++kk) acc = mfma16(Qs + (wave * 16 + fr) * LQ + kk * 32 + 8 * fq, CT + (ct * 16 + fr) * LQ + kk * 32 + 8 * fq, acc);
#pragma unroll
        for (int r = 0; r < 4; ++r) acc[r] *= wint[jrow + r];
#pragma unroll
        for (int kk = 0; kk < 4; ++kk) acc = mfma16(Pm + (wave * 16 + fr) * LS + kk * 32 + 8 * fq, VT + (ct * 16 + fr) * LS + kk * 32 + 8 * fq, acc);
        o[ct] = acc;
    }
    float rden[4];
#pragma unroll
    for (int r = 0; r < 4; ++r) { const float den = __shfl(o[8][r], fq * 16); rden[r] = 1.0f / fmaxf(fabsf(den), nfl[jrow + r]); }
    float mean[4], rstd[4];
#pragma unroll
    for (int r = 0; r < 4; ++r) {
        float s = 0.f;
#pragma unroll
        for (int ct = 0; ct < 8; ++ct) { o[ct][r] *= rden[r]; s += o[ct][r]; }
        s += __shfl_xor(s, 1); s += __shfl_xor(s, 2); s += __shfl_xor(s, 4); s += __shfl_xor(s, 8);
        mean[r] = s * (1.0f / 128.0f);
        float q = 0.f;
#pragma unroll
        for (int ct = 0; ct < 8; ++ct) { const float d = o[ct][r] - mean[r]; q += d * d; }
        q += __shfl_xor(q, 1); q += __shfl_xor(q, 2); q += __shfl_xor(q, 4); q += __shfl_xor(q, 8);
        rstd[r] = rsqrtf(q * (1.0f / 128.0f) + GN_EPS);
    }
    const bf16* MO = (const bf16*)(p.ws + WS_MO); bf16* YM = (bf16*)((unsigned char*)p.out + DO_YM);
    const float* gain = p.in[4];
#pragma unroll
    for (int ct = 0; ct < 8; ++ct) {
        const int v = h * 128 + ct * 16 + fr; const float g = gain[v];
#pragma unroll
        for (int r = 0; r < 4; ++r) {
            const size_t idx = (tok0 + jrow + r) * 1024 + v;
            const float y = (o[ct][r] - mean[r]) * rstd[r] * g * bf2f(MO[idx]);
            YM[idx] = (bf16)f2bf(y);
        }
        asm volatile("" ::: "memory");
    }
    __syncthreads();
}

struct EpiGate {
    static constexpr bool PERM = true, AFTER_DRAIN = false;
    const bf16* gate; bf16* out; int add;
    __device__ __forceinline__ void operator()(const f32x4 (&acc)[2][2][4][2], const pg8::Unit& u, int wr, int wc, int fr, int fq) const {
        const int row0 = u.pm * 256 + wr * 64 + fr, col0 = u.pn * 256 + wc * 32 + 8 * fq;
#pragma unroll
        for (int ai = 0; ai < 2; ++ai)
#pragma unroll
            for (int m = 0; m < 4; ++m)
#pragma unroll
                for (int bj = 0; bj < 2; ++bj) {
                    const size_t idx = (size_t)(row0 + ai * 128 + m * 16) * 1024 + col0 + bj * 128;
                    const u32x4 gv = *(const u32x4*)(gate + idx);
                    const unsigned gw[4] = {gv.x, gv.y, gv.z, gv.w};
                    const f32x4 v0 = acc[ai][bj][m][0], v1 = acc[ai][bj][m][1];
                    float r[8] = {v0[0], v0[1], v0[2], v0[3], v1[0], v1[1], v1[2], v1[3]};
#pragma unroll
                    for (int i = 0; i < 4; ++i) { r[2 * i] *= __uint_as_float(gw[i] << 16); r[2 * i + 1] *= __uint_as_float(gw[i] & 0xffff0000u); }
                    if (add) {
                        const u32x4 ov = *(const u32x4*)(out + idx); const unsigned ow[4] = {ov.x, ov.y, ov.z, ov.w};
#pragma unroll
                        for (int i = 0; i < 4; ++i) { r[2 * i] += __uint_as_float(ow[i] << 16); r[2 * i + 1] += __uint_as_float(ow[i] & 0xffff0000u); }
                    }
                    u32x4 w; w.x = pk2(r[0], r[1]); w.y = pk2(r[2], r[3]); w.z = pk2(r[4], r[5]); w.w = pk2(r[6], r[7]);
                    *(u32x4*)(out + idx) = w;
                }
    }
};
__device__ __forceinline__ void phase_merge(const Params& p, LAS unsigned char* lds) {
    bf16* merged = (bf16*)(p.ws + WS_MERGED);
    pg8::StaticOrder S; S.init(T, 1024, gridDim.x, (int)blockIdx.x);
    { pg8::Gemm g{(const bf16*)(p.ws + WS_YA), (const bf16*)(p.ws + WS_WBA), T, 1024, 512};
      EpiGate E{(const bf16*)(p.ws + WS_GA), merged, 0};
      pg8::gemm_phase<EpiGate, pg8::StaticOrder, true, true>(lds, g, S, E); }
    __syncthreads();
    { pg8::Gemm g{(const bf16*)((unsigned char*)p.out + DO_YM), (const bf16*)(p.ws + WS_WBM), T, 1024, 1024};
      EpiGate E{(const bf16*)((unsigned char*)p.out + DO_GM), merged, 1};
      pg8::gemm_phase<EpiGate, pg8::StaticOrder, true, true>(lds, g, S, E); }
}

struct EpiOutRes {
    static constexpr bool PERM = false, AFTER_DRAIN = false;
    const float* x; float* out;
    __device__ __forceinline__ void operator()(const f32x4 (&acc)[2][2][4][2], const pg8::Unit& u, int wr, int wc, int fr, int fq) const {
        const int row0 = u.pm * 256 + wr * 64 + fr, col0 = u.pn * 256 + wc * 32 + 4 * fq;
#pragma unroll
        for (int ai = 0; ai < 2; ++ai)
#pragma unroll
            for (int m = 0; m < 4; ++m)
#pragma unroll
                for (int bj = 0; bj < 2; ++bj)
#pragma unroll
                    for (int n = 0; n < 2; ++n) {
                        const size_t idx = (size_t)(row0 + ai * 128 + m * 16) * 1024 + col0 + bj * 128 + n * 16;
                        const f32x4 xv = *(const f32x4*)(x + idx);
                        *(f32x4*)(out + idx) = xv * ALPHA + acc[ai][bj][m][n];
                    }
    }
};
__device__ __forceinline__ void phase_outproj(const Params& p, LAS unsigned char* lds) {
    pg8::Gemm g{(const bf16*)(p.ws + WS_MERGED), (const bf16*)(p.ws + WS_WOUT), T, 1024, 1024};
    pg8::StaticOrder S; S.init(T, 1024, gridDim.x, (int)blockIdx.x);
    EpiOutRes E{p.in[0], p.out};
    pg8::gemm_phase<EpiOutRes, pg8::StaticOrder, true, true>(lds, g, S, E);
}

__device__ __forceinline__ void phase_ln1_route(const Params& p, LAS unsigned char* lds) {
    const int tid = threadIdx.x, lane = tid & 63, wave = tid >> 6;
    LAS int* cnt = (LAS int*)lds;
    LAS int* base = cnt + 16;
    LAS int* info = base + 16;
    LAS float* infw = (LAS float*)(info + 512);
    const float* gain = p.in[8]; const float* bias = p.in[9];
    const float* Wg = p.in[10]; const float* bg = p.in[11]; const float* We = p.in[12]; const float* be = p.in[13];
    unsigned* cursor = (unsigned*)(p.ws + WS_CTL) + CW_CURSOR;
    for (int blk = blockIdx.x; blk < T / 128; blk += gridDim.x) {
        if (tid < 16) cnt[tid] = 0;
        __syncthreads();
        for (int i = 0; i < 16; ++i) {
            const int tl = wave * 16 + i; const size_t tok = (size_t)blk * 128 + tl;
            f32x4* row = (f32x4*)(p.out + tok * 1024) + lane;
            f32x4 v[4]; float s = 0.f;
#pragma unroll
            for (int j = 0; j < 4; ++j) { v[j] = row[64 * j]; s += (v[j].x + v[j].y) + (v[j].z + v[j].w); }
            const float mean = wave_sum(s) * (1.f / 1024.f); float s2 = 0.f;
#pragma unroll
            for (int j = 0; j < 4; ++j) { v[j] = v[j] - mean; s2 += (v[j].x * v[j].x + v[j].y * v[j].y) + (v[j].z * v[j].z + v[j].w * v[j].w); }
            const float rstd = rsqrtf(wave_sum(s2) * (1.f / 1024.f) + LN_EPS);
            float lg[4] = {0.f, 0.f, 0.f, 0.f}, le[16];
#pragma unroll
            for (int k = 0; k < 16; ++k) le[k] = 0.f;
#pragma unroll
            for (int j = 0; j < 4; ++j) {
                const int e0 = (lane + 64 * j) * 4;
                const f32x4 g4 = *(const f32x4*)(gain + e0), b4 = *(const f32x4*)(bias + e0);
                v[j] = v[j] * rstd * g4 + b4;
                row[64 * j] = v[j];
#pragma unroll
                for (int q = 0; q < 4; ++q) {
                    const float xv = v[j][q];
                    const f32x4 wg4 = *(const f32x4*)(Wg + (size_t)(e0 + q) * 4);
                    lg[0] += xv * wg4[0]; lg[1] += xv * wg4[1]; lg[2] += xv * wg4[2]; lg[3] += xv * wg4[3];
#pragma unroll
                    for (int k4 = 0; k4 < 4; ++k4) { const f32x4 we4 = *(const f32x4*)(We + (size_t)(e0 + q) * 16 + k4 * 4);
                        le[k4 * 4 + 0] += xv * we4[0]; le[k4 * 4 + 1] += xv * we4[1]; le[k4 * 4 + 2] += xv * we4[2]; le[k4 * 4 + 3] += xv * we4[3]; }
                }
            }
#pragma unroll
            for (int k = 0; k < 4; ++k) lg[k] = wave_sum(lg[k]) + bg[k];
#pragma unroll
            for (int k = 0; k < 16; ++k) le[k] = wave_sum(le[k]) + be[k];
            int gs = 0; float gm = lg[0];
#pragma unroll
            for (int k = 1; k < 4; ++k) if (lg[k] > gm) { gm = lg[k]; gs = k; }
            float gsum = 0.f;
#pragma unroll
            for (int k = 0; k < 4; ++k) gsum += __expf(lg[k] - gm);
            const float gw = 1.0f / gsum;
            float el[4];
#pragma unroll
            for (int k = 0; k < 4; ++k) el[k] = gs == 0 ? le[k] : gs == 1 ? le[4 + k] : gs == 2 ? le[8 + k] : le[12 + k];
            int i0 = 0; float v0 = el[0];
#pragma unroll
            for (int k = 1; k < 4; ++k) if (el[k] > v0) { v0 = el[k]; i0 = k; }
            int i1 = -1; float v1 = -INFINITY;
#pragma unroll
            for (int k = 0; k < 4; ++k) if (k != i0 && el[k] > v1) { v1 = el[k]; i1 = k; }
            const float p1 = __expf(v1 - v0); const float w0 = gw / (1.f + p1), w1 = gw * p1 / (1.f + p1);
            if (lane == 0) {
                const int e0 = gs * 4 + i0, e1 = gs * 4 + i1;
                const int r0 = atomicAdd((int*)&cnt[e0], 1), r1 = atomicAdd((int*)&cnt[e1], 1);
                info[tl * 4 + 0] = e0; info[tl * 4 + 1] = r0; info[tl * 4 + 2] = e1; info[tl * 4 + 3] = r1;
                infw[tl * 2 + 0] = w0; infw[tl * 2 + 1] = w1;
            }
        }
        __syncthreads();
        if (tid < 16) base[tid] = (int)atomicAdd(&cursor[tid], (unsigned)cnt[tid]);
        __syncthreads();
        if (tid < 128) {
            const size_t tok = (size_t)blk * 128 + tid;
            int* te = (int*)(p.ws + WS_TE) + tok * 4; float* tw = (float*)(p.ws + WS_TW) + tok * 2;
            const int e0 = info[tid * 4 + 0], e1 = info[tid * 4 + 2];
            te[0] = e0; te[1] = base[e0] + info[tid * 4 + 1]; te[2] = e1; te[3] = base[e1] + info[tid * 4 + 3];
            tw[0] = infw[tid * 2 + 0]; tw[1] = infw[tid * 2 + 1];
        }
        __syncthreads();
    }
}

struct Segs {
    int st[17];
    __device__ __forceinline__ void init(const unsigned* cursor) {
        int a = 0;
#pragma unroll
        for (int e = 0; e < 16; ++e) { st[e] = a; a += ((int)cursor[e] + 255) & ~255; }
        st[16] = a;
    }
    __device__ __forceinline__ int start(int e) const {
        int r = 0;
#pragma unroll
        for (int k = 0; k < 16; ++k) r = (k == e) ? st[k] : r;
        return r;
    }
};

__device__ __forceinline__ void phase_gather(const Params& p) {
    const int tid = threadIdx.x, lane = tid & 63, wave = tid >> 6;
    Segs sg; sg.init((const unsigned*)(p.ws + WS_CTL) + CW_CURSOR);
    bf16* XS = (bf16*)(p.ws + WS_XS);
    for (int tok = blockIdx.x * 8 + wave; tok < T; tok += gridDim.x * 8) {
        const int* te = (const int*)(p.ws + WS_TE) + (size_t)tok * 4;
        const int g0 = sg.start(te[0]) + te[1], g1 = sg.start(te[2]) + te[3];
        if (lane == 0) { int* pos = (int*)(p.ws + WS_POS) + (size_t)tok * 2; pos[0] = g0; pos[1] = g1; }
        const f32x4* xr = (const f32x4*)(p.out + (size_t)tok * 1024) + lane;
        unsigned long long* o0 = (unsigned long long*)(XS + (size_t)g0 * 1024) + lane;
        unsigned long long* o1 = (unsigned long long*)(XS + (size_t)g1 * 1024) + lane;
#pragma unroll
        for (int j = 0; j < 4; ++j) { const f32x4 v = xr[64 * j]; const unsigned long long w = (unsigned long long)pk2(v.x, v.y) | ((unsigned long long)pk2(v.z, v.w) << 32); o0[64 * j] = w; o1[64 * j] = w; }
    }
}

struct MoeOrder {
    Segs sg; int ntiles, G, c;
    __device__ __forceinline__ void init(const unsigned* cursor, int G_, int c_) { sg.init(cursor); ntiles = sg.st[16] >> 8; G = G_; c = c_; }
    __device__ __forceinline__ bool next(int i, pg8::Unit& u) const {
        const int L = i * G + c; if (L >= ntiles * 4) return false;
        const int pm = L >> 2, j = L & 3; int e = 0;
#pragma unroll
        for (int k = 1; k < 16; ++k) e += (sg.st[k] <= pm * 256) ? 1 : 0;
        u.pm = pm; u.pn = e * 4 + j; return true;
    }
    __device__ __forceinline__ void a_ready(const pg8::Unit&) const {}
    __device__ __forceinline__ void done(const pg8::Unit&) const {}
};
struct EpiSwiGLU {
    static constexpr bool PERM = true, AFTER_DRAIN = false;
    bf16* H;
    __device__ __forceinline__ void operator()(const f32x4 (&acc)[2][2][4][2], const pg8::Unit& u, int wr, int wc, int fr, int fq) const {
        const int row0 = u.pm * 256 + wr * 64 + fr, col0 = (u.pn & 3) * 128 + wc * 32 + 8 * fq;
#pragma unroll
        for (int ai = 0; ai < 2; ++ai)
#pragma unroll
            for (int m = 0; m < 4; ++m) {
                const f32x4 g0 = acc[ai][0][m][0], g1 = acc[ai][0][m][1], u0 = acc[ai][1][m][0], u1 = acc[ai][1][m][1];
                u32x4 w;
                w.x = pk2(siluf_(g0[0]) * u0[0], siluf_(g0[1]) * u0[1]); w.y = pk2(siluf_(g0[2]) * u0[2], siluf_(g0[3]) * u0[3]);
                w.z = pk2(siluf_(g1[0]) * u1[0], siluf_(g1[1]) * u1[1]); w.w = pk2(siluf_(g1[2]) * u1[2], siluf_(g1[3]) * u1[3]);
                *(u32x4*)(H + (size_t)(row0 + ai * 128 + m * 16) * 512 + col0) = w;
            }
    }
};
struct EpiPlain {
    static constexpr bool PERM = true, AFTER_DRAIN = false;
    bf16* Y;
    __device__ __forceinline__ void operator()(const f32x4 (&acc)[2][2][4][2], const pg8::Unit& u, int wr, int wc, int fr, int fq) const {
        const int row0 = u.pm * 256 + wr * 64 + fr, col0 = (u.pn & 3) * 256 + wc * 32 + 8 * fq;
#pragma unroll
        for (int ai = 0; ai < 2; ++ai)
#pragma unroll
            for (int m = 0; m < 4; ++m)
#pragma unroll
                for (int bj = 0; bj < 2; ++bj) {
                    const f32x4 v0 = acc[ai][bj][m][0], v1 = acc[ai][bj][m][1];
                    u32x4 w; w.x = pk2(v0[0], v0[1]); w.y = pk2(v0[2], v0[3]); w.z = pk2(v1[0], v1[1]); w.w = pk2(v1[2], v1[3]);
                    *(u32x4*)(Y + (size_t)(row0 + ai * 128 + m * 16) * 1024 + col0 + bj * 128) = w;
                }
    }
};
__device__ __forceinline__ void phase_moe_up(const Params& p, LAS unsigned char* lds) {
    pg8::Gemm g{(const bf16*)(p.ws + WS_XS), (const bf16*)(p.ws + WS_WGU), MOE_MAXROWS, 16 * 1024, 1024};
    MoeOrder S; S.init((const unsigned*)(p.ws + WS_CTL) + CW_CURSOR, gridDim.x, (int)blockIdx.x);
    EpiSwiGLU E{(bf16*)(p.ws + WS_H)};
    pg8::gemm_phase<EpiSwiGLU, MoeOrder, true, true>(lds, g, S, E);
}
__device__ __forceinline__ void phase_moe_down(const Params& p, LAS unsigned char* lds) {
    pg8::Gemm g{(const bf16*)(p.ws + WS_H), (const bf16*)(p.ws + WS_WD), MOE_MAXROWS, 16 * 1024, 512};
    MoeOrder S; S.init((const unsigned*)(p.ws + WS_CTL) + CW_CURSOR, gridDim.x, (int)blockIdx.x);
    EpiPlain E{(bf16*)(p.ws + WS_Y)};
    pg8::gemm_phase<EpiPlain, MoeOrder, true, true>(lds, g, S, E);
}

__device__ __forceinline__ void phase_final(const Params& p) {
    const int tid = threadIdx.x, lane = tid & 63, wave = tid >> 6;
    const float* gain = p.in[17]; const float* bias = p.in[18];
    const bf16* Y = (const bf16*)(p.ws + WS_Y);
    for (int tok = blockIdx.x * 8 + wave; tok < T; tok += gridDim.x * 8) {
        const int* pos = (const int*)(p.ws + WS_POS) + (size_t)tok * 2; const float* tw = (const float*)(p.ws + WS_TW) + (size_t)tok * 2;
        const int g0 = pos[0], g1 = pos[1]; const float w0 = tw[0], w1 = tw[1];
        f32x4* row = (f32x4*)(p.out + (size_t)tok * 1024) + lane;
        const unsigned long long* y0 = (const unsigned long long*)(Y + (size_t)g0 * 1024) + lane;
        const unsigned long long* y1 = (const unsigned long long*)(Y + (size_t)g1 * 1024) + lane;
        f32x4 v[4]; float s = 0.f;
#pragma unroll
        for (int j = 0; j < 4; ++j) {
            const f32x4 xv = row[64 * j]; const unsigned long long a = y0[64 * j], bq = y1[64 * j];
            const unsigned a0 = (unsigned)a, a1 = (unsigned)(a >> 32), b0 = (unsigned)bq, b1 = (unsigned)(bq >> 32);
            f32x4 mo;
            mo.x = w0 * __uint_as_float(a0 << 16) + w1 * __uint_as_float(b0 << 16);
            mo.y = w0 * __uint_as_float(a0 & 0xffff0000u) + w1 * __uint_as_float(b0 & 0xffff0000u);
            mo.z = w0 * __uint_as_float(a1 << 16) + w1 * __uint_as_float(b1 << 16);
            mo.w = w0 * __uint_as_float(a1 & 0xffff0000u) + w1 * __uint_as_float(b1 & 0xffff0000u);
            v[j] = xv * ALPHA + mo; s += (v[j].x + v[j].y) + (v[j].z + v[j].w);
        }
        const float mean = wave_sum(s) * (1.f / 1024.f); float s2 = 0.f;
#pragma unroll
        for (int j = 0; j < 4; ++j) { v[j] = v[j] - mean; s2 += (v[j].x * v[j].x + v[j].y * v[j].y) + (v[j].z * v[j].z + v[j].w * v[j].w); }
        const float rstd = rsqrtf(wave_sum(s2) * (1.f / 1024.f) + LN_EPS);
#pragma unroll
        for (int j = 0; j < 4; ++j) { const int e0 = (lane + 64 * j) * 4; row[64 * j] = v[j] * rstd * (*(const f32x4*)(gain + e0)) + (*(const f32x4*)(bias + e0)); }
    }
}

constexpr int LDS_BYTES = 147456;
template <int PH>
__global__ void __launch_bounds__(512, 2) k_phase(Params p) {
    extern __shared__ __attribute__((aligned(16))) unsigned char lds_raw[];
    LAS unsigned char* lds = (LAS unsigned char*)lds_raw;
    if (PH == 0) phase_prologue(p, lds);
    if (PH == 1) phase_inproj(p, lds);
    if (PH == 2) { for (int u = blockIdx.x; u < NUNIT_M; u += gridDim.x) mlstm_kv_unit(p, lds, u); }
    if (PH == 3) mlstm_scan(p);
    if (PH == 4) { for (int u = blockIdx.x; u < NUNIT_M; u += gridDim.x) mlstm_out_unit(p, lds, u); }
    if (PH == 5) { phase_expert_weights(p, lds); __syncthreads(); phase_merge(p, lds); }
    if (PH == 6) phase_outproj(p, lds);
    if (PH == 7) phase_ln1_route(p, lds);
    if (PH == 8) phase_gather(p);
    if (PH == 9) phase_moe_up(p, lds);
    if (PH == 10) phase_moe_down(p, lds);
    if (PH == 11) phase_final(p);
}

template <int PH> static void launch_phase(const Params& p, int grid, hipStream_t stream) {
    static bool attr = false;
    if (!attr) { (void)hipFuncSetAttribute((const void*)k_phase<PH>, hipFuncAttributeMaxDynamicSharedMemorySize, LDS_BYTES); attr = true; }
    hipLaunchKernelGGL(k_phase<PH>, dim3(grid), dim3(512), LDS_BYTES, stream, p);
}

extern "C" void kernel_launch(void* const* d_in, const int* in_sizes, int n_in, void* d_out, int out_size, void* d_ws, size_t ws_size, hipStream_t stream) {
    if (n_in != 19 || out_size != T * DM || ws_size < WS_END) { fprintf(stderr, "kernel_launch: unexpected shapes (n_in %d out %d ws %zu)\n", n_in, out_size, ws_size); return; }
    Params p{};
    for (int i = 0; i < 19; ++i) p.in[i] = (const float*)d_in[i];
    p.out = (float*)d_out; p.ws = (unsigned char*)d_ws;
    (void)hipMemsetAsync((char*)d_ws + WS_CTL, 0, 4096, stream);
    static bool attr = false;
    if (!attr) { (void)hipFuncSetAttribute((const void*)k_attn_simple, hipFuncAttributeMaxDynamicSharedMemorySize, 4 * 32768 + 4096); attr = true; }
    const int G = 256;
    launch_phase<0>(p, G, stream);
    launch_phase<1>(p, G, stream);
    hipLaunchKernelGGL(k_attn_simple, dim3(2048), dim3(256), 4 * 32768 + 4096, stream, p);
    launch_phase<2>(p, G, stream);
    launch_phase<3>(p, G, stream);
    launch_phase<4>(p, G, stream);
    launch_phase<5>(p, G, stream);
    launch_phase<6>(p, G, stream);
    launch_phase<7>(p, G, stream);
    launch_phase<8>(p, G, stream);
    launch_phase<9>(p, G, stream);
    launch_phase<10>(p, G, stream);
    launch_phase<11>(p, G, stream);
}
```

```cpp
#include <hip/hip_runtime.h>
#include <cstdio>
#include <cstdint>
#include <cmath>
#define FAST_ATTN 1
#define IDX_OLD_P2 1
#define IDX_NOCLAMP 1
#define LN1_PF 1
#define IDX_KPF 1
#define MOU_UNROLL 4
namespace pg8 {
#define PG8_LAS __attribute__((address_space(3)))
typedef unsigned short bf16_t;
typedef short bf16x8 __attribute__((ext_vector_type(8)));
typedef float f32x4 __attribute__((ext_vector_type(4)));
typedef unsigned u32x4 __attribute__((ext_vector_type(4)));
constexpr int BM = 256, BK = 64, HALF = 128, HTB = HALF * BK * 2  , STAGE_BYTES = 8 * HTB, NXCD = 8, WGM = 8;

__host__ __device__ __forceinline__ int lds_byte(int r, int c) { const int st = (r >> 4) * 2 + (c >> 5), rr = r & 15, cc = c & 31, ob = rr * 64 + cc * 2; return st * 1024 + (ob ^ (((ob >> 9) & 1) << 5)); }
__host__ __device__ __forceinline__ void stage_rc(int b, int& R, int& C) { const int st = b / 1024, sb = b % 1024, swz = sb ^ (((sb >> 9) & 1) << 5); R = (st >> 1) * 16 + swz / 64; C = (st & 1) * 32 + (swz % 64) / 2; }
__host__ __device__ __forceinline__ int perm32(int rho) { const int n = rho >> 4, i = rho & 15; return 8 * (i >> 2) + 4 * n + (i & 3); }

struct Unit { int pm, pn; };
struct Gemm { const bf16_t* A; const bf16_t* Bt; int M, N, K; };

struct StaticOrder {
    int nM, nN, nwg, G, c;
    __host__ __device__ void init(int M, int N, int G_, int c_) { nM = M / BM; nN = N / BM; nwg = nM * nN; G = G_; c = c_; }
    __host__ __device__ bool next(int i, Unit& u) const {
        const long L = (long)i * G + c; if (L >= nwg) return false;
        int wgid = (int)L; { const int q = nwg / NXCD, r = nwg % NXCD, xcd = wgid % NXCD, off = wgid / NXCD; wgid = (xcd < r ? xcd * (q + 1) : r * (q + 1) + (xcd - r) * q) + off; }
        const int nig = WGM * nN, gid = wgid / nig, fm = gid * WGM, gsz = (nM - fm) < WGM ? (nM - fm) : WGM;
        u.pm = fm + ((wgid % nig) % gsz); u.pn = (wgid % nig) / gsz; return true;
    }
    __device__ __forceinline__ void a_ready(const Unit&) const {}
    __device__ __forceinline__ void done(const Unit&) const {}
};

__device__ __forceinline__ unsigned cvt_pk_bf16(float lo, float hi) { unsigned r; asm volatile("v_cvt_pk_bf16_f32 %0, %1, %2" : "=v"(r) : "v"(lo), "v"(hi)); return r; }
typedef float f32x2 __attribute__((ext_vector_type(2)));
template <class Epi, class Sched, bool ALIGN_EPI = false, bool SP2 = false, bool GATHER = false>
__device__ __forceinline__ void gemm_phase(PG8_LAS unsigned char* lds, const Gemm g, const Sched& S, const Epi& E, const PG8_LAS int* tokL = nullptr) {
    int tid_ = threadIdx.x; asm volatile("" : "+v"(tid_));
    const int tid = tid_, wid = __builtin_amdgcn_readfirstlane(tid >> 6), lane = tid & 63, wr = wid >> 2, wc = wid & 3, fr = lane & 15, fq = lane >> 4;
    const int K = g.K, nt = K / BK;
    unsigned voffA[2], voffB[2]; int stR[2], stC[2];
#pragma unroll
    for (int i = 0; i < 2; ++i) { int R, C; stage_rc(tid * 16 + i * 8192, R, C); const int Rb = Epi::PERM ? ((R & ~31) + perm32(R & 31)) : R; stR[i] = R; stC[i] = C;
        voffA[i] = (unsigned)(R * K + C) * 2u; voffB[i] = (unsigned)(Rb * K + C) * 2u; }
    unsigned gaC[2][2], gaN[2][2];
#define PG8_GOFF(dst, un) do { _Pragma("unroll") for (int h_ = 0; h_ < 2; ++h_) _Pragma("unroll") for (int i_ = 0; i_ < 2; ++i_) \
        dst[h_][i_] = (unsigned)tokL[(un) * 256 + h_ * HALF + stR[i_]] * (unsigned)(K * 2) + (unsigned)stC[i_] * 2u; } while (0)
#define PG8_STAGEA(bufoff, kbase, h, NEXT) do { if constexpr (GATHER) { const unsigned vo_[2] = {(NEXT) ? gaN[h][0] : gaC[h][0], (NEXT) ? gaN[h][1] : gaC[h][1]}; PG8_STAGE(bufoff, kbase, vo_); } \
        else { PG8_STAGE(bufoff, (kbase) + (h) * hstep, voffA); } } while (0)
    const size_t kstep = (size_t)(BK * 2);
    const size_t hstep = (size_t)HALF * K * 2;
    const size_t tstep = 2 * hstep;
    const unsigned ldsw = (unsigned)wid * 1024u;
    const int aoff = lds_byte(wr * 64 + fr, fq * 8), boff = lds_byte(wc * 32 + fr, fq * 8);
#define PG8_SA(b, h) (((b) * 2 + (h)) * HTB)
#define PG8_SB(b, h) ((4 + (b) * 2 + (h)) * HTB)
#define PG8_STAGE(bufoff, gbase, voff) do { _Pragma("unroll") for (int _i = 0; _i < 2; ++_i) \
        __builtin_amdgcn_global_load_lds((const unsigned*)((const char*)(gbase) + (voff)[_i]), (PG8_LAS unsigned*)(lds + (bufoff) + ldsw + _i * 8192), 16, 0, 0); } while (0)
#define PG8_LDA(dst, b, h) do { _Pragma("unroll") for (int m = 0; m < 4; ++m) _Pragma("unroll") for (int k = 0; k < 2; ++k) dst[m][k] = *(const PG8_LAS bf16x8*)(lds + PG8_SA(b, h) + aoff + m * 2048 + k * 1024); } while (0)
#define PG8_LDB(dst, b, h) do { _Pragma("unroll") for (int n = 0; n < 2; ++n) _Pragma("unroll") for (int k = 0; k < 2; ++k) dst[n][k] = *(const PG8_LAS bf16x8*)(lds + PG8_SB(b, h) + boff + n * 2048 + k * 1024); } while (0)
#define PG8_MMA(ai, bj, At, Bt) do { __builtin_amdgcn_s_setprio(1); _Pragma("unroll") for (int m = 0; m < 4; ++m) _Pragma("unroll") for (int n = 0; n < 2; ++n) _Pragma("unroll") for (int k = 0; k < 2; ++k) \
        acc[ai][bj][m][n] = __builtin_amdgcn_mfma_f32_16x16x32_bf16(Bt[n][k], At[m][k], acc[ai][bj][m][n], 0, 0, 0); __builtin_amdgcn_s_setprio(0); } while (0)
#define PG8_WAIT_V(n) asm volatile("s_waitcnt vmcnt(" #n ")" ::: "memory")
#define PG8_WAIT_L(n) asm volatile("s_waitcnt lgkmcnt(" #n ")" ::: "memory")
#define PG8_BAR __builtin_amdgcn_s_barrier()
#define PG8_SCHED __builtin_amdgcn_sched_barrier(0)
    Unit cur, nxt; int ui = 0;
    if (!S.next(0, cur)) return;
    f32x4 acc[2][2][4][2];
#pragma unroll
    for (int a = 0; a < 2; ++a)
#pragma unroll
        for (int b = 0; b < 2; ++b)
#pragma unroll
            for (int m = 0; m < 4; ++m)
#pragma unroll
                for (int n = 0; n < 2; ++n) acc[a][b][m][n] = (f32x4){0.f, 0.f, 0.f, 0.f};
    bf16x8 At[4][2], B0[2][2], B1[2][2];
    const char* cA = (const char*)g.A + (GATHER ? (size_t)0 : (size_t)cur.pm * tstep); const char* cB = (const char*)g.Bt + (size_t)cur.pn * tstep;
    if constexpr (GATHER) { PG8_GOFF(gaC, 0); }
    S.a_ready(cur);
    if constexpr (SP2) {
        PG8_STAGE(PG8_SB(0, 0), cB, voffB); PG8_STAGE(PG8_SB(0, 1), cB + hstep, voffB); PG8_STAGEA(PG8_SA(0, 0), cA, 0, false); PG8_STAGEA(PG8_SA(0, 1), cA, 1, false);
        if (wr == 1) PG8_BAR;
        PG8_WAIT_V(2); PG8_BAR;
        PG8_STAGE(PG8_SB(1, 0), cB + kstep, voffB); PG8_STAGEA(PG8_SA(1, 0), cA + kstep, 0, false); PG8_STAGE(PG8_SB(1, 1), cB + hstep + kstep, voffB);
        PG8_WAIT_V(6); PG8_BAR;
    } else {
        PG8_STAGE(PG8_SB(0, 0), cB, voffB); PG8_STAGEA(PG8_SA(0, 0), cA, 0, false); PG8_STAGE(PG8_SB(0, 1), cB + hstep, voffB); PG8_STAGEA(PG8_SA(0, 1), cA, 1, false);
        if (wr == 1) PG8_BAR;
        PG8_WAIT_V(4); PG8_BAR;
        PG8_STAGE(PG8_SB(1, 0), cB + kstep, voffB); PG8_STAGEA(PG8_SA(1, 0), cA + kstep, 0, false); PG8_STAGE(PG8_SB(1, 1), cB + hstep + kstep, voffB);
        PG8_WAIT_V(6); PG8_BAR;
    }
    for (;;) {
        const bool has_next = S.next(ui + 1, nxt);
        const char* nA = (has_next && !GATHER) ? (const char*)g.A + (size_t)nxt.pm * tstep : cA; const char* nB = has_next ? (const char*)g.Bt + (size_t)nxt.pn * tstep : cB;
        if constexpr (GATHER) { if (has_next) { PG8_GOFF(gaN, ui + 1); } else { _Pragma("unroll") for (int h_ = 0; h_ < 2; ++h_) _Pragma("unroll") for (int i_ = 0; i_ < 2; ++i_) gaN[h_][i_] = gaC[h_][i_]; } }
        for (int t = 0; t < nt; t += 2) {
            const bool last = (t == nt - 2);
            const char* a1 = cA + (size_t)(t + 1) * kstep;
            const char* a2 = last ? nA : cA + (size_t)(t + 2) * kstep; const char* b2 = last ? nB : cB + (size_t)(t + 2) * kstep;
            const char* a3 = a2 + kstep; const char* b3 = b2 + kstep;
            if (last && has_next) S.a_ready(nxt);
            if constexpr (SP2) {
            PG8_LDB(B0, 0, 0); PG8_LDB(B1, 0, 1); PG8_SCHED; PG8_LDA(At, 0, 0); PG8_STAGEA(PG8_SA(1, 1), a1, 1, false);
            PG8_WAIT_V(8); PG8_WAIT_L(0); PG8_BAR; PG8_MMA(0, 0, At, B0); PG8_MMA(0, 1, At, B1); PG8_BAR; PG8_SCHED;
            PG8_LDA(At, 0, 1); PG8_STAGE(PG8_SB(0, 0), b2, voffB); PG8_STAGE(PG8_SB(0, 1), b2 + hstep, voffB); PG8_STAGEA(PG8_SA(0, 0), a2, 0, last);
            PG8_WAIT_V(8); PG8_WAIT_L(0); PG8_BAR; PG8_MMA(1, 0, At, B0); PG8_MMA(1, 1, At, B1); PG8_BAR; PG8_SCHED;
            PG8_LDB(B0, 1, 0); PG8_LDB(B1, 1, 1); PG8_SCHED; PG8_LDA(At, 1, 0); PG8_STAGEA(PG8_SA(0, 1), a2, 1, last);
            PG8_WAIT_V(8); PG8_WAIT_L(0); PG8_BAR; PG8_MMA(0, 0, At, B0); PG8_MMA(0, 1, At, B1); PG8_BAR; PG8_SCHED;
            PG8_LDA(At, 1, 1); PG8_STAGE(PG8_SB(1, 0), b3, voffB); PG8_STAGE(PG8_SB(1, 1), b3 + hstep, voffB); PG8_STAGEA(PG8_SA(1, 0), a3, 0, last);
            PG8_WAIT_V(8); PG8_WAIT_L(0); PG8_BAR; PG8_MMA(1, 0, At, B0); PG8_MMA(1, 1, At, B1); PG8_BAR; PG8_SCHED;
            } else {
            PG8_LDB(B0, 0, 0); PG8_SCHED; PG8_LDA(At, 0, 0); PG8_STAGEA(PG8_SA(1, 1), a1, 1, false);
            PG8_WAIT_L(8); PG8_BAR; PG8_WAIT_L(0); PG8_MMA(0, 0, At, B0); PG8_BAR; PG8_SCHED;
            PG8_LDB(B1, 0, 1); PG8_STAGE(PG8_SB(0, 0), b2, voffB);
            PG8_BAR; PG8_WAIT_L(0); PG8_MMA(0, 1, At, B1); PG8_BAR;
            PG8_LDA(At, 0, 1); PG8_STAGEA(PG8_SA(0, 0), a2, 0, last);
            PG8_BAR; PG8_WAIT_L(0); PG8_MMA(1, 0, At, B0); PG8_BAR; PG8_SCHED;
            PG8_STAGE(PG8_SB(0, 1), b2 + hstep, voffB);
            PG8_WAIT_V(6); PG8_BAR; PG8_MMA(1, 1, At, B1); PG8_BAR;
            PG8_LDB(B0, 1, 0); PG8_SCHED; PG8_LDA(At, 1, 0); PG8_STAGEA(PG8_SA(0, 1), a2, 1, last);
            PG8_WAIT_L(8); PG8_BAR; PG8_WAIT_L(0); PG8_MMA(0, 0, At, B0); PG8_BAR; PG8_SCHED;
            PG8_LDB(B1, 1, 1); PG8_STAGE(PG8_SB(1, 0), b3, voffB);
            PG8_BAR; PG8_WAIT_L(0); PG8_MMA(0, 1, At, B1); PG8_BAR;
            PG8_LDA(At, 1, 1); PG8_STAGEA(PG8_SA(1, 0), a3, 0, last);
            PG8_BAR; PG8_WAIT_L(0); PG8_MMA(1, 0, At, B0); PG8_BAR; PG8_SCHED;
            PG8_STAGE(PG8_SB(1, 1), b3 + hstep, voffB);
            PG8_WAIT_V(6); PG8_BAR; PG8_MMA(1, 1, At, B1); PG8_BAR;
            }
        }
        if constexpr (ALIGN_EPI) { if (wr == 0) PG8_BAR; }
        if constexpr (!Epi::AFTER_DRAIN) { E(acc, cur, wr, wc, fr, fq); S.done(cur); }
        if (!has_next) break;
#pragma unroll
        for (int a = 0; a < 2; ++a)
#pragma unroll
            for (int b = 0; b < 2; ++b)
#pragma unroll
                for (int m = 0; m < 4; ++m)
#pragma unroll
                    for (int n = 0; n < 2; ++n) acc[a][b][m][n] = (f32x4){0.f, 0.f, 0.f, 0.f};
        cur = nxt; cA = nA; cB = nB; ++ui;
        if constexpr (GATHER) { _Pragma("unroll") for (int h_ = 0; h_ < 2; ++h_) _Pragma("unroll") for (int i_ = 0; i_ < 2; ++i_) gaC[h_][i_] = gaN[h_][i_]; }
        if constexpr (ALIGN_EPI) { if (wr == 1) PG8_BAR; }
    }
    PG8_WAIT_V(0);
    if constexpr (!ALIGN_EPI) { if (wr == 0) PG8_BAR; }
    PG8_BAR;
    if constexpr (Epi::AFTER_DRAIN) { E.fused(acc, cur, wr, wc, fr, fq, lds, wid, lane); S.done(cur); }
#undef PG8_SA
#undef PG8_SB
#undef PG8_STAGE
#undef PG8_STAGEA
#undef PG8_GOFF
#undef PG8_LDA
#undef PG8_LDB
#undef PG8_MMA
#undef PG8_WAIT_V
#undef PG8_WAIT_L
#undef PG8_BAR
#undef PG8_SCHED
}
}

#define GAS __attribute__((address_space(1)))
#define LAS __attribute__((address_space(3)))
typedef unsigned short bf16;
typedef float f32x4 __attribute__((ext_vector_type(4)));
typedef float f32x2 __attribute__((ext_vector_type(2)));
typedef short bf16x8 __attribute__((ext_vector_type(8)));
typedef unsigned u32x4 __attribute__((ext_vector_type(4)));
typedef unsigned u32x2 __attribute__((ext_vector_type(2)));

constexpr int NB = 4, SEQ = 8192, T = NB * SEQ, DM = 1024;
constexpr int NW_IN = 7168;
constexpr int NCHUNK = 64, NUNIT_M = NB * 8 * NCHUNK;
constexpr float ALPHA = 1.189207115002721f;
constexpr float QSCALE2 = 0.125f * 1.4426950408889634f;
constexpr float LN_EPS = 1e-5f, GN_EPS = 1e-6f;
#ifdef IDX_NOCLAMP
constexpr float IDX_QSCALE = 1.0f, IDX_WSCALE = 1.0f;
#else
constexpr float IDX_QSCALE = 9.313225746154785e-10f, IDX_WSCALE = 1073741824.0f;
#endif
constexpr int MOE_MAXROWS = 65536 + 16 * 256;

constexpr size_t MiB = 1u << 20;
constexpr size_t WS_CTL = 0;
constexpr size_t WS_WIN = 1 * MiB;
constexpr size_t WS_WBA = 15 * MiB;
constexpr size_t WS_WBM = 16 * MiB;
constexpr size_t WS_WOUT = 18 * MiB;
constexpr size_t WS_COS = 20 * MiB, WS_SIN = 21 * MiB;
constexpr size_t WS_BIAS = 22 * MiB;
constexpr size_t WS_TE = 22 * MiB + 64 * 1024;
constexpr size_t WS_TW = WS_TE + (size_t)T * 16;
constexpr size_t WS_POS = WS_TW + (size_t)T * 8;
constexpr size_t WS_CST = 24 * MiB;
constexpr size_t WS_DSC = 60 * MiB;
constexpr size_t WS_MC = 60 * MiB + 64 * 1024;
constexpr size_t WS_DN = 61 * MiB;
constexpr size_t WS_WGU = 24 * MiB;
constexpr size_t WS_WD = 56 * MiB;
constexpr size_t WS_AQ = 72 * MiB, WS_AK = 104 * MiB, WS_AV = 136 * MiB;
constexpr size_t WS_IQ = 168 * MiB;
constexpr size_t WS_IK = 184 * MiB;
constexpr size_t WS_IW = 188 * MiB;
constexpr size_t WS_MI = 189 * MiB, WS_MF = 190 * MiB;
constexpr size_t WS_MQ = 192 * MiB, WS_MK = 224 * MiB;
constexpr size_t WS_MV = 256 * MiB;
constexpr size_t WS_MO = 320 * MiB;
constexpr size_t WS_GA = 384 * MiB;
constexpr size_t WS_MASK = 448 * MiB;
constexpr size_t WS_YA = 480 * MiB;
constexpr size_t WS_MERGED = 192 * MiB;
constexpr size_t WS_X1B = 72 * MiB;
constexpr size_t WS_INV = 136 * MiB;
constexpr size_t WS_H = 208 * MiB;
constexpr size_t WS_Y = 276 * MiB;
constexpr size_t WS_END = 512 * MiB;
constexpr size_t DO_XN = 0;
constexpr size_t DO_GM = 64 * MiB;
constexpr size_t DO_DC = 0;
constexpr size_t DO_YM = 0;
constexpr int CW_CURSOR = 64;
constexpr int CW_MISMATCH = 96;

struct Params { const float* in[19]; float* out; unsigned char* ws; };

__device__ __forceinline__ float bf2f(unsigned h) { return __uint_as_float(h << 16); }
typedef float f32x2_t_ __attribute__((ext_vector_type(2))); typedef __bf16 bf16x2_t_ __attribute__((ext_vector_type(2)));
__device__ __forceinline__ unsigned pk2(float lo, float hi) { const f32x2_t_ v = {lo, hi}; const bf16x2_t_ b = __builtin_convertvector(v, bf16x2_t_); return __builtin_bit_cast(unsigned, b); }
__device__ __forceinline__ unsigned f2bf(float f) { return pk2(f, 0.f) & 0xffffu; }
__device__ __forceinline__ float rcpf_(float x) { return __builtin_amdgcn_rcpf(x); }
__device__ __forceinline__ float sigmoidf_(float x) { return __builtin_amdgcn_rcpf(1.0f + __builtin_amdgcn_exp2f(-1.4426950408889634f * x)); }
__device__ __forceinline__ float siluf_(float x) { return x * __builtin_amdgcn_rcpf(1.0f + __builtin_amdgcn_exp2f(-1.4426950408889634f * x)); }
__device__ __forceinline__ float logsigmoidf_(float x) { return fminf(x, 0.f) - log1pf(__expf(-fabsf(x))); }
__device__ __forceinline__ float wave_sum(float v) {
#pragma unroll
    for (int o = 1; o < 64; o <<= 1) v += __shfl_xor(v, o);
    return v;
}
__device__ __forceinline__ float wave_max(float v) {
#pragma unroll
    for (int o = 1; o < 64; o <<= 1) v = fmaxf(v, __shfl_xor(v, o));
    return v;
}
__host__ __device__ __forceinline__ int ropeil(int d) { return d < 32 ? 2 * d : 2 * (d - 32) + 1; }
__host__ __device__ __forceinline__ int win_newcol(int c) {
    if (c < 1024) return (c & ~63) + ropeil(c & 63);
    if (c < 1536) return c;
    if (c < 1792) return (c & ~63) + ropeil(c & 63);
    if (c < 1856) return 1792 + ropeil(c - 1792);
    if (c < 1860) return 1792 + 64 + (c - 1856);
    if (c < 2372) return 2048 + (c - 1860);
    if (c < 2884) return 2560 + (c - 2372);
    if (c < 3908) return 3072 + (c - 2884);
    if (c < 3916) return 1792 + 72 + (c - 3908);
    if (c < 3924) return 1792 + 80 + (c - 3916);
    if (c < 4948) return 4096 + (c - 3924);
    if (c < 5972) return 5120 + (c - 4948);
    return 6144 + (c - 5972);
}
typedef GAS unsigned gu32;
typedef GAS unsigned long long gu64;
#define RLX_AGENT __ATOMIC_RELAXED, __HIP_MEMORY_SCOPE_AGENT
#define LDS_WAIT() asm volatile("s_waitcnt lgkmcnt(0)" ::: "memory")
#define VM_WAIT() asm volatile("s_waitcnt vmcnt(0)" ::: "memory")
__device__ __forceinline__ unsigned long long rt() { return __builtin_amdgcn_s_memrealtime(); }
#define XB_TMO      128
#define XB_XCNT(j)  (256  + 64 * (j))
#define XB_XSUB(j)  (1280 + 64 * (j))
#define XB_XGEN(j)  (2304 + 64 * (j))
#define XB_TOP      3328
#define XB_TOPGEN   3392
#define XCD_BAR_WORDS 3456
#define XB_SPIN_CAP (1u << 18)

__device__ __forceinline__ unsigned xb_ld(unsigned* p)              { return __hip_atomic_load(p, __ATOMIC_RELAXED, __HIP_MEMORY_SCOPE_AGENT); }
__device__ __forceinline__ unsigned xb_add(unsigned* p, unsigned v) { return __hip_atomic_fetch_add(p, v, __ATOMIC_RELAXED, __HIP_MEMORY_SCOPE_AGENT); }
__device__ __forceinline__ unsigned xb_xcc_id() { return (unsigned)__builtin_amdgcn_s_getreg((3 << 11) | 20) & 0xFu; }
#define XB_SPIN(cond, bar) do { unsigned _sp = 0; while (cond) { __builtin_amdgcn_s_sleep(1); \
    if ((++_sp & 255u) == 0u) { if (xb_ld(&(bar)[XB_TMO])) break; if (_sp > XB_SPIN_CAP) { atomicAdd(&(bar)[XB_TMO], 1u); break; } } } } while (0)

struct XcdBarrier {
    unsigned* bar; unsigned x;
    volatile LAS unsigned* st;
};

__device__ __forceinline__ XcdBarrier xcd_barrier_post(unsigned* bar, volatile LAS unsigned* st) {
    XcdBarrier b; b.bar = bar; b.x = xb_xcc_id(); b.st = st;
    if (threadIdx.x == 0) (void)xb_add(&bar[XB_XCNT(b.x)], 1u);
    return b;
}
__device__ __forceinline__ void xcd_barrier_complete(unsigned* bar, unsigned x, unsigned& nloc, unsigned& nx) {
    const unsigned G = gridDim.x * gridDim.y * gridDim.z;
    unsigned sum, cnt, mine, sp = 0u;
    for (;;) {
        sum = 0u; cnt = 0u; mine = 0u;
#pragma unroll
        for (unsigned j = 0; j < 16; ++j) { const unsigned c = xb_ld(&bar[XB_XCNT(j)]); sum += c; cnt += (c > 0u) ? 1u : 0u; mine = (j == x) ? c : mine; }
        if (sum == G) break;
        __builtin_amdgcn_s_sleep(1);
        if ((++sp & 255u) == 0u) { if (xb_ld(&bar[XB_TMO])) break; if (sp > XB_SPIN_CAP) { atomicAdd(&bar[XB_TMO], 1u); break; } }
    }
    nloc = mine > 0u ? mine : 1u; nx = cnt > 0u ? cnt : 1u;
}

__device__ __forceinline__ void xcd_barrier(const XcdBarrier& b) {
    asm volatile("s_waitcnt vmcnt(0)" ::: "memory");
    __syncthreads();
    if (threadIdx.x == 0) {
        unsigned* bar = b.bar;
        __builtin_amdgcn_s_waitcnt(0);
        unsigned nloc = b.st[0], nx = b.st[1];
        if (nloc == 0u) { xcd_barrier_complete(bar, b.x, nloc, nx); b.st[0] = nloc; b.st[1] = nx; }
        const unsigned old = xb_add(&bar[XB_XSUB(b.x)], 1u);
        const unsigned gen = old / nloc;
        if (old + 1u == (gen + 1u) * nloc) {
            __builtin_amdgcn_fence(__ATOMIC_RELEASE, "agent");
            asm volatile("s_waitcnt vmcnt(0)" ::: "memory");
            const unsigned og = xb_add(&bar[XB_TOP], 1u);
            const unsigned tg = og / nx;
            if (og + 1u == (tg + 1u) * nx) xb_add(&bar[XB_TOPGEN], 1u);
            else XB_SPIN(xb_ld(&bar[XB_TOPGEN]) == tg, bar);
            __builtin_amdgcn_fence(__ATOMIC_ACQUIRE, "agent");
            xb_add(&bar[XB_XGEN(b.x)], 1u);
            asm volatile("s_waitcnt vmcnt(0)" ::: "memory");
        } else {
            XB_SPIN(xb_ld(&bar[XB_XGEN(b.x)]) == gen, bar);
            __builtin_amdgcn_fence(__ATOMIC_ACQUIRE, "agent");
            asm volatile("s_waitcnt vmcnt(0)" ::: "memory");
        }
    }
    __syncthreads();
}

template <class F>
__device__ __forceinline__ void transpose_item(const float* W, int K, int N, bf16* WT, LAS float* scr, int item, int lane, F rowmap, int ldk = 0, int koff = 0) {
    if (ldk == 0) ldk = K;
    const int nblk = (N + 31) / 32, kb = item / nblk, nb = item % nblk, k0 = 64 * kb, n0 = 32 * nb;
    const int nsrc = n0 + (lane & 31);
    float wv[32];
#pragma unroll
    for (int i = 0; i < 32; ++i) { const int kk = 2 * i + (lane >> 5); wv[i] = nsrc < N ? W[(size_t)(k0 + kk) * N + nsrc] : 0.f; }
#pragma unroll
    for (int i = 0; i < 32; ++i) { const int kk = 2 * i + (lane >> 5); scr[kk * 33 + (lane & 31)] = wv[i]; }
    asm volatile("s_waitcnt lgkmcnt(0)" ::: "memory");
    const int c = lane & 7;
#pragma unroll
    for (int j = 0; j < 4; ++j) {
        const int nl = (lane >> 3) + 8 * j, n = n0 + nl;
        const LAS float* s = scr + (8 * c) * 33 + nl;
        u32x4 o; o.x = pk2(s[0 * 33], s[1 * 33]); o.y = pk2(s[2 * 33], s[3 * 33]); o.z = pk2(s[4 * 33], s[5 * 33]); o.w = pk2(s[6 * 33], s[7 * 33]);
        if (n < N) { const int dr = rowmap(n); *(u32x4*)(WT + (size_t)dr * ldk + koff + k0 + 8 * c) = o; }
    }
    asm volatile("s_waitcnt lgkmcnt(0)" ::: "memory");
}

struct MapId { __device__ __forceinline__ int operator()(int n) const { return n; } };
struct MapWin { __device__ __forceinline__ int operator()(int n) const { return win_newcol(n); } };
struct MapGU { int off; __device__ __forceinline__ int operator()(int n) const { return (n >> 7) * 256 + off + (n & 127); } };

__device__ __forceinline__ void row_to_bf16(const float* xrow, bf16* orow, int lane) {
    const f32x4* xr = (const f32x4*)xrow + lane;
    unsigned long long* o8 = (unsigned long long*)orow + lane;
#pragma unroll
    for (int j = 0; j < 4; ++j) { const f32x4 v = xr[64 * j]; o8[64 * j] = (unsigned long long)pk2(v.x, v.y) | ((unsigned long long)pk2(v.z, v.w) << 32); }
}

__device__ __forceinline__ void phase_prologue(const Params& p, LAS unsigned char* lds) {
    int tid_ = threadIdx.x; asm volatile("" : "+v"(tid_));
    const int tid = tid_, lane = tid & 63, wave = tid >> 6;
    const int gw = blockIdx.x * 8 + wave, NGW = gridDim.x * 8;
    LAS float* scr = (LAS float*)(lds + wave * 16384);
    unsigned char* ws = p.ws;
    constexpr int I_WIN = (1024 / 64) * 219, I_WBA = (512 / 64) * 32, I_WBM = 16 * 32, I_WOUT = 16 * 32;
    constexpr int NIT = I_WIN + I_WBA + I_WBM + I_WOUT;
    for (int it = gw; it < NIT; it += NGW) {
        int r = it;
        if (r < I_WIN) { transpose_item(p.in[1], 1024, 6996, (bf16*)(ws + WS_WIN), scr, r, lane, MapWin()); continue; } r -= I_WIN;
        if (r < I_WBA) { transpose_item(p.in[5], 512, 1024, (bf16*)(ws + WS_WBA), scr, r, lane, MapId()); continue; } r -= I_WBA;
        if (r < I_WBM) { transpose_item(p.in[6], 1024, 1024, (bf16*)(ws + WS_WBM), scr, r, lane, MapId()); continue; } r -= I_WBM;
        transpose_item(p.in[7], 1024, 1024, (bf16*)(ws + WS_WOUT), scr, r, lane, MapId());
    }
    {
        const int gt = blockIdx.x * 512 + tid, NGT = gridDim.x * 512;
        bf16* wt = (bf16*)(ws + WS_WIN); float* bp = (float*)(ws + WS_BIAS);
        for (int i = gt; i < 172 * 128; i += NGT) {
            const int pr = i / 128, ch = i % 128; const int row = pr < 4 ? 1860 + pr : 1880 + (pr - 4);
            *(u32x4*)(wt + (size_t)row * 1024 + ch * 8) = (u32x4){0u, 0u, 0u, 0u};
        }
        for (int i = gt; i < 172; i += NGT) { const int row = i < 4 ? 1860 + i : 1880 + (i - 4); bp[row] = 0.f; }
        for (int c = gt; c < 6996; c += NGT) bp[win_newcol(c)] = p.in[2][c];
    }
    bf16* xn = (bf16*)((unsigned char*)p.out + DO_XN);
    for (int m = gw; m < T; m += 4 * NGW) {
        f32x4 v[4][4];
#pragma unroll
        for (int r = 0; r < 4; ++r) { const int mr = m + r * NGW; if (mr < T) { const f32x4* xr = (const f32x4*)(p.in[0] + (size_t)mr * DM) + lane;
#pragma unroll
            for (int j = 0; j < 4; ++j) v[r][j] = xr[64 * j]; } }
#pragma unroll
        for (int r = 0; r < 4; ++r) { const int mr = m + r * NGW; if (mr < T) { unsigned long long* o8 = (unsigned long long*)(xn + (size_t)mr * DM) + lane;
#pragma unroll
            for (int j = 0; j < 4; ++j) o8[64 * j] = (unsigned long long)pk2(v[r][j].x, v[r][j].y) | ((unsigned long long)pk2(v[r][j].z, v[r][j].w) << 32); } }
    }
}

__device__ __forceinline__ void phase_expert_weights(const Params& p, LAS unsigned char* lds) {
    int tid_ = threadIdx.x; asm volatile("" : "+v"(tid_));
    const int tid = tid_, lane = tid & 63, wave = tid >> 6;
    const int gw = blockIdx.x * 8 + wave, NGW = gridDim.x * 8;
    LAS float* scr = (LAS float*)(lds + wave * 16384);
    constexpr int I_G = 16 * 16, I_D = 8 * 32;
    constexpr int NIT = 16 * (2 * I_G + I_D);
    for (int it = gw; it < NIT; it += NGW) {
        const int e = it / (2 * I_G + I_D); int r = it % (2 * I_G + I_D);
        bf16* wgu = (bf16*)(p.ws + WS_WGU) + (size_t)e * 1024 * 1024;
        if (r < I_G) { transpose_item(p.in[14] + (size_t)e * 1024 * 512, 1024, 512, wgu, scr, r, lane, MapGU{0}); continue; } r -= I_G;
        if (r < I_G) { transpose_item(p.in[15] + (size_t)e * 1024 * 512, 1024, 512, wgu, scr, r, lane, MapGU{128}); continue; } r -= I_G;
        transpose_item(p.in[16] + (size_t)e * 512 * 1024, 512, 1024, (bf16*)(p.ws + WS_WD) + (size_t)e * 1024 * 512, scr, r, lane, MapId());
    }
}

__device__ __forceinline__ void rope_cs(const LAS float* linv, int t, int d0, f32x4& c4, f32x4& s4) {
    const f32x4 fr4 = *(const LAS f32x4*)(linv + d0); const float tf = (float)t;
#pragma unroll
    for (int i = 0; i < 4; ++i) { const float rev = __builtin_amdgcn_fractf(tf * fr4[i]); c4[i] = __builtin_amdgcn_cosf(rev); s4[i] = __builtin_amdgcn_sinf(rev); }
}
struct EpiInProj {
    static constexpr bool PERM = true, AFTER_DRAIN = false;
    unsigned char* ws; unsigned char* dout; const LAS bf16* lbias; const LAS float* linv;
    __device__ __forceinline__ void operator()(const f32x4 (&acc)[2][2][4][2], const pg8::Unit& u, int wr, int wc, int fr, int fq) const {
        const int pn = u.pn;
        const int row0 = u.pm * 256 + wr * 64 + fr;
        const int cl0 = wc * 32 + 8 * fq;
        f32x4 bv[2][2];
#pragma unroll
        for (int bj = 0; bj < 2; ++bj) { const u32x4 bw = *(const LAS u32x4*)(lbias + pn * 256 + cl0 + bj * 128);
            bv[bj][0] = (f32x4){__uint_as_float(bw.x << 16), __uint_as_float(bw.x & 0xffff0000u), __uint_as_float(bw.y << 16), __uint_as_float(bw.y & 0xffff0000u)};
            bv[bj][1] = (f32x4){__uint_as_float(bw.z << 16), __uint_as_float(bw.z & 0xffff0000u), __uint_as_float(bw.w << 16), __uint_as_float(bw.w & 0xffff0000u)}; }
        int cat; bf16* dst = nullptr; int ld = 0, cb = 0; float sc = 1.f;
        if (pn < 2)       { cat = 0; dst = (bf16*)(ws + WS_AQ); ld = 512; cb = pn * 256; sc = QSCALE2; }
        else if (pn < 4)  { cat = 0; dst = (bf16*)(ws + WS_AK); ld = 512; cb = (pn - 2) * 256; }
        else if (pn < 6)  { cat = 1; dst = (bf16*)(ws + WS_AV); ld = 512; cb = (pn - 4) * 256; }
        else if (pn == 6) { cat = 0; dst = (bf16*)(ws + WS_IQ); ld = 256; cb = 0; sc = IDX_QSCALE; }
        else if (pn == 7) { cat = 3; }
        else if (pn < 10) { cat = 1; dst = (bf16*)(ws + WS_MQ); ld = 512; cb = (pn - 8) * 256; }
        else if (pn < 12) { cat = 1; dst = (bf16*)(ws + WS_MK); ld = 512; cb = (pn - 10) * 256; }
        else if (pn < 16) { cat = 1; dst = (bf16*)(ws + WS_MV); ld = 1024; cb = (pn - 12) * 256; }
        else if (pn < 20) { cat = 2; dst = (bf16*)(ws + WS_MO); ld = 1024; cb = (pn - 16) * 256; }
        else if (pn < 24) { cat = 2; dst = (bf16*)(ws + WS_GA); ld = 1024; cb = (pn - 20) * 256; }
        else              { cat = 2; dst = (bf16*)(dout + DO_GM); ld = 1024; cb = (pn - 24) * 256; }
#pragma unroll
        for (int ai = 0; ai < 2; ++ai)
#pragma unroll
            for (int m = 0; m < 4; ++m) {
                const int row = row0 + ai * 128 + m * 16;
                const int t = row & (SEQ - 1);
#pragma unroll
                for (int bj = 0; bj < 2; ++bj) {
                    f32x4 v0 = acc[ai][bj][m][0] + bv[bj][0], v1 = acc[ai][bj][m][1] + bv[bj][1];
                    const int cl = cl0 + bj * 128;
                    if (cat == 3) {
                        if (cl < 64) {
                            const int d0 = cl >> 1;
                            f32x4 c4, s4; rope_cs(linv, t, d0, c4, s4);
                            u32x4 w;
                            w.x = pk2(v0[0] * c4[0] - v0[1] * s4[0], v0[0] * s4[0] + v0[1] * c4[0]);
                            w.y = pk2(v0[2] * c4[1] - v0[3] * s4[1], v0[2] * s4[1] + v0[3] * c4[1]);
                            w.z = pk2(v1[0] * c4[2] - v1[1] * s4[2], v1[0] * s4[2] + v1[1] * c4[2]);
                            w.w = pk2(v1[2] * c4[3] - v1[3] * s4[3], v1[2] * s4[3] + v1[3] * c4[3]);
                            *(u32x4*)((bf16*)(ws + WS_IK) + (size_t)row * 64 + cl) = w;
                        } else if (cl == 64) {
                            *(f32x4*)((float*)(ws + WS_IW) + (size_t)row * 4) = v0 * (0.0625f * IDX_WSCALE);
                        } else if (cl == 72) {
                            float* d = (float*)(ws + WS_MI) + (size_t)row * 8; *(f32x4*)d = v0; *(f32x4*)(d + 4) = v1;
                        } else if (cl == 80) {
                            float* d = (float*)(ws + WS_MF) + (size_t)row * 8; *(f32x4*)d = v0; *(f32x4*)(d + 4) = v1;
                        }
                    } else {
                        u32x4 w;
                        if (cat == 0) {
                            const int d0 = (cl & 63) >> 1;
                            f32x4 c4, s4; rope_cs(linv, t, d0, c4, s4);
                            w.x = pk2((v0[0] * c4[0] - v0[1] * s4[0]) * sc, (v0[0] * s4[0] + v0[1] * c4[0]) * sc);
                            w.y = pk2((v0[2] * c4[1] - v0[3] * s4[1]) * sc, (v0[2] * s4[1] + v0[3] * c4[1]) * sc);
                            w.z = pk2((v1[0] * c4[2] - v1[1] * s4[2]) * sc, (v1[0] * s4[2] + v1[1] * c4[2]) * sc);
                            w.w = pk2((v1[2] * c4[3] - v1[3] * s4[3]) * sc, (v1[2] * s4[3] + v1[3] * c4[3]) * sc);
                        } else if (cat == 1) {
                            w.x = pk2(v0[0], v0[1]); w.y = pk2(v0[2], v0[3]); w.z = pk2(v1[0], v1[1]); w.w = pk2(v1[2], v1[3]);
                        } else {
                            w.x = pk2(sigmoidf_(v0[0]), sigmoidf_(v0[1])); w.y = pk2(sigmoidf_(v0[2]), sigmoidf_(v0[3]));
                            w.z = pk2(sigmoidf_(v1[0]), sigmoidf_(v1[1])); w.w = pk2(sigmoidf_(v1[2]), sigmoidf_(v1[3]));
                        }
                        *(u32x4*)(dst + (size_t)row * ld + cb + cl) = w;
                    }
                }
            }
    }
};

constexpr int INP_LBIAS = 131072, INP_LINV = 131072 + 14336;
__device__ __forceinline__ void phase_inproj(const Params& p, LAS unsigned char* lds) {
    {
        LAS bf16* lb = (LAS bf16*)(lds + INP_LBIAS); LAS float* li = (LAS float*)(lds + INP_LINV);
        const float* bp = (const float*)(p.ws + WS_BIAS);
        int tl_ = threadIdx.x; asm volatile("" : "+v"(tl_));
        for (int i = tl_; i < NW_IN; i += 512) lb[i] = (bf16)f2bf(bp[i]);
        if (tl_ < 32) li[tl_] = (float)(pow(10000.0, -(double)tl_ / 32.0)) * 0.15915494309189535f;
        __syncthreads();
    }
    pg8::Gemm g{(const bf16*)((unsigned char*)p.out + DO_XN), (const bf16*)(p.ws + WS_WIN), T, NW_IN, 1024};
    pg8::StaticOrder S; S.init(T, NW_IN, gridDim.x, (int)blockIdx.x);
    EpiInProj E{p.ws, (unsigned char*)p.out, (const LAS bf16*)(lds + INP_LBIAS), (const LAS float*)(lds + INP_LINV)};
    pg8::gemm_phase<EpiInProj, pg8::StaticOrder, true, true>(lds, g, S, E);
}

struct EpiDummy {
    static constexpr bool PERM = true, AFTER_DRAIN = false;
    bf16* O;
    __device__ __forceinline__ void operator()(const f32x4 (&acc)[2][2][4][2], const pg8::Unit& u, int wr, int wc, int fr, int fq) const {
        const int row0 = u.pm * 256 + wr * 64 + fr, col0 = wc * 32 + 8 * fq;
#pragma unroll
        for (int ai = 0; ai < 2; ++ai)
#pragma unroll
            for (int m = 0; m < 4; ++m)
#pragma unroll
                for (int bj = 0; bj < 2; ++bj) {
                    const f32x4 v0 = acc[ai][bj][m][0], v1 = acc[ai][bj][m][1];
                    u32x4 w; w.x = pk2(v0[0], v0[1]); w.y = pk2(v0[2], v0[3]); w.z = pk2(v1[0], v1[1]); w.w = pk2(v1[2], v1[3]);
                    *(u32x4*)(O + (size_t)(row0 + ai * 128 + m * 16) * 256 + col0 + bj * 128) = w;
                }
    }
};
__device__ __forceinline__ void phase_inproj_dummy(const Params& p, LAS unsigned char* lds) {
    pg8::Gemm g{(const bf16*)((unsigned char*)p.out + DO_XN), (const bf16*)(p.ws + WS_WIN), T, NW_IN, 1024};
    pg8::StaticOrder S; S.init(T, NW_IN, gridDim.x, (int)blockIdx.x);
    EpiDummy E{(bf16*)(p.ws + WS_MASK)};
    pg8::gemm_phase<EpiDummy, pg8::StaticOrder, true, true>(lds, g, S, E);
}

typedef float f32x16 __attribute__((ext_vector_type(16)));
struct IdxQ { bf16x8 qf[4][4]; float w[4]; };
__device__ __forceinline__ float relu_f(float x) { const int b = __float_as_int(x); return __int_as_float(b & ~(b >> 31)); }

__device__ __forceinline__ void idx_loadk(const bf16* IK, size_t keytok0, int lane, bf16x8 (&kf)[4]) {
    const bf16* kp = IK + (keytok0 + (lane & 31)) * 64 + 8 * (lane >> 5);
#pragma unroll
    for (int ks = 0; ks < 4; ++ks) kf[ks] = *(const bf16x8*)(kp + ks * 16);
}
#define IDX_RP(i_) "v_pk_mul_f32 %[t" #i_ "], %[a" #i_ "], 1.0 op_sel_hi:[1,0] clamp\n\tv_pk_fma_f32 %[s" #i_ "], %[w], %[t" #i_ "], %[s" #i_ "]\n\t"
__device__ __forceinline__ void idx_scores2(const bf16x8 (&kf)[4], const IdxQ& Q, f32x2 (&sc)[8]) {
#pragma unroll
    for (int i = 0; i < 8; ++i) sc[i] = (f32x2){0.f, 0.f};
#pragma unroll
    for (int h = 0; h < 4; ++h) {
        f32x16 acc = {0.f, 0.f, 0.f, 0.f, 0.f, 0.f, 0.f, 0.f, 0.f, 0.f, 0.f, 0.f, 0.f, 0.f, 0.f, 0.f};
#pragma unroll
        for (int ks = 0; ks < 4; ++ks) acc = __builtin_amdgcn_mfma_f32_32x32x16_bf16(kf[ks], Q.qf[h][ks], acc, 0, 0, 0);
        const f32x2 w2 = {Q.w[h], Q.w[h]};
#ifdef IDX_NOCLAMP
#pragma unroll
        for (int i = 0; i < 8; ++i) { const f32x2 rl = {relu_f(acc[2 * i]), relu_f(acc[2 * i + 1])}; sc[i] = __builtin_elementwise_fma(w2, rl, sc[i]); }
#else
        { const f32x2 rl = {relu_f(acc[0]), relu_f(acc[1])}; sc[0] = __builtin_elementwise_fma(w2, rl, sc[0]); }
        const f32x2 a1 = {acc[2], acc[3]}, a2 = {acc[4], acc[5]}, a3 = {acc[6], acc[7]}, a4 = {acc[8], acc[9]}, a5 = {acc[10], acc[11]}, a6 = {acc[12], acc[13]}, a7 = {acc[14], acc[15]};
        f32x2 t1, t2, t3, t4, t5, t6, t7;
        asm(IDX_RP(1) IDX_RP(2) IDX_RP(3) IDX_RP(4) IDX_RP(5) IDX_RP(6) IDX_RP(7)
            : [s1] "+v"(sc[1]), [s2] "+v"(sc[2]), [s3] "+v"(sc[3]), [s4] "+v"(sc[4]), [s5] "+v"(sc[5]), [s6] "+v"(sc[6]), [s7] "+v"(sc[7]),
              [t1] "=&v"(t1), [t2] "=&v"(t2), [t3] "=&v"(t3), [t4] "=&v"(t4), [t5] "=&v"(t5), [t6] "=&v"(t6), [t7] "=&v"(t7)
            : [a1] "v"(a1), [a2] "v"(a2), [a3] "v"(a3), [a4] "v"(a4), [a5] "v"(a5), [a6] "v"(a6), [a7] "v"(a7), [w] "v"(w2), [dep] "v"(sc[0]));
#endif
    }
}
#undef IDX_RP
#define IDX_CB(n_) "v_cmp_ge_f32_e32 vcc, %" #n_ ", %18\n\tv_addc_co_u32_e32 %0, vcc, %0, %0, vcc\n\tv_cmp_ge_f32_e32 vcc, %" #n_ ", %19\n\tv_addc_co_u32_e32 %1, vcc, %1, %1, vcc\n\t"
__device__ __forceinline__ void idx_cmpbits(const f32x2 (&sc)[8], float fH, float fL, unsigned& mh, unsigned& ml) {
    unsigned a = 0u, b = 0u;
    asm(IDX_CB(17) IDX_CB(16) IDX_CB(15) IDX_CB(14) IDX_CB(13) IDX_CB(12) IDX_CB(11) IDX_CB(10) IDX_CB(9) IDX_CB(8) IDX_CB(7) IDX_CB(6) IDX_CB(5) IDX_CB(4) IDX_CB(3) IDX_CB(2)
        : "+v"(a), "+v"(b)
        : "v"(sc[0][0]), "v"(sc[0][1]), "v"(sc[1][0]), "v"(sc[1][1]), "v"(sc[2][0]), "v"(sc[2][1]), "v"(sc[3][0]), "v"(sc[3][1]),
          "v"(sc[4][0]), "v"(sc[4][1]), "v"(sc[5][0]), "v"(sc[5][1]), "v"(sc[6][0]), "v"(sc[6][1]), "v"(sc[7][0]), "v"(sc[7][1]), "v"(fH), "v"(fL)
        : "vcc");
    mh = a; ml = b;
}
#undef IDX_CB

constexpr int IDX_HIST = 0, IDX_THR = 131072, IDX_NEED = 131072 + 128, IDX_CCNT = 131072 + 256, IDX_SEG = 131072 + 384, IDX_THRH = 131072 + 384 + 4096, IDX_LO = IDX_THRH + 128, IDX_SI = IDX_LO + 128, IDX_FLAG = IDX_SI + 128;
constexpr int IDX_BASE = 107 << 23;
constexpr int IDX_TOP = IDX_BASE + (1024 << 18) - 1;

template <bool FINE> __device__ __forceinline__ void idx_hadd(LAS unsigned char* histb, unsigned bb, int cF, unsigned q4) {
    if (FINE) {
        const int m = min(max((int)(bb & 0x7FFFFFFFu), IDX_BASE), IDX_TOP);
        const unsigned a = (((unsigned)m >> 18) << 7) + (unsigned)cF;
        __hip_atomic_fetch_add((LAS unsigned*)a, ((int)bb < 0) ? 65536u : 1u, __ATOMIC_RELAXED, __HIP_MEMORY_SCOPE_WORKGROUP);
    } else {
        __hip_atomic_fetch_add((LAS unsigned*)(histb + (((bb >> 14) & 0x1FF80u) | q4)), ((int)bb < 0) ? 65536u : 1u, __ATOMIC_RELAXED, __HIP_MEMORY_SCOPE_WORKGROUP);
    }
}

#define IDX_H1(n_, A_, B_) "v_med3_f32 %" #A_ ", |%" #n_ "|, %21, %22\n\tv_bfe_u32 %" #B_ ", %" #n_ ", 31, 1\n\tv_bfe_u32 %" #A_ ", %" #A_ ", 18, 14\n\tv_mad_u32_u24 %" #B_ ", %" #B_ ", %24, 1\n\tv_lshl_add_u32 %" #A_ ", %" #A_ ", 7, %23\n\tds_add_u32 %" #A_ ", %" #B_ "\n\t"
__device__ __forceinline__ void idx_hist16_fine(const f32x2 (&sc)[8], int cF) {
    unsigned t0, t1, t2, t3; const float lo = __int_as_float(IDX_BASE), hi = __int_as_float(IDX_TOP); const int c16 = 65535;
    asm volatile(IDX_H1(4, 0, 1) IDX_H1(5, 2, 3) IDX_H1(6, 0, 1) IDX_H1(7, 2, 3) IDX_H1(8, 0, 1) IDX_H1(9, 2, 3) IDX_H1(10, 0, 1) IDX_H1(11, 2, 3)
                 IDX_H1(12, 0, 1) IDX_H1(13, 2, 3) IDX_H1(14, 0, 1) IDX_H1(15, 2, 3) IDX_H1(16, 0, 1) IDX_H1(17, 2, 3) IDX_H1(18, 0, 1) IDX_H1(19, 2, 3)
        : "=&v"(t0), "=&v"(t1), "=&v"(t2), "=&v"(t3)
        : "v"(sc[0][0]), "v"(sc[0][1]), "v"(sc[1][0]), "v"(sc[1][1]), "v"(sc[2][0]), "v"(sc[2][1]), "v"(sc[3][0]), "v"(sc[3][1]),
          "v"(sc[4][0]), "v"(sc[4][1]), "v"(sc[5][0]), "v"(sc[5][1]), "v"(sc[6][0]), "v"(sc[6][1]), "v"(sc[7][0]), "v"(sc[7][1]),
          "v"(0), "v"(lo), "v"(hi), "v"(cF), "v"(c16)
        : "memory");
}
#undef IDX_H1
template <bool FINE> __device__ __forceinline__ void idx_pass1(const bf16* IK, size_t tokb, const IdxQ& Q, LAS unsigned char* histb, int qg, int ntl, int wave, int lane, int t) {
    const int q = lane & 31, hi = lane >> 5;
    const int cF = (int)(unsigned)(size_t)histb + 4 * q - ((IDX_BASE >> 18) << 7); const unsigned q4 = (unsigned)(4 * q);
#ifdef IDX_KPF
    bf16x8 kn[2][4];
    { const int t0 = min(wave, ntl - 1); idx_loadk(IK, tokb + (size_t)t0 * 64, lane, kn[0]); idx_loadk(IK, tokb + (size_t)t0 * 64 + 32, lane, kn[1]); }
#endif
#pragma unroll 1
    for (int tile = wave; tile < ntl; tile += 8) {
        bf16x8 kt[2][4];
#ifdef IDX_KPF
#pragma unroll
        for (int i = 0; i < 4; ++i) { kt[0][i] = kn[0][i]; kt[1][i] = kn[1][i]; }
        { const int t1 = min(tile + 8, ntl - 1); idx_loadk(IK, tokb + (size_t)t1 * 64, lane, kn[0]); idx_loadk(IK, tokb + (size_t)t1 * 64 + 32, lane, kn[1]); }
#else
        idx_loadk(IK, tokb + (size_t)tile * 64, lane, kt[0]);
        if (2 * tile + 1 <= qg) idx_loadk(IK, tokb + (size_t)tile * 64 + 32, lane, kt[1]);
#endif
#pragma unroll
        for (int pp = 0; pp < 2; ++pp) {
            const int blk = 2 * tile + pp;
            if (blk <= qg) {
                f32x2 sc2[8]; idx_scores2(kt[pp], Q, sc2);
                if (blk < qg) {
                    if (FINE) idx_hist16_fine(sc2, cF);
                    else {
#pragma unroll
                        for (int r = 0; r < 16; ++r) idx_hadd<FINE>(histb, __float_as_uint(sc2[r >> 1][r & 1]), cF, q4);
                    }
                } else {
#pragma unroll
                    for (int r = 0; r < 16; ++r) { const int key = blk * 32 + (r & 3) + 8 * (r >> 2) + 4 * hi;
                        if (key <= t) idx_hadd<FINE>(histb, __float_as_uint(sc2[r >> 1][r & 1]), cF, q4); }
                }
            }
        }
    }
    asm volatile("s_waitcnt lgkmcnt(0)" ::: "memory");
}

template <bool FINE> __device__ __forceinline__ void idx_find_thr(LAS unsigned* hist, LAS int* segsum, LAS int* thrb, LAS unsigned* thrh, LAS int* need, LAS unsigned* thrlo, LAS unsigned* thrsi, LAS int* flag, int tid) {
    { const int qq_ = tid & 31, seg_ = tid >> 5; int sp_ = 0, sn_ = 0;
#pragma unroll 8
      for (int i = 0; i < 64; ++i) { const unsigned wv = hist[(1023 - 64 * seg_ - i) * 32 + qq_]; sp_ += (int)(wv & 0xffffu); sn_ += (int)(wv >> 16); }
      segsum[seg_ * 32 + qq_] = sp_; segsum[(31 - seg_) * 32 + qq_] = sn_; }
    __syncthreads();
    {
        const int qq_ = tid >> 4, part = tid & 15, lane = tid & 63, grp = (lane >> 4) * 16;
        const int s0 = segsum[(2 * part) * 32 + qq_], s1 = segsum[(2 * part + 1) * 32 + qq_];
        int incl = s0 + s1;
#pragma unroll
        for (int o = 1; o < 16; o <<= 1) { const int v = __shfl_up(incl, o, 16); if (part >= o) incl += v; }
        const int excl = incl - s0 - s1;
        const int tot = __shfl(incl, 15, 16);
        bool h0 = (excl < 256 && excl + s0 >= 256), h1 = (excl + s0 < 256 && excl + s0 + s1 >= 256);
        if (tot < 256) { h0 = false; h1 = (part == 15); }
        const unsigned gm = (unsigned)((__ballot(h0 || h1) >> grp) & 0xFFFFull);
        const int src = gm ? (int)__builtin_ctz(gm) : 15;
        const int sgl = h0 ? 2 * part : 2 * part + 1, cml = h0 ? excl : excl + s0;
        const int sg = __shfl(sgl, src, 16), cums = __shfl(cml, src, 16);
        const bool neg_ = sg >= 16; const int base_ = neg_ ? 64 * (sg - 16) : 1023 - 64 * sg, dir_ = neg_ ? 1 : -1, sh_ = neg_ ? 16 : 0;
        int c_[4];
#pragma unroll
        for (int e = 0; e < 4; ++e) c_[e] = (int)((hist[(base_ + dir_ * (4 * part + e)) * 32 + qq_] >> sh_) & 0xffffu);
        const int ls = c_[0] + c_[1] + c_[2] + c_[3];
        int inc2 = ls;
#pragma unroll
        for (int o = 1; o < 16; o <<= 1) { const int v = __shfl_up(inc2, o, 16); if (part >= o) inc2 += v; }
        int cum = cums + inc2 - ls;
        int wsel_ = 0, above_ = 0, csel_ = 0; bool done_ = false;
#pragma unroll
        for (int e = 0; e < 4; ++e) { if (!done_ && cum < 256 && cum + c_[e] >= 256) { wsel_ = base_ + dir_ * (4 * part + e); above_ = cum; csel_ = c_[e]; done_ = true; } cum += c_[e]; }
        const bool any_ = ((__ballot(done_) >> grp) & 0xFFFFull) != 0ull;
        if (done_ || (!any_ && part == 0)) {
            unsigned L_, H_, lo_, s_;
            const unsigned w_ = (unsigned)wsel_;
            if (!done_) { L_ = 0xFF800000u; H_ = 0xFF800000u; above_ = 256; lo_ = 0u; s_ = 0u; }
            else if (FINE) {
                if (csel_ > 1024) flag[0] = 1;
                const unsigned bl_ = (unsigned)IDX_BASE + (w_ << 18), bh_ = bl_ + (1u << 18);
                lo_ = (w_ == 0u) ? 0u : bl_; s_ = (w_ == 0u || w_ == 1023u) ? 11u : 0u;
                if (!neg_) { L_ = lo_; H_ = (w_ == 1023u) ? 0x7F800000u : bh_; }
                else { H_ = (w_ == 0u) ? 0u : (0x80000000u | (bl_ - 1u)); L_ = (w_ == 1023u) ? 0xFF800000u : (0x80000000u | (bh_ - 1u)); s_ |= 0x80000000u; }
            } else {
                lo_ = w_ << 21; s_ = 2u;
                if (!neg_) { L_ = lo_; H_ = (w_ == 1023u) ? 0x7F800000u : ((w_ + 1u) << 21); }
                else { H_ = (w_ == 0u) ? 0u : (0x80000000u | (lo_ - 1u)); L_ = 0x80000000u | (((w_ + 1u) << 21) - 1u); s_ |= 0x80000000u; }
            }
            thrb[qq_] = (int)L_; thrh[qq_] = H_; need[qq_] = 256 - above_; thrlo[qq_] = lo_; thrsi[qq_] = s_;
        }
    }
    __syncthreads();
}

__device__ __forceinline__ void indexer_unit(const Params& p, LAS unsigned char* lds, int b, int qg) {
    int tid_ = threadIdx.x; asm volatile("" : "+v"(tid_));
    const int tid = tid_, lane = tid & 63, wave = __builtin_amdgcn_readfirstlane(tid >> 6), q = lane & 31, hi = lane >> 5;
    LAS unsigned* hist = (LAS unsigned*)(lds + IDX_HIST);
    LAS int* thrb = (LAS int*)(lds + IDX_THR);
    LAS unsigned* thrh = (LAS unsigned*)(lds + IDX_THRH);
    LAS int* need = (LAS int*)(lds + IDX_NEED);
    LAS unsigned* ccnt = (LAS unsigned*)(lds + IDX_CCNT);
    LAS int* segsum = (LAS int*)(lds + IDX_SEG);
    LAS int* flag = (LAS int*)(lds + IDX_FLAG);
    LAS unsigned* thrlo = (LAS unsigned*)(lds + IDX_LO); LAS unsigned* thrsi = (LAS unsigned*)(lds + IDX_SI);
    const bf16* IQ = (const bf16*)(p.ws + WS_IQ); const bf16* IK = (const bf16*)(p.ws + WS_IK); const float* IW = (const float*)(p.ws + WS_IW);
    unsigned* MASK = (unsigned*)(p.ws + WS_MASK) + ((size_t)(b * 256 + qg) * 128) * 64;
    const size_t tokb = (size_t)b * SEQ;
    const int t = qg * 32 + q;
    const int ntl = (qg >> 1) + 1;
    const int ntw = 4 * (qg >> 3) + 4;
    IdxQ Q;
    {
        const bf16* qp = IQ + (tokb + t) * 256 + 8 * hi;
#pragma unroll
        for (int h = 0; h < 4; ++h)
#pragma unroll
            for (int ks = 0; ks < 4; ++ks) Q.qf[h][ks] = *(const bf16x8*)(qp + h * 64 + ks * 16);
        const f32x4 w4 = *(const f32x4*)(IW + (tokb + t) * 4);
        Q.w[0] = w4[0]; Q.w[1] = w4[1]; Q.w[2] = w4[2]; Q.w[3] = w4[3];
    }
    const bool full = (qg < 8);
    if (tid < 32) { ccnt[tid] = 0u; thrb[tid] = (int)0xFF800000u; thrh[tid] = 0xFF800000u; need[tid] = 0; thrlo[tid] = 0u; thrsi[tid] = 0u; }
    if (tid == 0) flag[0] = 0;
    if (!full) {
        for (int i = tid; i < 8192; i += 512) ((LAS u32x4*)hist)[i] = (u32x4){0u, 0u, 0u, 0u};
        __syncthreads();
#ifndef IDX_REP_P1
#define IDX_REP_P1 1
#endif
        for (int rep1_ = 0; rep1_ < IDX_REP_P1; ++rep1_) {
            if (rep1_) { __syncthreads(); for (int i = tid; i < 8192; i += 512) ((LAS u32x4*)hist)[i] = (u32x4){0u, 0u, 0u, 0u}; __syncthreads(); }
            idx_pass1<true>(IK, tokb, Q, (LAS unsigned char*)hist, qg, ntl, wave, lane, t);
        }
        __syncthreads();
#ifndef IDX_REP_THR
#define IDX_REP_THR 1
#endif
        for (int rept_ = 0; rept_ < IDX_REP_THR; ++rept_) idx_find_thr<true>(hist, segsum, thrb, thrh, need, thrlo, thrsi, flag, tid);
        if (flag[0] != 0) {
            __syncthreads();
            for (int i = tid; i < 8192; i += 512) ((LAS u32x4*)hist)[i] = (u32x4){0u, 0u, 0u, 0u};
            __syncthreads();
            idx_pass1<false>(IK, tokb, Q, (LAS unsigned char*)hist, qg, ntl, wave, lane, t);
            __syncthreads();
            idx_find_thr<false>(hist, segsum, thrb, thrh, need, thrlo, thrsi, flag, tid);
        }
        __syncthreads();
    } else {
        __syncthreads();
    }
    LAS unsigned* rec = hist;
    const float fL = __int_as_float(thrb[q]), fH = __uint_as_float(thrh[q]);
#ifndef IDX_REP_P2
#define IDX_REP_P2 1
#endif
    for (int rep2_ = 0; rep2_ < IDX_REP_P2; ++rep2_) {
    if (rep2_) { __syncthreads(); if (tid < 32) ccnt[tid] = 0u; __syncthreads(); }
#ifdef IDX_KPF
    bf16x8 kn[2][4];
    { const int t0 = min(wave, ntl - 1); idx_loadk(IK, tokb + (size_t)t0 * 64, lane, kn[0]); idx_loadk(IK, tokb + (size_t)t0 * 64 + 32, lane, kn[1]); }
#endif
#pragma unroll 1
    for (int tile = wave; tile < ntw; tile += 8) {
        unsigned mw = 0u;
        if (tile < ntl) {
            bf16x8 kt[2][4];
#ifdef IDX_KPF
#pragma unroll
            for (int i = 0; i < 4; ++i) { kt[0][i] = kn[0][i]; kt[1][i] = kn[1][i]; }
            { const int t1 = min(tile + 8, ntl - 1); idx_loadk(IK, tokb + (size_t)t1 * 64, lane, kn[0]); idx_loadk(IK, tokb + (size_t)t1 * 64 + 32, lane, kn[1]); }
#else
            idx_loadk(IK, tokb + (size_t)tile * 64, lane, kt[0]);
            if (2 * tile + 1 <= qg) idx_loadk(IK, tokb + (size_t)tile * 64 + 32, lane, kt[1]);
#endif
#pragma unroll
            for (int pp = 0; pp < 2; ++pp) {
                const int blk = 2 * tile + pp;
                if (blk <= qg) {
                    f32x2 sc2[8];
                    idx_scores2(kt[pp], Q, sc2);
                    unsigned mh, ml;
                    idx_cmpbits(sc2, fH, fL, mh, ml);
                    if (blk == qg) {
                        unsigned vm = 0u;
#pragma unroll
                        for (int r = 0; r < 16; ++r) vm |= (blk * 32 + (r & 3) + 8 * (r >> 2) + 4 * hi <= t) ? (1u << r) : 0u;
                        mh &= vm; ml &= vm;
                    }
                    const unsigned cm = ml & ~mh;
                    mw |= mh << (16 * pp);
                    if (__ballot(cm != 0u)) {
                        unsigned slot = 0u;
                        if (cm) slot = __hip_atomic_fetch_add(ccnt + q, (unsigned)__popc(cm), __ATOMIC_RELAXED, __HIP_MEMORY_SCOPE_WORKGROUP);
                        const unsigned rlo = thrlo[q], rsi = thrsi[q];
#pragma unroll
                        for (int r = 0; r < 16; ++r) {
                            if (cm & (1u << r)) {
                                const int key = blk * 32 + (r & 3) + 8 * (r >> 2) + 4 * hi;
                                const unsigned mag = __float_as_uint(sc2[r >> 1][r & 1]) & 0x7FFFFFFFu;
                                const unsigned mid = (((mag - rlo) >> (rsi & 31u)) ^ (unsigned)((int)rsi >> 31)) & 0x7FFFFu;
                                if (slot < 1024u) rec[q * 1024 + slot] = (mid << 13) | (unsigned)(8191 - key);
                                ++slot;
                            }
                        }
                    }
                }
            }
        }
        MASK[(size_t)tile * 64 + lane] = mw;
    }
    }
    asm volatile("s_waitcnt vmcnt(0)" ::: "memory");
    __syncthreads();
    if (!full) {
#ifndef IDX_REP_BIS
#define IDX_REP_BIS 1
#endif
#pragma unroll 1
        for (int repb_ = 0; repb_ < IDX_REP_BIS; ++repb_) {
        int mq[4], ndq[4], rk[4]; unsigned rv0[4];
#pragma unroll
        for (int k = 0; k < 4; ++k) { mq[k] = __builtin_amdgcn_readfirstlane((int)min(ccnt[wave * 4 + k], 1024u)); ndq[k] = __builtin_amdgcn_readfirstlane(need[wave * 4 + k]); }
        int mmax = 0;
#pragma unroll
        for (int k = 0; k < 4; ++k) { const bool small = mq[k] <= 64; rv0[k] = (small && lane < mq[k]) ? rec[(wave * 4 + k) * 1024 + lane] : 0u; rk[k] = 0; if (small) mmax = max(mmax, mq[k]); }
#pragma unroll 1
        for (int j = 0; j < mmax; ++j) {
#pragma unroll
            for (int k = 0; k < 4; ++k) { const unsigned x = (unsigned)__builtin_amdgcn_readlane((int)rv0[k], j); rk[k] += (x > rv0[k]) ? 1 : 0; }
        }
#pragma unroll
        for (int k = 0; k < 4; ++k) {
            if (mq[k] <= 64 && lane < mq[k] && rk[k] < ndq[k]) {
                const int key = 8191 - (int)(rv0[k] & 8191u);
                const int tile = key >> 6, pp = (key >> 5) & 1, k5 = key & 31, khi = (k5 >> 2) & 1, r = (k5 & 3) + 4 * (k5 >> 3);
                atomicOr(MASK + (size_t)tile * 64 + (wave * 4 + k) + 32 * khi, 1u << (16 * pp + r));
            }
        }
#pragma unroll 1
        for (int k = 0; k < 4; ++k) {
            const int qq = wave * 4 + k;
            const int m = __builtin_amdgcn_readfirstlane((int)min(ccnt[qq], 1024u)), nd = __builtin_amdgcn_readfirstlane(need[qq]);
            if (m <= 64) continue;
            const int jmax = (m + 63) >> 6;
            unsigned rv[16];
#pragma unroll
            for (int j = 0; j < 16; ++j) rv[j] = (j < jmax && lane + 64 * j < m) ? rec[qq * 1024 + lane + 64 * j] : 0u;
            unsigned theta = 0u;
            if (jmax <= 4) {
#pragma unroll 1
                for (int bit = 31; bit >= 0; --bit) {
                    const unsigned cand = theta | (1u << bit);
                    const int cnt = __popcll(__ballot(rv[0] >= cand)) + __popcll(__ballot(rv[1] >= cand)) + __popcll(__ballot(rv[2] >= cand)) + __popcll(__ballot(rv[3] >= cand));
                    theta = (cnt >= nd) ? cand : theta;
                }
            } else {
#pragma unroll 1
                for (int bit = 31; bit >= 0; --bit) {
                    const unsigned cand = theta | (1u << bit);
                    int cnt = 0;
#pragma unroll
                    for (int j = 0; j < 16; ++j) cnt += __popcll(__ballot(rv[j] >= cand));
                    theta = (cnt >= nd) ? cand : theta;
                }
            }
#pragma unroll
            for (int j = 0; j < 16; ++j) {
                if (j < jmax && lane + 64 * j < m && rv[j] >= theta) {
                    const int key = 8191 - (int)(rv[j] & 8191u);
                    const int tile = key >> 6, pp = (key >> 5) & 1, k5 = key & 31, khi = (k5 >> 2) & 1, r = (k5 & 3) + 4 * (k5 >> 3);
                    atomicOr(MASK + (size_t)tile * 64 + qq + 32 * khi, 1u << (16 * pp + r));
                }
            }
        }
        }
    }
    __syncthreads();
}

__device__ __forceinline__ void phase_indexer(const Params& p, LAS unsigned char* lds) {
    for (int i = blockIdx.x; i < 256; i += gridDim.x) {
        const int b = (i & 7) >> 1, j = ((i & 1) << 5) + (i >> 3);
        indexer_unit(p, lds, b, 255 - j);
        indexer_unit(p, lds, b, 128 + j);
        indexer_unit(p, lds, b, 127 - j);
        indexer_unit(p, lds, b, j);
    }
}

#include <hip/hip_bf16.h>
#include <cmath>
namespace attn_body {
using bf16=__hip_bfloat16;
using bf16x8=__attribute__((ext_vector_type(8)))short;
using s16x4=__attribute__((ext_vector_type(4)))short;
using f32x16=__attribute__((ext_vector_type(16)))float;
using u32x4=__attribute__((ext_vector_type(4)))unsigned;
constexpr int BATCH=4,NHEAD=8,SEQ=8192,D=64,DM=NHEAD*D;
constexpr int NW=8,QBLK=32,QB=QBLK*NW,KVBLK=64,NQB=SEQ/QB;
constexpr int ATTN_PITCH=DM, ATTN_UNIT_ROWS=QB;
__device__ __forceinline__ int crow(int r,int hi){return (r&3)+8*(r>>2)+4*hi;}
#define SBAR() __builtin_amdgcn_sched_barrier(0)
__device__ __forceinline__ void cmask(f32x16&p0,f32x16&p1,int jb,int qrel,int hi){
  const float NEG=-INFINITY; int kb=64*jb+4*hi;
  #pragma unroll
  for(int r=0;r<16;++r){int kv=kb+(r&3)+8*(r>>2); if(kv>qrel)p0[r]=NEG; if(kv+32>qrel)p1[r]=NEG;}
}

constexpr int NSLOT=3, SLOTB=8192;
constexpr int LDS_K=0, LDS_V=NSLOT*SLOTB, LDS_WS=2*NSLOT*SLOTB, LDS_OST=LDS_WS+NW*64*4, LDS_BYTES=LDS_OST+NW*4096;
constexpr float C2=0.125f*1.4426950408889634f;
__device__ __forceinline__ void glds16(const void*gsrc,unsigned lds_dst){unsigned keep;
  asm volatile("s_mov_b32 %0, m0\n\ts_mov_b32 m0, %2\n\ts_nop 0\n\tglobal_load_lds_dwordx4 %1, off\n\ts_mov_b32 m0, %0":"=&s"(keep):"v"(gsrc),"s"(lds_dst):"memory");}
__device__ __forceinline__ float max3f(float a,float b,float c){float r;asm("v_max3_f32 %0, %1, %2, %3":"=v"(r):"v"(a),"v"(b),"v"(c));return r;}
__device__ __forceinline__ float max2f(float a,float b){float r;asm("v_max_f32_e32 %0, %1, %2":"=v"(r):"v"(a),"v"(b));return r;}
__device__ __forceinline__ float fadd_s(float a,float b){float r;asm("v_add_f32_e32 %0, %1, %2":"=v"(r):"v"(a),"v"(b));return r;}
__device__ __forceinline__ float fsub_s(float a,float b){float r;asm("v_sub_f32_e32 %0, %1, %2":"=v"(r):"v"(a),"v"(b));return r;}
typedef float f32x2_t __attribute__((ext_vector_type(2))); typedef __bf16 bf16x2_t __attribute__((ext_vector_type(2)));
__device__ __forceinline__ unsigned cvtpk_s(float lo,float hi){f32x2_t v={lo,hi};bf16x2_t b=__builtin_convertvector(v,bf16x2_t);return __builtin_bit_cast(unsigned,b);}
#define WAIT_BAR(N) asm volatile("s_waitcnt vmcnt(" #N ") lgkmcnt(0)\n\ts_barrier":::"memory")

__device__ __forceinline__ void qkt(f32x16&p0,f32x16&p1,const char*Kslot,const bf16x8*qr,const f32x16&negm,int r32,int hi){
  const char*kb=Kslot+hi*1024+r32*16;
  #pragma unroll
  for(int d0=0;d0<4;++d0){
    const bf16x8 b0=*reinterpret_cast<const bf16x8*>(kb+d0*2048);
    const bf16x8 b1=*reinterpret_cast<const bf16x8*>(kb+d0*2048+512);
    if(d0==0){p0=__builtin_amdgcn_mfma_f32_32x32x16_bf16(b0,qr[0],negm,0,0,0);p1=__builtin_amdgcn_mfma_f32_32x32x16_bf16(b1,qr[0],negm,0,0,0);}
    else{p0=__builtin_amdgcn_mfma_f32_32x32x16_bf16(b0,qr[d0],p0,0,0,0);p1=__builtin_amdgcn_mfma_f32_32x32x16_bf16(b1,qr[d0],p1,0,0,0);}}
}
typedef __attribute__((address_space(3))) const char* lds_cptr;
typedef short v4i16_t __attribute__((ext_vector_type(4)));
__device__ __forceinline__ void kload8(bf16x8*kf,lds_cptr kp){
  kf[0]=*(const __attribute__((address_space(3))) bf16x8*)(kp);      kf[1]=*(const __attribute__((address_space(3))) bf16x8*)(kp+512);
  kf[2]=*(const __attribute__((address_space(3))) bf16x8*)(kp+2048); kf[3]=*(const __attribute__((address_space(3))) bf16x8*)(kp+2560);
  kf[4]=*(const __attribute__((address_space(3))) bf16x8*)(kp+4096); kf[5]=*(const __attribute__((address_space(3))) bf16x8*)(kp+4608);
  kf[6]=*(const __attribute__((address_space(3))) bf16x8*)(kp+6144); kf[7]=*(const __attribute__((address_space(3))) bf16x8*)(kp+6656);
}
__device__ __forceinline__ void kload2(bf16x8*kf,lds_cptr kp,int j){ kf[2*j]=*(const __attribute__((address_space(3))) bf16x8*)(kp+j*2048); kf[2*j+1]=*(const __attribute__((address_space(3))) bf16x8*)(kp+j*2048+512); }
__device__ __forceinline__ s16x4 vtr(lds_cptr p){ return __builtin_bit_cast(s16x4,__builtin_amdgcn_ds_read_tr16_b64_v4i16((__attribute__((address_space(3))) v4i16_t*)p)); }
__device__ __forceinline__ float rowmax(const f32x16&p0,const f32x16&p1){
  float a=max3f(p0[0],p0[1],p1[0]),b=max3f(p0[2],p0[3],p1[1]);a=max3f(a,p1[2],p1[3]);
  #pragma unroll
  for(int r=4;r<16;r+=4){a=max3f(a,p0[r],p0[r+1]);b=max3f(b,p0[r+2],p0[r+3]);a=max3f(a,p1[r],p1[r+1]);b=max3f(b,p1[r+2],p1[r+3]);}
  const float m=max2f(a,b);
  auto rr=__builtin_amdgcn_permlane32_swap(__float_as_uint(m),__float_as_uint(m),false,false);
  return max2f(__uint_as_float(rr[0]),__uint_as_float(rr[1]));
}
__device__ __forceinline__ void pv(f32x16*o,int vb,bf16x8 pa0,bf16x8 pa1,bf16x8 pa2,bf16x8 pa3){
  #pragma unroll
  for(int d0=0;d0<2;++d0){s16x4 lo[4],hi[4];
    #pragma unroll
    for(int ks=0;ks<4;++ks){
      asm volatile("ds_read_b64_tr_b16 %0,%1 offset:%c2":"=&v"(lo[ks]):"v"(vb),"i"(d0*4096+ks*1024):"memory");
      asm volatile("ds_read_b64_tr_b16 %0,%1 offset:%c2":"=&v"(hi[ks]):"v"(vb),"i"(d0*4096+ks*1024+512):"memory");}
    asm volatile("s_waitcnt lgkmcnt(0)":::"memory");SBAR();
    #define PK(k) (bf16x8){lo[k][0],lo[k][1],lo[k][2],lo[k][3],hi[k][0],hi[k][1],hi[k][2],hi[k][3]}
    o[d0]=__builtin_amdgcn_mfma_f32_32x32x16_bf16(pa0,PK(0),o[d0],0,0,0);
    o[d0]=__builtin_amdgcn_mfma_f32_32x32x16_bf16(pa1,PK(1),o[d0],0,0,0);
    o[d0]=__builtin_amdgcn_mfma_f32_32x32x16_bf16(pa2,PK(2),o[d0],0,0,0);
    o[d0]=__builtin_amdgcn_mfma_f32_32x32x16_bf16(pa3,PK(3),o[d0],0,0,0);
    #undef PK
  }
}

#ifndef ATTN_STORE16
#define ATTN_STORE16(p,v) (*(u32x4*)(p)=(v))
#endif
template<int THRL> __device__ __forceinline__ void attn_unit(int b,int h,int qb,const bf16*Q,const bf16*__restrict__ K,const bf16*__restrict__ V,bf16*O,const unsigned long long*MASK64,char*shm){
  int tid_=threadIdx.x; asm volatile("":"+v"(tid_)); const int tid=tid_,lane=tid&63,r32=lane&31,hi=lane>>5; const int wid=__builtin_amdgcn_readfirstlane(tid>>6);
  const long rowbase=(long)b*SEQ; const int q0=qb*QB;
  const bf16*Qw=Q+(rowbase+q0+wid*QBLK)*DM+h*D;
  const bf16*Kh=K+rowbase*DM+h*D,*Vh=V+rowbase*DM+h*D;
  const unsigned lds0=(unsigned)(uintptr_t)shm;
  float*wsf=(float*)(shm+LDS_WS)+wid*64;
  const bf16*ksrc=Kh+(long)lane*DM+wid*8;
  const bf16*vsrc=Vh+(long)(16*(wid&3)+(lane>>2))*DM+(wid>>2)*32+(lane&3)*8;
  const unsigned kdst=lds0+LDS_K+wid*1024, vdst=lds0+LDS_V+wid*1024;
  #define DMA_K(t,slot) glds16(ksrc+(long)(t)*KVBLK*DM,(unsigned)__builtin_amdgcn_readfirstlane(kdst+(slot)))
  #define DMA_V(t,slot) glds16(vsrc+(long)(t)*KVBLK*DM,(unsigned)__builtin_amdgcn_readfirstlane(vdst+(slot)))
  const int vb0=(int)(lds0+LDS_V)+((lane>>4)&1)*32+(lane&3)*8+(4*hi+((lane&15)>>2))*64;
  const char*Kbase=shm+LDS_K; bf16x8 kf[8];
  const lds_cptr shm3=(lds_cptr)shm; const lds_cptr kp0=shm3+LDS_K+hi*1024+r32*16; const lds_cptr vp0=shm3+LDS_V+((lane>>4)&1)*32+(lane&3)*8+(4*hi+((lane&15)>>2))*64;
  const int NT=(q0+QB)/KVBLK;
  DMA_K(0,0);DMA_V(0,0);DMA_K(1,SLOTB);
  bf16x8 qr[4];
  #pragma unroll
  for(int d0=0;d0<4;++d0)qr[d0]=*reinterpret_cast<const bf16x8*>(&Qw[(long)r32*DM+d0*16+hi*8]);
  float mhat=0.f,l_reg=0.f;f32x16 o[2];o[0]=f32x16{};o[1]=f32x16{};f32x16 negm=f32x16{};asm volatile("":"+v"(negm));
  const int qrel=wid*QBLK+r32; (void)qrel;
  const char*mbase=(const char*)MASK64+((size_t)(b*256+qb*8+wid)*128)*256;
  const unsigned moff=(unsigned)lane*4u;
  unsigned mwcur=*(const unsigned*)(mbase+moff);
  #define MASK_NEXT(t) do{ if(((t)+1)<NT){ const unsigned long long ma_=(unsigned long long)(uintptr_t)(mbase+(size_t)((t)+1)*256); \
      asm volatile("s_nop 4\n\tglobal_load_dword %0, %1, %2":"=v"(mwcur):"v"(moff),"s"(ma_):"memory"); } }while(0)
#define MLOAD(t)
#define CMASK(P0,P1,t) do{ const unsigned w_=mwcur; \
    _Pragma("unroll") for(int r=0;r<16;++r){ const int m0_=((int)(w_<<(31-r)))>>31, m1_=((int)(w_<<(15-r)))>>31; \
      P0[r]=__uint_as_float((__float_as_uint(P0[r])&(unsigned)m0_)|(0xFF800000u&~(unsigned)m0_)); P1[r]=__uint_as_float((__float_as_uint(P1[r])&(unsigned)m1_)|(0xFF800000u&~(unsigned)m1_)); } \
    asm volatile("":"+v"(P0),"+v"(P1)); MASK_NEXT(t); }while(0)
  bool resc=false;
  #define START(P0,P1) do{ const float rm=rowmax(P0,P1); resc=false; \
    { const float dl=__builtin_fmaxf(rm,-60.f); mhat=fadd_s(mhat,dl); \
      _Pragma("unroll") for(int r=0;r<16;++r){P0[r]=fsub_s(P0[r],dl);P1[r]=fsub_s(P1[r],dl);} \
      _Pragma("unroll") for(int r=0;r<16;++r)negm[r]=-mhat; asm volatile("":"+v"(negm)); } \
    _Pragma("unroll") for(int r=0;r<16;++r)P0[r]=__builtin_amdgcn_exp2f(P0[r]); }while(0)
  #define RESC() do{ if(resc){ asm volatile("s_waitcnt lgkmcnt(0)":::"memory"); \
      _Pragma("unroll") for(int d_=0;d_<2;++d_) _Pragma("unroll") for(int r=0;r<16;++r)o[d_][r]*=wsf[crow(r,hi)]; } }while(0)
  f32x16 pA0,pA1,pB0,pB1;
  int sl_prev=0,sl_cur=0,sl_next=SLOTB;
  #define ROT() do{sl_prev=sl_cur;sl_cur=sl_next;sl_next=(sl_next==(NSLOT-1)*SLOTB)?0:sl_next+SLOTB;}while(0)
  DMA_K(2,2*SLOTB);
  WAIT_BAR(3);
  { qkt(pA0,pA1,Kbase,qr,negm,r32,hi);asm volatile("s_nop 15\n\ts_nop 7":"+v"(pA0),"+v"(pA1));CMASK(pA0,pA1,0); }
  START(pA0,pA1);
  _Pragma("unroll") for(int r=0;r<16;++r)pA1[r]=__builtin_amdgcn_exp2f(pA1[r]);
  WAIT_BAR(0);
  DMA_K(3,0);DMA_V(1,SLOTB);
  ROT();
  kload8(kf,kp0+sl_cur);
  WAIT_BAR(2);
  s16x4 vlo[8],vhi[8]; u32x4 pw0,pw1,pw2,pw3;
  #define PKW(P,B) cvtpk_s(P[B],P[B+1])
  #define PAF(k) __builtin_bit_cast(bf16x8,pw##k)
  #define VFR(i) (bf16x8){vlo[i][0],vlo[i][1],vlo[i][2],vlo[i][3],vhi[i][0],vhi[i][1],vhi[i][2],vhi[i][3]}
  #define PIN(x) asm volatile("":"+v"(x))
  #define MX3(a,b,c) __builtin_fmaxf(__builtin_fmaxf((a),(b)),(c))
  #define GAPA(MF,A0,A1,A2,A3,W0,W1,PW) do{ MF; sacc+=A0; sacc+=A1; sacc+=A2; sacc+=A3; PIN(sacc); W0; W1; PIN(PW); SBAR(); }while(0)
  #define EX(v) __builtin_amdgcn_exp2f(v)
  #define GAPB(MF,X,B) do{ MF; X[B]=EX(X[B]); X[B+1]=EX(X[B+1]); X[B+2]=EX(X[B+2]); X[B+3]=EX(X[B+3]); PIN(X); SBAR(); }while(0)
  #define VRD(i) do{ vlo[i]=vtr(vp_+(((i)>>2)*4096+((i)&3)*1024)); vhi[i]=vtr(vp_+(((i)>>2)*4096+((i)&3)*1024+512)); }while(0)
  #define KRD(G,j) do{ if(G){ kload2(kf,kp0+sl_next,j); SBAR(); } }while(0)
  #define STEP(C0,C1,P0,P1,t,GK,GV,GL) do{ SBAR(); \
    const lds_cptr vp_=vp0+sl_prev; \
    VRD(0); SBAR(); float sacc=(P0[0]+P0[1]); \
    GAPA(C0=__builtin_amdgcn_mfma_f32_32x32x16_bf16(kf[0],qr[0],negm,0,0,0), P0[2],P0[3],P0[4],P0[5],     pw0[0]=PKW(P0,0), pw0[1]=PKW(P0,2), pw0); \
    VRD(4); SBAR(); GAPA(C1=__builtin_amdgcn_mfma_f32_32x32x16_bf16(kf[1],qr[0],negm,0,0,0), P0[6],P0[7],P0[8],P0[9],     pw0[2]=PKW(P0,4), pw0[3]=PKW(P0,6), pw0); \
    VRD(1); SBAR(); GAPA(C0=__builtin_amdgcn_mfma_f32_32x32x16_bf16(kf[2],qr[1],C0,0,0,0),   P0[10],P0[11],P0[12],P0[13], pw1[0]=PKW(P0,8), pw1[1]=PKW(P0,10), pw1); \
    VRD(5); SBAR(); GAPA(C1=__builtin_amdgcn_mfma_f32_32x32x16_bf16(kf[3],qr[1],C1,0,0,0),   P0[14],P0[15],P1[0],P1[1],   pw1[2]=PKW(P0,12),pw1[3]=PKW(P0,14), pw1); \
    VRD(2); SBAR(); GAPA(C0=__builtin_amdgcn_mfma_f32_32x32x16_bf16(kf[4],qr[2],C0,0,0,0),   P1[2],P1[3],P1[4],P1[5],     pw2[0]=PKW(P1,0), pw2[1]=PKW(P1,2), pw2); \
    VRD(6); SBAR(); GAPA(C1=__builtin_amdgcn_mfma_f32_32x32x16_bf16(kf[5],qr[2],C1,0,0,0),   P1[6],P1[7],P1[8],P1[9],     pw2[2]=PKW(P1,4), pw2[3]=PKW(P1,6), pw2); \
    VRD(3); SBAR(); GAPA(C0=__builtin_amdgcn_mfma_f32_32x32x16_bf16(kf[6],qr[3],C0,0,0,0),   P1[10],P1[11],P1[12],P1[13], pw3[0]=PKW(P1,8), pw3[1]=PKW(P1,10), pw3); \
    VRD(7); SBAR(); GAPA(C1=__builtin_amdgcn_mfma_f32_32x32x16_bf16(kf[7],qr[3],C1,0,0,0),   P1[14],P1[15],0.f,0.f,       pw3[2]=PKW(P1,12),pw3[3]=PKW(P1,14), pw3); \
    l_reg+=sacc; \
    CMASK(C0,C1,t); \
    if(GK){DMA_K((t)+3,sl_cur);} if(GV){DMA_V((t)+1,sl_next);} \
    { float a=MX3(C0[0],C0[1],C1[0]),b=MX3(C0[2],C0[3],C1[1]); a=MX3(a,C1[2],C1[3]); \
      _Pragma("unroll") for(int r=4;r<16;r+=4){a=MX3(a,C0[r],C0[r+1]);b=MX3(b,C0[r+2],C0[r+3]);a=MX3(a,C1[r],C1[r+1]);b=MX3(b,C1[r+2],C1[r+3]);} \
      float rm=__builtin_fmaxf(a,b); { auto rr=__builtin_amdgcn_permlane32_swap(__float_as_uint(rm),__float_as_uint(rm),false,false); rm=__builtin_fmaxf(__uint_as_float(rr[0]),__uint_as_float(rr[1])); } \
      resc=false; \
      if(__builtin_expect(__any(rm>(float)THRL),0)){ const float dl=__builtin_fmaxf(rm,0.f); mhat+=dl; \
        _Pragma("unroll") for(int r=0;r<16;++r){C0[r]-=dl;C1[r]-=dl;} \
        _Pragma("unroll") for(int r=0;r<16;++r)negm[r]=-mhat; asm volatile("":"+v"(negm)); \
        const float f=__builtin_amdgcn_exp2f(-dl); l_reg*=f; if(hi==0)wsf[r32]=f; resc=true; } } \
    SBAR(); \
    GAPB(o[0]=__builtin_amdgcn_mfma_f32_32x32x16_bf16(PAF(0),VFR(0),o[0],0,0,0), C0,0); \
    GAPB(o[1]=__builtin_amdgcn_mfma_f32_32x32x16_bf16(PAF(0),VFR(4),o[1],0,0,0), C0,4); \
    KRD(GL,0); GAPB(o[0]=__builtin_amdgcn_mfma_f32_32x32x16_bf16(PAF(1),VFR(1),o[0],0,0,0), C0,8); \
    KRD(GL,1); GAPB(o[1]=__builtin_amdgcn_mfma_f32_32x32x16_bf16(PAF(1),VFR(5),o[1],0,0,0), C0,12); \
    KRD(GL,2); GAPB(o[0]=__builtin_amdgcn_mfma_f32_32x32x16_bf16(PAF(2),VFR(2),o[0],0,0,0), C1,0); \
    KRD(GL,3); GAPB(o[1]=__builtin_amdgcn_mfma_f32_32x32x16_bf16(PAF(2),VFR(6),o[1],0,0,0), C1,4); \
    GAPB(o[0]=__builtin_amdgcn_mfma_f32_32x32x16_bf16(PAF(3),VFR(3),o[0],0,0,0), C1,8); \
    GAPB(o[1]=__builtin_amdgcn_mfma_f32_32x32x16_bf16(PAF(3),VFR(7),o[1],0,0,0), C1,12); \
    }while(0)
  int t=1;
  for(;t+5<NT;t+=2){
    STEP(pB0,pB1,pA0,pA1,t,true,true,true);     WAIT_BAR(2); RESC(); ROT();
    STEP(pA0,pA1,pB0,pB1,t+1,true,true,true);   WAIT_BAR(2); RESC(); ROT();
  }
  #define ENDW(tt) do{ if((tt)+3<NT){WAIT_BAR(2);} else if((tt)+2<NT){WAIT_BAR(1);} else {WAIT_BAR(0);} }while(0)
  for(;t+1<NT;t+=2){
    STEP(pB0,pB1,pA0,pA1,t,(t+3<NT),(t+1<NT),(t+1<NT));       ENDW(t);   RESC(); ROT();
    STEP(pA0,pA1,pB0,pB1,t+1,(t+4<NT),(t+2<NT),(t+2<NT));     ENDW(t+1); RESC(); ROT();
  }
  STEP(pB0,pB1,pA0,pA1,NT-1,false,false,false); RESC();
  { float sacc=pB0[0]+pB0[1]; _Pragma("unroll") for(int r=2;r<16;++r)sacc+=pB0[r]; _Pragma("unroll") for(int r=0;r<16;++r)sacc+=pB1[r]; l_reg+=sacc;
    pw0=(u32x4){PKW(pB0,0),PKW(pB0,2),PKW(pB0,4),PKW(pB0,6)};pw1=(u32x4){PKW(pB0,8),PKW(pB0,10),PKW(pB0,12),PKW(pB0,14)};pw2=(u32x4){PKW(pB1,0),PKW(pB1,2),PKW(pB1,4),PKW(pB1,6)};pw3=(u32x4){PKW(pB1,8),PKW(pB1,10),PKW(pB1,12),PKW(pB1,14)};
    SBAR(); pv(o,vb0+sl_cur,PAF(0),PAF(1),PAF(2),PAF(3)); }
  #undef PKW
  #undef PAF
  #undef VFR
  #undef PIN
  #undef MX3
  #undef GAPA
  #undef GAPB
  #undef EX
  #undef VRD
  #undef KRD
  #undef STEP
  #undef ENDW
  {auto rr=__builtin_amdgcn_permlane32_swap(__float_as_uint(l_reg),__float_as_uint(l_reg),false,false);l_reg=__uint_as_float(rr[0])+__uint_as_float(rr[1]);}
  if(hi==0)wsf[32+r32]=l_reg;asm volatile("s_waitcnt lgkmcnt(0)":::"memory");
  float rli[16];
  #pragma unroll
  for(int r=0;r<16;++r)rli[r]=__builtin_amdgcn_rcpf(wsf[32+crow(r,hi)]);
  bf16*Ow=O+(rowbase+q0+wid*QBLK)*DM+h*D;
  { bf16*stg=(bf16*)(shm+LDS_OST)+wid*2048;
    #pragma unroll
    for(int r=0;r<16;++r){const int orow=crow(r,hi);
      #pragma unroll
      for(int d0=0;d0<2;++d0)stg[orow*64+d0*32+r32]=__float2bfloat16(o[d0][r]*rli[r]);}
    asm volatile("s_waitcnt lgkmcnt(0)":::"memory");
    #pragma unroll
    for(int i=0;i<4;++i){const int row=i*8+(lane>>3),ch=lane&7; const u32x4 v=*(const u32x4*)(stg+row*64+ch*8); ATTN_STORE16(Ow+(long)row*DM+ch*8,v);} }
  asm volatile("s_waitcnt lgkmcnt(0)\n\ts_barrier":::"memory");
  #undef DMA_K
  #undef DMA_V
  #undef CMASK
  #undef START
  #undef RESC
  #undef ROT
}
constexpr int ATTN_LDS_BYTES=LDS_BYTES;
struct AttnTensors { const bf16* Q; const bf16* K; const bf16* V; bf16* O; const unsigned long long* M; };
struct AttnUnit { int bh; int qb; };
struct StaticOrder {
  int vcu;
  __device__ __forceinline__ explicit StaticOrder(int grid,int block):vcu((block%8)*(grid/8)+block/8){}
  __device__ __forceinline__ bool next(int i,AttnUnit&u)const{ if(i>=4)return false; const int s=vcu&7; u.bh=vcu>>3; u.qb=(i==0)?s:(i==1)?15-s:(i==2)?16+s:31-s; return true; }
  __device__ __forceinline__ void a_ready(const AttnUnit&)const{}
  __device__ __forceinline__ void done(const AttnUnit&)const{}
};
template<class Sched,int THRL=8> __device__ __forceinline__ void attn_phase(char*lds,const AttnTensors&T,const Sched&S){
  AttnUnit u;
  for(int i=0;S.next(i,u);++i){ S.a_ready(u); attn_unit<THRL>(u.bh/NHEAD,u.bh%NHEAD,u.qb,T.Q,T.K,T.V,T.O,T.M,lds); S.done(u); }
}
#undef SBAR
#undef WAIT_BAR
}

__device__ __forceinline__ unsigned sortable_u32(float s) { const unsigned b = __float_as_uint(s); return (b & 0x80000000u) ? ~b : (b | 0x80000000u); }

__device__ __forceinline__ void attn_simple_body(const Params& p, unsigned* sc, float* qs, int wslot, int nslots, int lane) {
    const bf16* IQ = (const bf16*)(p.ws + WS_IQ); const bf16* IK = (const bf16*)(p.ws + WS_IK); const float* IW = (const float*)(p.ws + WS_IW);
    const bf16* AQ = (const bf16*)(p.ws + WS_AQ); const bf16* AK = (const bf16*)(p.ws + WS_AK); const bf16* AV = (const bf16*)(p.ws + WS_AV);
    bf16* YA = (bf16*)(p.ws + WS_YA);
    const int nq = T;
    for (int qi = wslot; qi < nq; qi += nslots) {
        const int b = qi >> 13; int t = qi & (SEQ - 1);
        t = (t & 1) ? (SEQ - 1 - (t >> 1)) : (t >> 1);
        const size_t tok = (size_t)b * SEQ + t; const int n = t + 1;
        for (int e = lane; e < 256; e += 64) { const int h = e >> 6, d = e & 63; qs[d * 4 + h] = bf2f(IQ[tok * 256 + e]); }
        const f32x4 w4 = *(const f32x4*)(IW + tok * 4);
        asm volatile("s_waitcnt lgkmcnt(0)" ::: "memory");
#ifndef MASK_ONLY
        for (int j0 = 0; j0 < n; j0 += 64) {
            const int s = j0 + lane;
            if (s < n) {
                const u32x4* kp = (const u32x4*)(IK + ((size_t)b * SEQ + s) * 64);
                float a0 = 0.f, a1 = 0.f, a2 = 0.f, a3 = 0.f;
#pragma unroll
                for (int c = 0; c < 8; ++c) {
                    const u32x4 kv = kp[c];
                    const unsigned kw[4] = {kv.x, kv.y, kv.z, kv.w};
#pragma unroll
                    for (int i = 0; i < 4; ++i) {
                        const float k0 = __uint_as_float(kw[i] << 16), k1 = __uint_as_float(kw[i] & 0xffff0000u);
                        const f32x4 q0 = *(const f32x4*)(qs + (c * 8 + 2 * i) * 4), q1 = *(const f32x4*)(qs + (c * 8 + 2 * i + 1) * 4);
                        a0 += q0[0] * k0 + q1[0] * k1; a1 += q0[1] * k0 + q1[1] * k1; a2 += q0[2] * k0 + q1[2] * k1; a3 += q0[3] * k0 + q1[3] * k1;
                    }
                }
                float score = w4[0] * fmaxf(a0, 0.f) + w4[1] * fmaxf(a1, 0.f) + w4[2] * fmaxf(a2, 0.f) + w4[3] * fmaxf(a3, 0.f);
                score += 0.0f;
                sc[s] = sortable_u32(score);
            }
        }
        asm volatile("s_waitcnt lgkmcnt(0)" ::: "memory");
        unsigned theta = 0u; int cut = SEQ;
        if (n > 256) {
            for (int bit = 31; bit >= 0; --bit) {
                const unsigned cand = theta | (1u << bit);
                int cnt = 0;
                for (int s = lane; s < n; s += 64) cnt += (sc[s] >= cand) ? 1 : 0;
                cnt = (int)wave_sum((float)cnt);
                if (cnt >= 256) theta = cand;
            }
            int cgt = 0;
            for (int s = lane; s < n; s += 64) cgt += (sc[s] > theta) ? 1 : 0;
            cgt = (int)wave_sum((float)cgt);
            const int r = 256 - cgt;
            int x = 0;
            for (int bit = 12; bit >= 0; --bit) {
                const int xc = x | (1 << bit);
                int cnt = 0;
                for (int s = lane; s < n; s += 64) cnt += (sc[s] == theta && s < xc) ? 1 : 0;
                cnt = (int)wave_sum((float)cnt);
                if (cnt < r) x = xc;
            }
            cut = x;
        }
#else
        const unsigned theta = 0u; const int cut = SEQ;
#endif
        float q[8], o[8];
        { const u32x4 qv = *(const u32x4*)(AQ + tok * 512 + lane * 8); const unsigned qw[4] = {qv.x, qv.y, qv.z, qv.w};
#pragma unroll
          for (int i = 0; i < 4; ++i) { q[2 * i] = __uint_as_float(qw[i] << 16); q[2 * i + 1] = __uint_as_float(qw[i] & 0xffff0000u); } }
#pragma unroll
        for (int i = 0; i < 8; ++i) o[i] = 0.f;
        float mrun = -INFINITY, lsum = 0.f;
        for (int j0 = 0; j0 < n; j0 += 64) {
            const int s = j0 + lane;
            bool sel = false;
#ifndef MASK_ONLY
            if (s < n) { const unsigned u = sc[s]; sel = (u > theta) || (u == theta && s <= cut); }
#endif
#if defined(CHECK_MASK) || defined(MASK_ONLY)
            {
                const unsigned* MB = (const unsigned*)(p.ws + WS_MASK) + (((size_t)(b * 256 + (t >> 5)) * 128) + (j0 >> 6)) * 64;
                const int pp = lane >> 5, k5 = lane & 31, khi = (k5 >> 2) & 1, rr = (k5 & 3) + 4 * (k5 >> 3);
                const bool selm = (MB[(t & 31) + 32 * khi] >> (16 * pp + rr)) & 1u;
#ifndef MASK_ONLY
                const unsigned long long diff = __ballot(selm != sel);
                if (diff && lane == 0) atomicAdd((unsigned*)(p.ws + WS_CTL) + CW_MISMATCH, (unsigned)__popcll(diff));
#endif
                sel = (s < n) && selm;
            }
#endif
            unsigned long long mask = __ballot(sel);
            while (mask) {
                const int bit = __builtin_ctzll(mask); mask &= mask - 1;
                const size_t kt = (size_t)b * SEQ + j0 + bit;
                const u32x4 kv = *(const u32x4*)(AK + kt * 512 + lane * 8);
                const u32x4 vv = *(const u32x4*)(AV + kt * 512 + lane * 8);
                const unsigned kw[4] = {kv.x, kv.y, kv.z, kv.w}, vw[4] = {vv.x, vv.y, vv.z, vv.w};
                float dot = 0.f;
#pragma unroll
                for (int i = 0; i < 4; ++i) dot += q[2 * i] * __uint_as_float(kw[i] << 16) + q[2 * i + 1] * __uint_as_float(kw[i] & 0xffff0000u);
                dot += __shfl_xor(dot, 1); dot += __shfl_xor(dot, 2); dot += __shfl_xor(dot, 4);
                const float mn = fmaxf(mrun, dot);
                const float scl = exp2f(mrun - mn), pr = exp2f(dot - mn);
                lsum = lsum * scl + pr;
#pragma unroll
                for (int i = 0; i < 4; ++i) {
                    o[2 * i] = o[2 * i] * scl + pr * __uint_as_float(vw[i] << 16);
                    o[2 * i + 1] = o[2 * i + 1] * scl + pr * __uint_as_float(vw[i] & 0xffff0000u);
                }
                mrun = mn;
            }
        }
        const float inv = 1.0f / lsum;
        u32x4 w; w.x = pk2(o[0] * inv, o[1] * inv); w.y = pk2(o[2] * inv, o[3] * inv); w.z = pk2(o[4] * inv, o[5] * inv); w.w = pk2(o[6] * inv, o[7] * inv);
#ifdef CHECK_YA
        {   const u32x4 y = *(const u32x4*)(YA + tok * 512 + lane * 8); const unsigned yw[4] = {y.x, y.y, y.z, y.w}; float dmax = 0.f;
#pragma unroll
            for (int i = 0; i < 4; ++i) { dmax = fmaxf(dmax, fabsf(o[2 * i] * inv - __uint_as_float(yw[i] << 16))); dmax = fmaxf(dmax, fabsf(o[2 * i + 1] * inv - __uint_as_float(yw[i] & 0xffff0000u))); }
            dmax = wave_max(dmax);
            if (lane == 0) atomicMax((unsigned*)(p.ws + WS_CTL) + CW_MISMATCH, __float_as_uint(dmax)); }
#else
        *(u32x4*)(YA + tok * 512 + lane * 8) = w;
#endif
    }
}

__global__ void __launch_bounds__(256) k_attn_simple(Params p) {
    extern __shared__ __attribute__((aligned(16))) unsigned char lds_raw[];
    const int tid = threadIdx.x, lane = tid & 63, wave = tid >> 6;
    attn_simple_body(p, (unsigned*)(lds_raw + wave * 32768), (float*)(lds_raw + 131072 + wave * 1024), blockIdx.x * 4 + wave, gridDim.x * 4, lane);
}

constexpr int LQ = 72, LS = 136;

__device__ __forceinline__ f32x4 mfma16(const LAS bf16* Arow, const LAS bf16* Brow, f32x4 acc) {
    const bf16x8 a = *(const LAS bf16x8*)Arow, b = *(const LAS bf16x8*)Brow;
    return __builtin_amdgcn_mfma_f32_16x16x32_bf16(a, b, acc, 0, 0, 0);
}

struct ConvRegs { u32x4 x[2][4]; };
__device__ __forceinline__ void conv_load(ConvRegs& R, int tid, const bf16* src, int b, int c, int h) {
#pragma unroll
    for (int k = 0; k < 2; ++k) {
        const int task = tid + 512 * k, r = task >> 3, ch = task & 7;
        const int t = c * 128 + r;
        const bf16* base = src + ((size_t)b * SEQ) * 512 + h * 64 + ch * 8;
#pragma unroll
        for (int j = 0; j < 4; ++j) { const int tt = t - 3 + j; R.x[k][j] = (tt >= 0) ? *(const u32x4*)(base + (size_t)tt * 512) : (u32x4){0u, 0u, 0u, 0u}; }
    }
}
template <class F>
__device__ __forceinline__ void conv_emit(const ConvRegs& R, int tid, const float* convw, int chbase, int h, F emit) {
#pragma unroll
    for (int k = 0; k < 2; ++k) {
        const int task = tid + 512 * k, r = task >> 3, ch = task & 7;
        const float* wp = convw + chbase + h * 64 + ch * 8;
        float y[8];
#pragma unroll
        for (int e = 0; e < 8; ++e) y[e] = 0.f;
#pragma unroll
        for (int j = 0; j < 4; ++j) {
            const f32x4 wa = *(const f32x4*)(wp + j * 1024), wb = *(const f32x4*)(wp + j * 1024 + 4);
            const unsigned xw[4] = {R.x[k][j].x, R.x[k][j].y, R.x[k][j].z, R.x[k][j].w};
            y[0] += wa[0] * __uint_as_float(xw[0] << 16); y[1] += wa[1] * __uint_as_float(xw[0] & 0xffff0000u);
            y[2] += wa[2] * __uint_as_float(xw[1] << 16); y[3] += wa[3] * __uint_as_float(xw[1] & 0xffff0000u);
            y[4] += wb[0] * __uint_as_float(xw[2] << 16); y[5] += wb[1] * __uint_as_float(xw[2] & 0xffff0000u);
            y[6] += wb[2] * __uint_as_float(xw[3] << 16); y[7] += wb[3] * __uint_as_float(xw[3] & 0xffff0000u);
        }
        const f32x4 ya = {siluf_(y[0]), siluf_(y[1]), siluf_(y[2]), siluf_(y[3])}, yb = {siluf_(y[4]), siluf_(y[5]), siluf_(y[6]), siluf_(y[7])};
        emit(r, ch, ya, yb);
    }
}
__device__ __forceinline__ int tsw(int v, int s) { return v * LS + ((((s >> 3) ^ (v >> 3)) & 15) << 3) + (s & 7); }
__device__ __forceinline__ int tswb(int v, int cb) { return v * LS + (((cb ^ (v >> 3)) & 15) << 3); }
struct VRegs { u32x4 x[4]; };
__device__ __forceinline__ void v_load(VRegs& R, int tid, const bf16* MV, int b, int c, int h) {
    const bf16* base = MV + ((size_t)b * SEQ + c * 128) * 1024 + h * 128;
#pragma unroll
    for (int k = 0; k < 4; ++k) { const int task = tid + 512 * k, s = task >> 4, ch = task & 15; R.x[k] = *(const u32x4*)(base + (size_t)s * 1024 + ch * 8); }
}
__device__ __forceinline__ void v_store_t(const VRegs& R, int tid, LAS bf16* VT) {
#pragma unroll
    for (int k = 0; k < 4; ++k) {
        const int task = tid + 512 * k, s = task >> 4, ch = task & 15;
        const unsigned w[4] = {R.x[k].x, R.x[k].y, R.x[k].z, R.x[k].w};
#pragma unroll
        for (int i = 0; i < 4; ++i) { VT[tsw(ch * 8 + 2 * i, s)] = (bf16)(w[i] & 0xffffu); VT[tsw(ch * 8 + 2 * i + 1, s)] = (bf16)(w[i] >> 16); }
    }
    for (int i = tid; i < 16 * 128; i += 512) { const int r = 128 + (i >> 7), s = i & 127; VT[r * LS + s] = (r == 128) ? (bf16)0x3F80 : (bf16)0; }
}
__device__ __forceinline__ void scan_add2(float x0, float x1, int lane, float& i0, float& i1) {
    float incl = x0 + x1;
#pragma unroll
    for (int o = 1; o < 64; o <<= 1) { const float v = __shfl_up(incl, o); if (lane >= o) incl += v; }
    i1 = incl; i0 = incl - x1;
}
__device__ __forceinline__ void scan_max2(float x0, float x1, int lane, float& i0, float& i1) {
    float incl = fmaxf(x0, x1);
#pragma unroll
    for (int o = 1; o < 64; o <<= 1) { const float v = __shfl_up(incl, o); if (lane >= o) incl = fmaxf(incl, v); }
    const float prev = __shfl_up(incl, 1);
    i1 = incl; i0 = (lane == 0) ? x0 : fmaxf(prev, x0);
}

struct KvRegs { ConvRegs KR; VRegs VR; float f0, f1, i0, i1; };
__device__ __forceinline__ void mlstm_kv_load(const Params& p, KvRegs& R, int tid, int lane, int u) {
    const int c = u & 63, h = (u >> 6) & 7, b = u >> 9;
    const float* MI = (const float*)(p.ws + WS_MI); const float* MF = (const float*)(p.ws + WS_MF);
    const size_t tok0 = (size_t)b * SEQ + c * 128;
    conv_load(R.KR, tid, (const bf16*)(p.ws + WS_MK), b, c, h);
    v_load(R.VR, tid, (const bf16*)(p.ws + WS_MV), b, c, h);
    R.f0 = MF[(tok0 + 2 * lane) * 8 + h]; R.f1 = MF[(tok0 + 2 * lane + 1) * 8 + h];
    R.i0 = MI[(tok0 + 2 * lane) * 8 + h]; R.i1 = MI[(tok0 + 2 * lane + 1) * 8 + h];
}
__device__ __forceinline__ void mlstm_kv_phase(const Params& p, LAS unsigned char* lds) {
    int tid_ = threadIdx.x; asm volatile("" : "+v"(tid_));
    const int tid = tid_, lane = tid & 63, wave = __builtin_amdgcn_readfirstlane(tid >> 6), fr = lane & 15, fq = lane >> 4;
    LAS bf16* VT = (LAS bf16*)lds;
    LAS bf16* WKT = VT + 144 * LS;
    LAS float* wg = (LAS float*)(WKT + 64 * LS);
    KvRegs R;
    int u = blockIdx.x;
    if (u < NUNIT_M) mlstm_kv_load(p, R, tid, lane, u);
#pragma unroll 1
    for (; u < NUNIT_M; u += gridDim.x) {
        const int h = (u >> 6) & 7;
        if (wave == 0) {
            const float lf0 = logsigmoidf_(R.f0), lf1 = logsigmoidf_(R.f1);
            const float i0 = R.i0, i1 = R.i1;
            float b0, b1; scan_add2(lf0, lf1, lane, b0, b1);
            const float blast = __shfl(b1, 63);
            const float g0 = blast - b0 + i0, g1 = blast - b1 + i1;
            const float gmax = wave_max(fmaxf(g0, g1));
            wg[2 * lane] = __expf(g0 - gmax); wg[2 * lane + 1] = __expf(g1 - gmax);
            if (lane == 0) { float* dsc = (float*)(p.ws + WS_DSC) + (size_t)u * 2; dsc[0] = blast; dsc[1] = gmax; }
        }
        __syncthreads();
        conv_emit(R.KR, tid, p.in[3], 512, h, [&](int r, int ch, f32x4 ya, f32x4 yb) { const float w = wg[r];
#pragma unroll
            for (int e = 0; e < 4; ++e) { WKT[tsw(ch * 8 + e, r)] = (bf16)f2bf(ya[e] * w); WKT[tsw(ch * 8 + 4 + e, r)] = (bf16)f2bf(yb[e] * w); } });
        v_store_t(R.VR, tid, VT);
        __syncthreads();
        if (u + (int)gridDim.x < NUNIT_M) { int tl_ = tid; asm volatile("" : "+v"(tl_));
            mlstm_kv_load(p, R, tl_, tl_ & 63, u + gridDim.x); }
        float* DC = (float*)((unsigned char*)p.out + DO_DC) + (size_t)u * 128 * 64;
        float* DN = (float*)(p.ws + WS_DN) + (size_t)u * 64;
#pragma unroll
        for (int ct = 0; ct < 4; ++ct) {
            f32x4 acc = {0.f, 0.f, 0.f, 0.f};
#pragma unroll
            for (int kk = 0; kk < 4; ++kk) acc = mfma16(WKT + tswb(ct * 16 + fr, kk * 4 + fq), VT + tswb(wave * 16 + fr, kk * 4 + fq), acc);
            *(f32x4*)(DC + (size_t)(wave * 16 + fr) * 64 + ct * 16 + 4 * fq) = acc;
        }
        if (wave == 0) {
#pragma unroll
            for (int ct = 0; ct < 4; ++ct) {
                f32x4 acc = {0.f, 0.f, 0.f, 0.f};
#pragma unroll
                for (int kk = 0; kk < 4; ++kk) acc = mfma16(WKT + tswb(ct * 16 + fr, kk * 4 + fq), VT + (128 + fr) * LS + kk * 32 + 8 * fq, acc);
                if (fr == 0) *(f32x4*)(DN + ct * 16 + 4 * fq) = acc;
            }
        }
        __syncthreads();
    }
}

__device__ __forceinline__ void mlstm_scan(const Params& p) {
    int tid_ = threadIdx.x; asm volatile("" : "+v"(tid_));
    const int tid = tid_;
    for (int w = blockIdx.x; w < NB * 8 * 8; w += gridDim.x) {
        const int bh = w >> 3, part = w & 7;
        const float* DC = (const float*)((unsigned char*)p.out + DO_DC);
        const float* DN = (const float*)(p.ws + WS_DN);
        const float* DSC = (const float*)(p.ws + WS_DSC);
        bf16* CST = (bf16*)(p.ws + WS_CST);
        float* MC = (float*)(p.ws + WS_MC);
        const int e0 = part * 1024 + tid, e1 = e0 + 512;
        const bool hasn = (part == 0 && tid < 64);
        float c0 = 0.f, c1 = 0.f, nn = 0.f, m = 0.f;
        float d0n[8], d1n[8], dnn[8], bln[8], gmn[8];
#pragma unroll
        for (int k = 0; k < 8; ++k) {
            const size_t u = (size_t)bh * 64 + k;
            d0n[k] = DC[u * 8192 + e0]; d1n[k] = DC[u * 8192 + e1]; dnn[k] = hasn ? DN[u * 64 + tid] : 0.f;
            bln[k] = DSC[u * 2]; gmn[k] = DSC[u * 2 + 1];
        }
#pragma unroll 1
        for (int cb = 0; cb < NCHUNK; cb += 8) {
            float d0[8], d1[8], dn[8], bl[8], gm[8];
#pragma unroll
            for (int k = 0; k < 8; ++k) { d0[k] = d0n[k]; d1[k] = d1n[k]; dn[k] = dnn[k]; bl[k] = bln[k]; gm[k] = gmn[k]; }
            if (cb + 8 < NCHUNK) {
#pragma unroll
                for (int k = 0; k < 8; ++k) {
                    const size_t u = (size_t)bh * 64 + cb + 8 + k;
                    d0n[k] = DC[u * 8192 + e0]; d1n[k] = DC[u * 8192 + e1]; dnn[k] = hasn ? DN[u * 64 + tid] : 0.f;
                    bln[k] = DSC[u * 2]; gmn[k] = DSC[u * 2 + 1];
                }
            }
#pragma unroll
            for (int k = 0; k < 8; ++k) {
                const size_t u = (size_t)bh * 64 + cb + k;
                bf16* cs = CST + u * 144 * 64;
                cs[e0] = (bf16)f2bf(c0); cs[e1] = (bf16)f2bf(c1);
                if (hasn) cs[128 * 64 + tid] = (bf16)f2bf(nn);
                if (part == 0 && tid == 0) MC[u] = m;
                const float mn = fmaxf(bl[k] + m, gm[k]);
                const float a = __expf(bl[k] + m - mn), s = __expf(gm[k] - mn);
                c0 = a * c0 + s * d0[k]; c1 = a * c1 + s * d1[k]; nn = a * nn + s * dn[k];
                m = mn;
            }
        }
    }
}

struct OutRegs { ConvRegs QR, KR; VRegs VR; u32x4 cst[3]; float lf0, lf1, i0, i1, mc; };
__device__ __forceinline__ void mlstm_out_load(const Params& p, OutRegs& R, int tid, int lane, int u) {
    const int c = u & 63, h = (u >> 6) & 7, b = u >> 9;
    const float* MI = (const float*)(p.ws + WS_MI); const float* MF = (const float*)(p.ws + WS_MF);
    const size_t tok0 = (size_t)b * SEQ + c * 128;
    conv_load(R.QR, tid, (const bf16*)(p.ws + WS_MQ), b, c, h);
    conv_load(R.KR, tid, (const bf16*)(p.ws + WS_MK), b, c, h);
    v_load(R.VR, tid, (const bf16*)(p.ws + WS_MV), b, c, h);
    const bf16* cs = (const bf16*)(p.ws + WS_CST) + (size_t)u * 144 * 64;
#pragma unroll
    for (int k = 0; k < 3; ++k) { const int i = tid + 512 * k; R.cst[k] = (i < 129 * 8) ? *(const u32x4*)(cs + (size_t)i * 8) : (u32x4){0u, 0u, 0u, 0u}; }
    R.lf0 = MF[(tok0 + 2 * lane) * 8 + h]; R.lf1 = MF[(tok0 + 2 * lane + 1) * 8 + h];
    R.i0 = MI[(tok0 + 2 * lane) * 8 + h]; R.i1 = MI[(tok0 + 2 * lane + 1) * 8 + h];
    R.mc = ((const float*)(p.ws + WS_MC))[u];
}
__device__ __forceinline__ void mlstm_out_phase(const Params& p, LAS unsigned char* lds) {
    int tid_ = threadIdx.x; asm volatile("" : "+v"(tid_));
    const int tid = tid_, lane = tid & 63, wave = __builtin_amdgcn_readfirstlane(tid >> 6), fr = lane & 15, fq = lane >> 4;
    LAS bf16* Qs = (LAS bf16*)lds;
    LAS bf16* Ks = Qs + 128 * LQ;
    LAS bf16* VT = Ks + 128 * LQ;
    LAS bf16* Pm = VT + 144 * LS;
    LAS bf16* CT = Pm + 128 * LS;
    LAS float* fs = (LAS float*)(CT + 144 * LQ);
    LAS float* as_ = fs, *bsm = fs + 128, *wint = fs + 256, *nfl = fs + 384;
    OutRegs R;
#ifdef MOU_DB
    OutRegs RN;
#endif
    int u = blockIdx.x;
    if (u < NUNIT_M) mlstm_out_load(p, R, tid, lane, u);
#ifdef MOU_STAGGER
    if (blockIdx.x & 1) { for (int i_ = 0; i_ < MOU_STAGGER; ++i_) __builtin_amdgcn_s_sleep(127); }
#endif
#pragma unroll 1
    for (; u < NUNIT_M; u += gridDim.x) {
        const int c = u & 63, h = (u >> 6) & 7, b = u >> 9;
        const size_t tok0 = (size_t)b * SEQ + c * 128;
#ifdef MOU_DB
        if (u + (int)gridDim.x < NUNIT_M) { int tl_ = tid; asm volatile("" : "+v"(tl_));
            mlstm_out_load(p, RN, tl_, tl_ & 63, u + gridDim.x); }
#endif
        if (wave == 0) {
            const float mc = R.mc;
            const float lf0 = logsigmoidf_(R.lf0), lf1 = logsigmoidf_(R.lf1);
            const float i0 = R.i0, i1 = R.i1;
            float b0, b1; scan_add2(lf0, lf1, lane, b0, b1);
            const float a0 = i0 - b0, a1 = i1 - b1;
            float pm0, pm1; scan_max2(a0, a1, lane, pm0, pm1);
            const float mt0 = fmaxf(b0 + mc, b0 + pm0), mt1 = fmaxf(b1 + mc, b1 + pm1);
            as_[2 * lane] = a0; as_[2 * lane + 1] = a1;
            bsm[2 * lane] = b0 - mt0; bsm[2 * lane + 1] = b1 - mt1;
            wint[2 * lane] = __expf(b0 + mc - mt0); wint[2 * lane + 1] = __expf(b1 + mc - mt1);
            nfl[2 * lane] = __expf(-mt0); nfl[2 * lane + 1] = __expf(-mt1);
        }
        conv_emit(R.QR, tid, p.in[3], 0, h, [&](int r, int ch, f32x4 ya, f32x4 yb) { ya = ya * 0.125f; yb = yb * 0.125f;
            *(LAS u32x4*)(Qs + r * LQ + ch * 8) = (u32x4){pk2(ya[0], ya[1]), pk2(ya[2], ya[3]), pk2(yb[0], yb[1]), pk2(yb[2], yb[3])}; });
        conv_emit(R.KR, tid, p.in[3], 512, h, [&](int r, int ch, f32x4 ya, f32x4 yb) {
            *(LAS u32x4*)(Ks + r * LQ + ch * 8) = (u32x4){pk2(ya[0], ya[1]), pk2(ya[2], ya[3]), pk2(yb[0], yb[1]), pk2(yb[2], yb[3])}; });
        v_store_t(R.VR, tid, VT);
#pragma unroll
        for (int k = 0; k < 3; ++k) { const int i = tid + 512 * k; if (i < 144 * 8) { const int r = i >> 3, ch = i & 7; *(LAS u32x4*)(CT + r * LQ + ch * 8) = R.cst[k]; } }
        __syncthreads();
#ifndef MOU_DB
        if (u + (int)gridDim.x < NUNIT_M) { int tl_ = tid; asm volatile("" : "+v"(tl_));
            mlstm_out_load(p, R, tl_, tl_ & 63, u + gridDim.x); }
#endif
        const int j = wave * 16 + fr;
        const float bsmj = bsm[j];
#ifdef MOU_UNROLL
#pragma unroll MOU_UNROLL
#else
#pragma unroll 1
#endif
        for (int ct = 0; ct < 8; ++ct) {
            f32x4 acc = {0.f, 0.f, 0.f, 0.f};
#ifdef MOU_NOBR
            {
#else
            if (ct <= wave) {
#endif
#pragma unroll
                for (int kk = 0; kk < 2; ++kk) acc = mfma16(Ks + (ct * 16 + fr) * LQ + kk * 32 + 8 * fq, Qs + (wave * 16 + fr) * LQ + kk * 32 + 8 * fq, acc);
            }
            const int s0 = ct * 16 + 4 * fq; const f32x4 a4 = *(const LAS f32x4*)(as_ + s0);
            float v[4];
#pragma unroll
            for (int r = 0; r < 4; ++r) v[r] = (s0 + r <= j) ? acc[r] * __expf(bsmj + a4[r]) : 0.f;
            *(LAS u32x2*)(Pm + j * LS + s0) = (u32x2){pk2(v[0], v[1]), pk2(v[2], v[3])};
        }
        asm volatile("s_waitcnt lgkmcnt(0)" ::: "memory");
        const float wj = wint[j];
        f32x4 o[9];
#ifndef MOU_SB
#define MOU_SB __builtin_amdgcn_sched_barrier(0)
#endif
#ifdef MOU_BATCH
        {
            bf16x8 bq[2], bp[4];
#pragma unroll
            for (int kk = 0; kk < 2; ++kk) bq[kk] = *(const LAS bf16x8*)(Qs + (wave * 16 + fr) * LQ + kk * 32 + 8 * fq);
#pragma unroll
            for (int kk = 0; kk < 4; ++kk) bp[kk] = *(const LAS bf16x8*)(Pm + (wave * 16 + fr) * LS + kk * 32 + 8 * fq);
#pragma unroll
            for (int ct = 0; ct < 9; ++ct) {
                bf16x8 a[3];
#pragma unroll
                for (int kk = 0; kk < 2; ++kk) a[kk] = *(const LAS bf16x8*)(CT + (ct * 16 + fr) * LQ + kk * 32 + 8 * fq);
                a[2] = *(const LAS bf16x8*)(VT + (ct < 8 ? tswb(ct * 16 + fr, fq) : (128 + fr) * LS + 8 * fq));
                MOU_SB;
                f32x4 acc = {0.f, 0.f, 0.f, 0.f};
#pragma unroll
                for (int kk = 0; kk < 2; ++kk) acc = __builtin_amdgcn_mfma_f32_16x16x32_bf16(a[kk], bq[kk], acc, 0, 0, 0);
                acc = acc * wj;
                acc = __builtin_amdgcn_mfma_f32_16x16x32_bf16(a[2], bp[0], acc, 0, 0, 0);
#pragma unroll
                for (int kk = 1; kk < 4; ++kk) a[kk - 1] = *(const LAS bf16x8*)(VT + (ct < 8 ? tswb(ct * 16 + fr, kk * 4 + fq) : (128 + fr) * LS + kk * 32 + 8 * fq));
                MOU_SB;
#pragma unroll
                for (int kk = 1; kk < 4; ++kk) acc = __builtin_amdgcn_mfma_f32_16x16x32_bf16(a[kk - 1], bp[kk], acc, 0, 0, 0);
                o[ct] = acc;
            }
        }
#else
#pragma unroll
        for (int ct = 0; ct < 9; ++ct) {
            f32x4 acc = {0.f, 0.f, 0.f, 0.f};
#pragma unroll
            for (int kk = 0; kk < 2; ++kk) acc = mfma16(CT + (ct * 16 + fr) * LQ + kk * 32 + 8 * fq, Qs + (wave * 16 + fr) * LQ + kk * 32 + 8 * fq, acc);
            acc = acc * wj;
#pragma unroll
            for (int kk = 0; kk < 4; ++kk) acc = mfma16(VT + (ct < 8 ? tswb(ct * 16 + fr, kk * 4 + fq) : (128 + fr) * LS + kk * 32 + 8 * fq), Pm + (wave * 16 + fr) * LS + kk * 32 + 8 * fq, acc);
            o[ct] = acc;
        }
#endif
        const float den = __shfl(o[8][0], fr);
        const float rden = rcpf_(fmaxf(fabsf(den), nfl[j]));
        float s = 0.f;
#pragma unroll
        for (int ct = 0; ct < 8; ++ct) { o[ct] = o[ct] * rden; s += (o[ct][0] + o[ct][1]) + (o[ct][2] + o[ct][3]); }
        s += __shfl_xor(s, 16); s += __shfl_xor(s, 32);
        const float mean = s * (1.0f / 128.0f);
        float q = 0.f;
#pragma unroll
        for (int ct = 0; ct < 8; ++ct) { const f32x4 d = o[ct] - mean; q += (d[0] * d[0] + d[1] * d[1]) + (d[2] * d[2] + d[3] * d[3]); }
        q += __shfl_xor(q, 16); q += __shfl_xor(q, 32);
        const float rstd = rsqrtf(q * (1.0f / 128.0f) + GN_EPS);
        const bf16* MO = (const bf16*)(p.ws + WS_MO); bf16* YM = (bf16*)((unsigned char*)p.out + DO_YM);
        const float* gain = p.in[4];
        const size_t rowoff = (tok0 + j) * 1024 + h * 128 + 4 * fq;
#pragma unroll
        for (int ct = 0; ct < 8; ++ct) {
            const f32x4 g4 = *(const f32x4*)(gain + h * 128 + ct * 16 + 4 * fq);
            const u32x2 mo = *(const u32x2*)(MO + rowoff + ct * 16);
            const f32x4 y = (o[ct] - mean) * rstd * g4;
            u32x2 w; w.x = pk2(y[0] * __uint_as_float(mo.x << 16), y[1] * __uint_as_float(mo.x & 0xffff0000u));
            w.y = pk2(y[2] * __uint_as_float(mo.y << 16), y[3] * __uint_as_float(mo.y & 0xffff0000u));
            *(u32x2*)(YM + rowoff + ct * 16) = w;
        }
#ifdef MOU_DB
        R = RN;
#endif
        __syncthreads();
    }
}

struct EpiGate {
    static constexpr bool PERM = true, AFTER_DRAIN = false;
    const bf16* gate; bf16* out; int add;
    __device__ __forceinline__ void operator()(const f32x4 (&acc)[2][2][4][2], const pg8::Unit& u, int wr, int wc, int fr, int fq) const {
        const int row0 = u.pm * 256 + wr * 64 + fr, col0 = u.pn * 256 + wc * 32 + 8 * fq;
#pragma unroll
        for (int ai = 0; ai < 2; ++ai)
#pragma unroll
            for (int m = 0; m < 4; ++m)
#pragma unroll
                for (int bj = 0; bj < 2; ++bj) {
                    const size_t idx = (size_t)(row0 + ai * 128 + m * 16) * 1024 + col0 + bj * 128;
                    const u32x4 gv = *(const u32x4*)(gate + idx);
                    const unsigned gw[4] = {gv.x, gv.y, gv.z, gv.w};
                    const f32x4 v0 = acc[ai][bj][m][0], v1 = acc[ai][bj][m][1];
                    float r[8] = {v0[0], v0[1], v0[2], v0[3], v1[0], v1[1], v1[2], v1[3]};
#pragma unroll
                    for (int i = 0; i < 4; ++i) { r[2 * i] *= __uint_as_float(gw[i] << 16); r[2 * i + 1] *= __uint_as_float(gw[i] & 0xffff0000u); }
                    if (add) {
                        const u32x4 ov = *(const u32x4*)(out + idx); const unsigned ow[4] = {ov.x, ov.y, ov.z, ov.w};
#pragma unroll
                        for (int i = 0; i < 4; ++i) { r[2 * i] += __uint_as_float(ow[i] << 16); r[2 * i + 1] += __uint_as_float(ow[i] & 0xffff0000u); }
                    }
                    u32x4 w; w.x = pk2(r[0], r[1]); w.y = pk2(r[2], r[3]); w.z = pk2(r[4], r[5]); w.w = pk2(r[6], r[7]);
                    *(u32x4*)(out + idx) = w;
                }
    }
};
__device__ __forceinline__ void phase_merge(const Params& p, LAS unsigned char* lds) {
    bf16* merged = (bf16*)(p.ws + WS_MERGED);
    pg8::StaticOrder S; S.init(T, 1024, gridDim.x, (int)blockIdx.x);
    { pg8::Gemm g{(const bf16*)(p.ws + WS_YA), (const bf16*)(p.ws + WS_WBA), T, 1024, 512};
      EpiGate E{(const bf16*)(p.ws + WS_GA), merged, 0};
      pg8::gemm_phase<EpiGate, pg8::StaticOrder, true, true>(lds, g, S, E); }
    __syncthreads();
    { pg8::Gemm g{(const bf16*)((unsigned char*)p.out + DO_YM), (const bf16*)(p.ws + WS_WBM), T, 1024, 1024};
      EpiGate E{(const bf16*)((unsigned char*)p.out + DO_GM), merged, 1};
      pg8::gemm_phase<EpiGate, pg8::StaticOrder, true, true>(lds, g, S, E); }
}

struct EpiOutRes {
    static constexpr bool PERM = true, AFTER_DRAIN = false;
    const float* x; bf16* out;
    __device__ __forceinline__ void operator()(const f32x4 (&acc)[2][2][4][2], const pg8::Unit& u, int wr, int wc, int fr, int fq) const {
        const int row0 = u.pm * 256 + wr * 64 + fr, col0 = u.pn * 256 + wc * 32 + 8 * fq;
#pragma unroll
        for (int ai = 0; ai < 2; ++ai)
#pragma unroll
            for (int m = 0; m < 4; ++m)
#pragma unroll
                for (int bj = 0; bj < 2; ++bj) {
                    const size_t idx = (size_t)(row0 + ai * 128 + m * 16) * 1024 + col0 + bj * 128;
                    const f32x4 x0 = *(const f32x4*)(x + idx), x1 = *(const f32x4*)(x + idx + 4);
                    const f32x4 v0 = x0 * ALPHA + acc[ai][bj][m][0], v1 = x1 * ALPHA + acc[ai][bj][m][1];
                    u32x4 w; w.x = pk2(v0[0], v0[1]); w.y = pk2(v0[2], v0[3]); w.z = pk2(v1[0], v1[1]); w.w = pk2(v1[2], v1[3]);
                    *(u32x4*)(out + idx) = w;
                }
    }
};
__device__ __forceinline__ void phase_outproj(const Params& p, LAS unsigned char* lds) {
    pg8::Gemm g{(const bf16*)(p.ws + WS_MERGED), (const bf16*)(p.ws + WS_WOUT), T, 1024, 1024};
    pg8::StaticOrder S; S.init(T, 1024, gridDim.x, (int)blockIdx.x);
    EpiOutRes E{p.in[0], (bf16*)p.out};
    pg8::gemm_phase<EpiOutRes, pg8::StaticOrder, true, true>(lds, g, S, E);
}

__device__ __forceinline__ void phase_ln1_route(const Params& p, LAS unsigned char* lds) {
    int tid_ = threadIdx.x; asm volatile("" : "+v"(tid_));
    const int tid = tid_, lane = tid & 63, wave = __builtin_amdgcn_readfirstlane(tid >> 6);
    LAS int* cnt = (LAS int*)lds;
    LAS int* base = cnt + 16;
    LAS int* info = base + 16;
    LAS float* infw = (LAS float*)(info + 512);
    const float* gain = p.in[8]; const float* bias = p.in[9];
    const float* Wg = p.in[10]; const float* bg = p.in[11]; const float* We = p.in[12]; const float* be = p.in[13];
    unsigned* cursor = (unsigned*)(p.ws + WS_CTL) + CW_CURSOR;
    for (int blk = blockIdx.x; blk < T / 128; blk += gridDim.x) {
        if (tid < 16) cnt[tid] = 0;
        __syncthreads();
        u32x2 rwn[4];
        { const u32x2* row = (const u32x2*)((const bf16*)p.out + ((size_t)blk * 128 + wave * 16) * 1024) + lane;
#pragma unroll
          for (int j = 0; j < 4; ++j) rwn[j] = row[64 * j]; }
#pragma unroll 1
        for (int i = 0; i < 16; ++i) {
            const int tl = wave * 16 + i; const size_t tok = (size_t)blk * 128 + tl;
            u32x2 rwc[4];
#ifndef LN1_PF
            { const u32x2* row = (const u32x2*)((const bf16*)p.out + tok * 1024) + lane;
#pragma unroll
              for (int j = 0; j < 4; ++j) rwn[j] = row[64 * j]; }
#endif
#pragma unroll
            for (int j = 0; j < 4; ++j) rwc[j] = rwn[j];
#ifdef LN1_PF
            { const u32x2* row = (const u32x2*)((const bf16*)p.out + ((size_t)blk * 128 + wave * 16 + min(i + 1, 15)) * 1024) + lane;
#pragma unroll
              for (int j = 0; j < 4; ++j) rwn[j] = row[64 * j]; }
#endif
            f32x4 v[4]; float s = 0.f;
#pragma unroll
            for (int j = 0; j < 4; ++j) { const u32x2 rw = rwc[j];
                v[j] = (f32x4){__uint_as_float(rw.x << 16), __uint_as_float(rw.x & 0xffff0000u), __uint_as_float(rw.y << 16), __uint_as_float(rw.y & 0xffff0000u)};
                s += (v[j].x + v[j].y) + (v[j].z + v[j].w); }
            const float mean = wave_sum(s) * (1.f / 1024.f); float s2 = 0.f;
#pragma unroll
            for (int j = 0; j < 4; ++j) { v[j] = v[j] - mean; s2 += (v[j].x * v[j].x + v[j].y * v[j].y) + (v[j].z * v[j].z + v[j].w * v[j].w); }
            const float rstd = rsqrtf(wave_sum(s2) * (1.f / 1024.f) + LN_EPS);
            float lg[4] = {0.f, 0.f, 0.f, 0.f};
#pragma unroll
            for (int j = 0; j < 4; ++j) {
                const int e0 = (lane + 64 * j) * 4;
                const f32x4 g4 = *(const f32x4*)(gain + e0), b4 = *(const f32x4*)(bias + e0);
                v[j] = v[j] * rstd * g4 + b4;
                ((unsigned long long*)((bf16*)(p.ws + WS_X1B) + tok * 1024))[lane + 64 * j] = (unsigned long long)pk2(v[j].x, v[j].y) | ((unsigned long long)pk2(v[j].z, v[j].w) << 32);
                const float* wgj = Wg + (size_t)e0 * 4;
#pragma unroll
                for (int q = 0; q < 4; ++q) { const float xv = v[j][q]; const f32x4 wg4 = *(const f32x4*)(wgj + q * 4);
                    lg[0] += xv * wg4[0]; lg[1] += xv * wg4[1]; lg[2] += xv * wg4[2]; lg[3] += xv * wg4[3]; }
            }
#pragma unroll
            for (int k = 0; k < 4; ++k) lg[k] = wave_sum(lg[k]) + bg[k];
            int gs = 0; float gm = lg[0];
#pragma unroll
            for (int k = 1; k < 4; ++k) if (lg[k] > gm) { gm = lg[k]; gs = k; }
            float gsum = 0.f;
#pragma unroll
            for (int k = 0; k < 4; ++k) gsum += __expf(lg[k] - gm);
            const float gw = 1.0f / gsum;
            gs = __builtin_amdgcn_readfirstlane(gs);
            float el[4] = {0.f, 0.f, 0.f, 0.f};
#pragma unroll
            for (int j = 0; j < 4; ++j) {
                const float* wej = We + (size_t)(lane + 64 * j) * 64 + gs * 4;
#pragma unroll
                for (int q = 0; q < 4; ++q) { const float xv = v[j][q]; const f32x4 we4 = *(const f32x4*)(wej + q * 16);
                    el[0] += xv * we4[0]; el[1] += xv * we4[1]; el[2] += xv * we4[2]; el[3] += xv * we4[3]; }
            }
            { const f32x4 be4 = *(const f32x4*)(be + gs * 4);
#pragma unroll
              for (int k = 0; k < 4; ++k) el[k] = wave_sum(el[k]) + be4[k]; }
            int i0 = 0; float v0 = el[0];
#pragma unroll
            for (int k = 1; k < 4; ++k) if (el[k] > v0) { v0 = el[k]; i0 = k; }
            int i1 = -1; float v1 = -INFINITY;
#pragma unroll
            for (int k = 0; k < 4; ++k) if (k != i0 && el[k] > v1) { v1 = el[k]; i1 = k; }
            const float p1 = __expf(v1 - v0); const float w0 = gw / (1.f + p1), w1 = gw * p1 / (1.f + p1);
            if (lane == 0) {
                const int e0 = gs * 4 + i0, e1 = gs * 4 + i1;
                const int r0 = atomicAdd((int*)&cnt[e0], 1), r1 = atomicAdd((int*)&cnt[e1], 1);
                info[tl * 4 + 0] = e0; info[tl * 4 + 1] = r0; info[tl * 4 + 2] = e1; info[tl * 4 + 3] = r1;
                infw[tl * 2 + 0] = w0; infw[tl * 2 + 1] = w1;
            }
        }
        __syncthreads();
        if (tid < 16) base[tid] = (int)atomicAdd(&cursor[tid], (unsigned)cnt[tid]);
        __syncthreads();
        if (tid < 128) {
            const size_t tok = (size_t)blk * 128 + tid;
            int* te = (int*)(p.ws + WS_TE) + tok * 4; float* tw = (float*)(p.ws + WS_TW) + tok * 2;
            const int e0 = info[tid * 4 + 0], e1 = info[tid * 4 + 2];
            const int p0 = base[e0] + info[tid * 4 + 1], p1 = base[e1] + info[tid * 4 + 3];
            te[0] = e0; te[1] = p0; te[2] = e1; te[3] = p1;
            int* inv = (int*)(p.ws + WS_INV); inv[(size_t)e0 * T + p0] = (int)tok; inv[(size_t)e1 * T + p1] = (int)tok;
            tw[0] = infw[tid * 2 + 0]; tw[1] = infw[tid * 2 + 1];
        }
        __syncthreads();
    }
}

struct Segs {
    int st[17];
    __device__ __forceinline__ void init(const unsigned* cursor) {
        int a = 0;
#pragma unroll
        for (int e = 0; e < 16; ++e) { st[e] = a; a += ((int)cursor[e] + 255) & ~255; }
        st[16] = a;
    }
    __device__ __forceinline__ int start(int e) const {
        int r = 0;
#pragma unroll
        for (int k = 0; k < 16; ++k) r = (k == e) ? st[k] : r;
        return r;
    }
};

struct MoeOrder {
    Segs sg; int ntiles, R, x, slot;
    __device__ __forceinline__ void init(const unsigned* cursor, int G_, int c_) { sg.init(cursor); ntiles = sg.st[16] >> 8; R = (ntiles + 7) >> 3; x = c_ & 7; slot = c_ >> 3; (void)G_; }
    __device__ __forceinline__ bool next(int i, pg8::Unit& u) const {
        const int lu = i * 32 + slot;
        const int pm = x * R + (lu >> 2), j = lu & 3;
        if ((lu >> 2) >= R || pm >= ntiles) return false;
        int e = 0;
#pragma unroll
        for (int k = 1; k < 16; ++k) e += (sg.st[k] <= pm * 256) ? 1 : 0;
        u.pm = pm; u.pn = e * 4 + j; return true;
    }
    __device__ __forceinline__ void a_ready(const pg8::Unit&) const {}
    __device__ __forceinline__ void done(const pg8::Unit&) const {}
};
struct EpiSwiGLU {
    static constexpr bool PERM = true, AFTER_DRAIN = false;
    bf16* H;
    __device__ __forceinline__ void operator()(const f32x4 (&acc)[2][2][4][2], const pg8::Unit& u, int wr, int wc, int fr, int fq) const {
        const int row0 = u.pm * 256 + wr * 64 + fr, col0 = (u.pn & 3) * 128 + wc * 32 + 8 * fq;
#pragma unroll
        for (int ai = 0; ai < 2; ++ai)
#pragma unroll
            for (int m = 0; m < 4; ++m) {
                const f32x4 g0 = acc[ai][0][m][0], g1 = acc[ai][0][m][1], u0 = acc[ai][1][m][0], u1 = acc[ai][1][m][1];
                u32x4 w;
                w.x = pk2(siluf_(g0[0]) * u0[0], siluf_(g0[1]) * u0[1]); w.y = pk2(siluf_(g0[2]) * u0[2], siluf_(g0[3]) * u0[3]);
                w.z = pk2(siluf_(g1[0]) * u1[0], siluf_(g1[1]) * u1[1]); w.w = pk2(siluf_(g1[2]) * u1[2], siluf_(g1[3]) * u1[3]);
                *(u32x4*)(H + (size_t)(row0 + ai * 128 + m * 16) * 512 + col0) = w;
            }
    }
};
struct EpiPlain {
    static constexpr bool PERM = true, AFTER_DRAIN = false;
    bf16* Y;
    __device__ __forceinline__ void operator()(const f32x4 (&acc)[2][2][4][2], const pg8::Unit& u, int wr, int wc, int fr, int fq) const {
        const int row0 = u.pm * 256 + wr * 64 + fr, col0 = (u.pn & 3) * 256 + wc * 32 + 8 * fq;
#pragma unroll
        for (int ai = 0; ai < 2; ++ai)
#pragma unroll
            for (int m = 0; m < 4; ++m)
#pragma unroll
                for (int bj = 0; bj < 2; ++bj) {
                    const f32x4 v0 = acc[ai][bj][m][0], v1 = acc[ai][bj][m][1];
                    u32x4 w; w.x = pk2(v0[0], v0[1]); w.y = pk2(v0[2], v0[3]); w.z = pk2(v1[0], v1[1]); w.w = pk2(v1[2], v1[3]);
                    *(u32x4*)(Y + (size_t)(row0 + ai * 128 + m * 16) * 1024 + col0 + bj * 128) = w;
                }
    }
};
constexpr int MOE_TOKL = 131072;
__device__ __forceinline__ void phase_moe_up(const Params& p, LAS unsigned char* lds) {
    int tid_ = threadIdx.x; asm volatile("" : "+v"(tid_));
    MoeOrder S; S.init((const unsigned*)(p.ws + WS_CTL) + CW_CURSOR, gridDim.x, (int)blockIdx.x);
    LAS int* tokL = (LAS int*)(lds + MOE_TOKL);
    {
        const unsigned* cursor = (const unsigned*)(p.ws + WS_CTL) + CW_CURSOR; const int* inv = (const int*)(p.ws + WS_INV);
        pg8::Unit u;
        for (int i = 0; i < 8 && S.next(i, u); ++i) {
            const int e = u.pn >> 2, st = S.sg.start(e), cnt = (int)cursor[e];
            if (tid_ < 256) { const int slot = u.pm * 256 + tid_ - st; tokL[i * 256 + tid_] = (slot < cnt) ? inv[(size_t)e * T + slot] : 0; }
        }
        __syncthreads();
    }
    pg8::Gemm g{(const bf16*)(p.ws + WS_X1B), (const bf16*)(p.ws + WS_WGU), T, 16 * 1024, 1024};
    EpiSwiGLU E{(bf16*)(p.ws + WS_H)};
    pg8::gemm_phase<EpiSwiGLU, MoeOrder, true, true, true>(lds, g, S, E, tokL);
}
__device__ __forceinline__ void phase_moe_down(const Params& p, LAS unsigned char* lds) {
    pg8::Gemm g{(const bf16*)(p.ws + WS_H), (const bf16*)(p.ws + WS_WD), MOE_MAXROWS, 16 * 1024, 512};
    MoeOrder S; S.init((const unsigned*)(p.ws + WS_CTL) + CW_CURSOR, gridDim.x, (int)blockIdx.x);
    EpiPlain E{(bf16*)(p.ws + WS_Y)};
    pg8::gemm_phase<EpiPlain, MoeOrder, true, true>(lds, g, S, E);
}

__device__ __forceinline__ void phase_final(const Params& p) {
    int tid_ = threadIdx.x; asm volatile("" : "+v"(tid_));
    const int tid = tid_, lane = tid & 63, wave = tid >> 6;
    const float* gain = p.in[17]; const float* bias = p.in[18];
    const bf16* Y = (const bf16*)(p.ws + WS_Y);
    Segs sg; sg.init((const unsigned*)(p.ws + WS_CTL) + CW_CURSOR);
#if defined(CHECK_YA)
    const bool poison = __uint_as_float(__hip_atomic_load((unsigned*)(p.ws + WS_CTL) + CW_MISMATCH, __ATOMIC_RELAXED, __HIP_MEMORY_SCOPE_AGENT)) > CHECK_YA;
#elif defined(CHECK_MASK)
    const bool poison = __hip_atomic_load((unsigned*)(p.ws + WS_CTL) + CW_MISMATCH, __ATOMIC_RELAXED, __HIP_MEMORY_SCOPE_AGENT) > (unsigned)CHECK_MASK;
#else
    const bool poison = false;
#endif
    const int step = gridDim.x * 8, tok0 = blockIdx.x * 8 + wave;
    const int* TE = (const int*)(p.ws + WS_TE); const float* TW = (const float*)(p.ws + WS_TW);
    const bf16* X1 = (const bf16*)(p.ws + WS_X1B);
#define FIN_TE(t_, E_, W_) do { const int tc_ = min((t_), T - 1); E_ = *(const u32x4*)(TE + (size_t)tc_ * 4); W_ = *(const f32x2*)(TW + (size_t)tc_ * 2); } while (0)
#define FIN_ROWS(t_, E_, XW_, YA_, YB_) do { const int tc_ = min((t_), T - 1); \
        const int g0_ = sg.start((int)E_.x) + (int)E_.y, g1_ = sg.start((int)E_.z) + (int)E_.w; \
        const u32x2* xr_ = (const u32x2*)(X1 + (size_t)tc_ * 1024) + lane; \
        const u32x2* y0_ = (const u32x2*)(Y + (size_t)g0_ * 1024) + lane; const u32x2* y1_ = (const u32x2*)(Y + (size_t)g1_ * 1024) + lane; \
        _Pragma("unroll") for (int j = 0; j < 4; ++j) { XW_[j] = xr_[64 * j]; YA_[j] = y0_[64 * j]; YB_[j] = y1_[64 * j]; } } while (0)
    u32x4 e_cur, e_nxt; f32x2 w_cur, w_nxt;
    u32x2 xw[4], ya[4], yb[4];
    FIN_TE(tok0, e_cur, w_cur);
    FIN_TE(tok0 + step, e_nxt, w_nxt);
    FIN_ROWS(tok0, e_cur, xw, ya, yb);
#pragma unroll 1
    for (int tok = tok0; tok < T; tok += step) {
        u32x4 e_n2; f32x2 w_n2; FIN_TE(tok + 2 * step, e_n2, w_n2);
        u32x2 xn[4], yan[4], ybn[4]; FIN_ROWS(tok + step, e_nxt, xn, yan, ybn);
        const float w0 = w_cur[0], w1 = w_cur[1];
        f32x4* row = (f32x4*)(p.out + (size_t)tok * 1024) + lane;
        f32x4 v[4]; float s = 0.f;
#pragma unroll
        for (int j = 0; j < 4; ++j) {
            const unsigned a0 = ya[j].x, a1 = ya[j].y, b0 = yb[j].x, b1 = yb[j].y;
            const f32x4 xv = {__uint_as_float(xw[j].x << 16), __uint_as_float(xw[j].x & 0xffff0000u), __uint_as_float(xw[j].y << 16), __uint_as_float(xw[j].y & 0xffff0000u)};
            f32x4 mo;
            mo.x = w0 * __uint_as_float(a0 << 16) + w1 * __uint_as_float(b0 << 16);
            mo.y = w0 * __uint_as_float(a0 & 0xffff0000u) + w1 * __uint_as_float(b0 & 0xffff0000u);
            mo.z = w0 * __uint_as_float(a1 << 16) + w1 * __uint_as_float(b1 << 16);
            mo.w = w0 * __uint_as_float(a1 & 0xffff0000u) + w1 * __uint_as_float(b1 & 0xffff0000u);
            v[j] = xv * ALPHA + mo; s += (v[j].x + v[j].y) + (v[j].z + v[j].w);
        }
        const float mean = wave_sum(s) * (1.f / 1024.f); float s2 = 0.f;
#pragma unroll
        for (int j = 0; j < 4; ++j) { v[j] = v[j] - mean; s2 += (v[j].x * v[j].x + v[j].y * v[j].y) + (v[j].z * v[j].z + v[j].w * v[j].w); }
        const float rstd = rsqrtf(wave_sum(s2) * (1.f / 1024.f) + LN_EPS);
#pragma unroll
        for (int j = 0; j < 4; ++j) { const int e0 = (lane + 64 * j) * 4; f32x4 o = v[j] * rstd * (*(const f32x4*)(gain + e0)) + (*(const f32x4*)(bias + e0)); if (poison) o = o * 3.0f; row[64 * j] = o; }
        e_cur = e_nxt; w_cur = w_nxt; e_nxt = e_n2; w_nxt = w_n2;
#pragma unroll
        for (int j = 0; j < 4; ++j) { xw[j] = xn[j]; ya[j] = yan[j]; yb[j] = ybn[j]; }
    }
#undef FIN_TE
#undef FIN_ROWS
}

constexpr int LDS_BYTES = 147456;
constexpr int MISC_OFF = LDS_BYTES - 64;
constexpr int CW_BAR = 4096;
constexpr size_t CTL_ZERO_BYTES = 65536;

#ifndef REP_PRO
#define REP_PRO 1
#endif
#ifndef REP_INP
#define REP_INP 1
#endif
#ifndef REP_IDX
#define REP_IDX 1
#endif
#ifndef REP_ATT
#define REP_ATT 1
#endif
#ifndef REP_MKV
#define REP_MKV 1
#endif
#ifndef REP_MSC
#define REP_MSC 1
#endif
#ifndef REP_MOU
#define REP_MOU 1
#endif
#ifndef REP_MRG
#define REP_MRG 1
#endif
#ifndef REP_OUT
#define REP_OUT 1
#endif
#ifndef REP_MOE
#define REP_MOE 1
#endif
#ifndef REP_EXW
#define REP_EXW 1
#endif
#ifndef REP_GAT
#define REP_GAT 1
#endif
#ifndef MEGA_MINB
#define MEGA_MINB 2
#endif
__global__ void __launch_bounds__(512, MEGA_MINB) k_mega(Params p) {
    extern __shared__ __attribute__((aligned(16))) unsigned char lds_raw[];
    LAS unsigned char* lds = (LAS unsigned char*)lds_raw;
    const int tid = threadIdx.x;
    volatile LAS unsigned* MISC = (volatile LAS unsigned*)(lds + MISC_OFF);
    if (tid < 16) MISC[tid] = 0u;
    __syncthreads();
    XcdBarrier bar = xcd_barrier_post((unsigned*)(p.ws + WS_CTL) + CW_BAR, MISC + 8);
    for (int rep_ = 0; rep_ < REP_PRO; ++rep_) { phase_prologue(p, lds); __syncthreads(); }
    xcd_barrier(bar);
    for (int rep_ = 0; rep_ < REP_INP; ++rep_) phase_inproj(p, lds);
#ifdef REP_INP_DUMMY
    phase_inproj_dummy(p, lds);
#endif
    xcd_barrier(bar);
#if defined(CHECK_MASK) || defined(FAST_ATTN)
    for (int rep_ = 0; rep_ < REP_IDX; ++rep_) phase_indexer(p, lds);
#endif
#ifdef CHECK_MASK
    xcd_barrier(bar);
#endif
#ifndef FAST_ATTN
    { const int lane = tid & 63, wave = tid >> 6;
      if (wave < 4) attn_simple_body(p, (unsigned*)(lds_raw + wave * 32768), (float*)(lds_raw + 131072 + wave * 1024), blockIdx.x * 4 + wave, gridDim.x * 4, lane);
      __syncthreads(); }
#endif
    for (int rep_ = 0; rep_ < REP_MKV; ++rep_) mlstm_kv_phase(p, lds);
    xcd_barrier(bar);
#ifdef FAST_ATTN
    {
        const attn_body::AttnTensors AT{(const attn_body::bf16*)(p.ws + WS_AQ), (const attn_body::bf16*)(p.ws + WS_AK), (const attn_body::bf16*)(p.ws + WS_AV),
                                        (attn_body::bf16*)(p.ws + WS_YA), (const unsigned long long*)(p.ws + WS_MASK)};
        const attn_body::StaticOrder S((int)gridDim.x, (int)blockIdx.x);
        for (int rep_ = 0; rep_ < REP_ATT; ++rep_) attn_body::attn_phase<attn_body::StaticOrder>((char*)lds_raw, AT, S);
        __syncthreads();
    }
#endif
    for (int rep_ = 0; rep_ < REP_MSC; ++rep_) mlstm_scan(p);
    xcd_barrier(bar);
#ifdef CHECK_YA
    {
        const int lane = tid & 63, wave = tid >> 6;
        if (wave < 4) attn_simple_body(p, (unsigned*)(lds_raw + wave * 32768), (float*)(lds_raw + 131072 + wave * 1024), blockIdx.x * 4 + wave, gridDim.x * 4, lane);
        __syncthreads(); }
#endif
    for (int rep_ = 0; rep_ < REP_MOU; ++rep_) mlstm_out_phase(p, lds);
    xcd_barrier(bar);
    for (int rep_ = 0; rep_ < REP_EXW; ++rep_) phase_expert_weights(p, lds);
    __syncthreads();
    for (int rep_ = 0; rep_ < REP_MRG; ++rep_) { phase_merge(p, lds); __syncthreads(); }
    xcd_barrier(bar);
    for (int rep_ = 0; rep_ < REP_OUT; ++rep_) phase_outproj(p, lds);
    xcd_barrier(bar);
    phase_ln1_route(p, lds);
    xcd_barrier(bar);
#ifndef REP_MUP
#define REP_MUP REP_MOE
#endif
#ifndef REP_MDN
#define REP_MDN REP_MOE
#endif
    for (int rep_ = 0; rep_ < REP_MUP; ++rep_) phase_moe_up(p, lds);
    xcd_barrier(bar);
    for (int rep_ = 0; rep_ < REP_MDN; ++rep_) phase_moe_down(p, lds);
    xcd_barrier(bar);
#ifdef REP_BAR
    for (int rep_ = 0; rep_ < REP_BAR; ++rep_) xcd_barrier(bar);
#endif
    phase_final(p);
}

extern "C" void kernel_launch(void* const* d_in, const int* in_sizes, int n_in, void* d_out, int out_size, void* d_ws, size_t ws_size, hipStream_t stream) {
    static int grid = 0;
    if (grid == 0) {
        if (n_in != 19 || out_size != T * DM || ws_size < WS_END) { fprintf(stderr, "kernel_launch: unexpected shapes (n_in %d out %d ws %zu)\n", n_in, out_size, ws_size); grid = -1; return; }
        int dev = 0, cus = 0, per_cu = 0;
        if (hipGetDevice(&dev) != hipSuccess || hipDeviceGetAttribute(&cus, hipDeviceAttributeMultiprocessorCount, dev) != hipSuccess) { grid = -1; return; }
        if (hipFuncSetAttribute((const void*)k_mega, hipFuncAttributeMaxDynamicSharedMemorySize, LDS_BYTES) != hipSuccess) { fprintf(stderr, "kernel_launch: hipFuncSetAttribute failed\n"); grid = -1; return; }
        if (hipOccupancyMaxActiveBlocksPerMultiprocessor(&per_cu, (const void*)k_mega, 512, LDS_BYTES) != hipSuccess || per_cu < 1) fprintf(stderr, "kernel_launch: occupancy query says %d\n", per_cu);
        (void)hipGetLastError();
        grid = cus;
    }
    if (grid < 0) return;
    (void)hipMemsetAsync((char*)d_ws + WS_CTL, 0, CTL_ZERO_BYTES, stream);
    Params p{};
    for (int i = 0; i < 19; ++i) p.in[i] = (const float*)d_in[i];
    p.out = (float*)d_out; p.ws = (unsigned char*)d_ws;
    hipLaunchKernelGGL(k_mega, dim3(grid), dim3(512), LDS_BYTES, stream, p);
}
```

```cpp
#include <hip/hip_runtime.h>
#include <cstdio>
#include <cstdint>
#include <cmath>
#define FAST_ATTN 1
#define IDX_OLD_P2 1
#define IDX_NOCLAMP 1
#define LN1_PF 1
#define IDX_KPF 1
#define MOU_UNROLL 4
namespace pg8 {
#define PG8_LAS __attribute__((address_space(3)))
typedef unsigned short bf16_t;
typedef short bf16x8 __attribute__((ext_vector_type(8)));
typedef float f32x4 __attribute__((ext_vector_type(4)));
typedef unsigned u32x4 __attribute__((ext_vector_type(4)));
constexpr int BM = 256, BK = 64, HALF = 128, HTB = HALF * BK * 2  , STAGE_BYTES = 8 * HTB, NXCD = 8, WGM = 8;

__host__ __device__ __forceinline__ int lds_byte(int r, int c) { const int st = (r >> 4) * 2 + (c >> 5), rr = r & 15, cc = c & 31, ob = rr * 64 + cc * 2; return st * 1024 + (ob ^ (((ob >> 9) & 1) << 5)); }
__host__ __device__ __forceinline__ void stage_rc(int b, int& R, int& C) { const int st = b / 1024, sb = b % 1024, swz = sb ^ (((sb >> 9) & 1) << 5); R = (st >> 1) * 16 + swz / 64; C = (st & 1) * 32 + (swz % 64) / 2; }
__host__ __device__ __forceinline__ int perm32(int rho) { const int n = rho >> 4, i = rho & 15; return 8 * (i >> 2) + 4 * n + (i & 3); }

struct Unit { int pm, pn; };
struct Gemm { const bf16_t* A; const bf16_t* Bt; int M, N, K; };

struct StaticOrder {
    int nM, nN, nwg, G, c;
    __host__ __device__ void init(int M, int N, int G_, int c_) { nM = M / BM; nN = N / BM; nwg = nM * nN; G = G_; c = c_; }
    __host__ __device__ bool next(int i, Unit& u) const {
        const long L = (long)i * G + c; if (L >= nwg) return false;
        int wgid = (int)L; { const int q = nwg / NXCD, r = nwg % NXCD, xcd = wgid % NXCD, off = wgid / NXCD; wgid = (xcd < r ? xcd * (q + 1) : r * (q + 1) + (xcd - r) * q) + off; }
        const int nig = WGM * nN, gid = wgid / nig, fm = gid * WGM, gsz = (nM - fm) < WGM ? (nM - fm) : WGM;
        u.pm = fm + ((wgid % nig) % gsz); u.pn = (wgid % nig) / gsz; return true;
    }
    __device__ __forceinline__ void a_ready(const Unit&) const {}
    __device__ __forceinline__ void done(const Unit&) const {}
};

__device__ __forceinline__ unsigned cvt_pk_bf16(float lo, float hi) { unsigned r; asm volatile("v_cvt_pk_bf16_f32 %0, %1, %2" : "=v"(r) : "v"(lo), "v"(hi)); return r; }
typedef float f32x2 __attribute__((ext_vector_type(2)));
template <class Epi, class Sched, bool ALIGN_EPI = false, bool SP2 = false, bool GATHER = false>
__device__ __forceinline__ void gemm_phase(PG8_LAS unsigned char* lds, const Gemm g, const Sched& S, const Epi& E, const PG8_LAS int* tokL = nullptr) {
    int tid_ = threadIdx.x; asm volatile("" : "+v"(tid_));
    const int tid = tid_, wid = __builtin_amdgcn_readfirstlane(tid >> 6), lane = tid & 63, wr = wid >> 2, wc = wid & 3, fr = lane & 15, fq = lane >> 4;
    const int K = g.K, nt = K / BK;
    unsigned voffA[2], voffB[2]; int stR[2], stC[2];
#pragma unroll
    for (int i = 0; i < 2; ++i) { int R, C; stage_rc(tid * 16 + i * 8192, R, C); const int Rb = Epi::PERM ? ((R & ~31) + perm32(R & 31)) : R; stR[i] = R; stC[i] = C;
        voffA[i] = (unsigned)(R * K + C) * 2u; voffB[i] = (unsigned)(Rb * K + C) * 2u; }
    unsigned gaC[2][2], gaN[2][2];
#define PG8_GOFF(dst, un) do { _Pragma("unroll") for (int h_ = 0; h_ < 2; ++h_) _Pragma("unroll") for (int i_ = 0; i_ < 2; ++i_) \
        dst[h_][i_] = (unsigned)tokL[(un) * 256 + h_ * HALF + stR[i_]] * (unsigned)(K * 2) + (unsigned)stC[i_] * 2u; } while (0)
#define PG8_STAGEA(bufoff, kbase, h, NEXT) do { if constexpr (GATHER) { const unsigned vo_[2] = {(NEXT) ? gaN[h][0] : gaC[h][0], (NEXT) ? gaN[h][1] : gaC[h][1]}; PG8_STAGE(bufoff, kbase, vo_); } \
        else { PG8_STAGE(bufoff, (kbase) + (h) * hstep, voffA); } } while (0)
    const size_t kstep = (size_t)(BK * 2);
    const size_t hstep = (size_t)HALF * K * 2;
    const size_t tstep = 2 * hstep;
    const unsigned ldsw = (unsigned)wid * 1024u;
    const int aoff = lds_byte(wr * 64 + fr, fq * 8), boff = lds_byte(wc * 32 + fr, fq * 8);
#define PG8_SA(b, h) (((b) * 2 + (h)) * HTB)
#define PG8_SB(b, h) ((4 + (b) * 2 + (h)) * HTB)
#define PG8_STAGE(bufoff, gbase, voff) do { _Pragma("unroll") for (int _i = 0; _i < 2; ++_i) \
        __builtin_amdgcn_global_load_lds((const unsigned*)((const char*)(gbase) + (voff)[_i]), (PG8_LAS unsigned*)(lds + (bufoff) + ldsw + _i * 8192), 16, 0, 0); } while (0)
#define PG8_LDA(dst, b, h) do { _Pragma("unroll") for (int m = 0; m < 4; ++m) _Pragma("unroll") for (int k = 0; k < 2; ++k) dst[m][k] = *(const PG8_LAS bf16x8*)(lds + PG8_SA(b, h) + aoff + m * 2048 + k * 1024); } while (0)
#define PG8_LDB(dst, b, h) do { _Pragma("unroll") for (int n = 0; n < 2; ++n) _Pragma("unroll") for (int k = 0; k < 2; ++k) dst[n][k] = *(const PG8_LAS bf16x8*)(lds + PG8_SB(b, h) + boff + n * 2048 + k * 1024); } while (0)
#define PG8_MMA(ai, bj, At, Bt) do { __builtin_amdgcn_s_setprio(1); _Pragma("unroll") for (int m = 0; m < 4; ++m) _Pragma("unroll") for (int n = 0; n < 2; ++n) _Pragma("unroll") for (int k = 0; k < 2; ++k) \
        acc[ai][bj][m][n] = __builtin_amdgcn_mfma_f32_16x16x32_bf16(Bt[n][k], At[m][k], acc[ai][bj][m][n], 0, 0, 0); __builtin_amdgcn_s_setprio(0); } while (0)
#define PG8_WAIT_V(n) asm volatile("s_waitcnt vmcnt(" #n ")" ::: "memory")
#define PG8_WAIT_L(n) asm volatile("s_waitcnt lgkmcnt(" #n ")" ::: "memory")
#define PG8_BAR __builtin_amdgcn_s_barrier()
#define PG8_SCHED __builtin_amdgcn_sched_barrier(0)
    Unit cur, nxt; int ui = 0;
    if (!S.next(0, cur)) return;
    f32x4 acc[2][2][4][2];
#pragma unroll
    for (int a = 0; a < 2; ++a)
#pragma unroll
        for (int b = 0; b < 2; ++b)
#pragma unroll
            for (int m = 0; m < 4; ++m)
#pragma unroll
                for (int n = 0; n < 2; ++n) acc[a][b][m][n] = (f32x4){0.f, 0.f, 0.f, 0.f};
    bf16x8 At[4][2], B0[2][2], B1[2][2];
    const char* cA = (const char*)g.A + (GATHER ? (size_t)0 : (size_t)cur.pm * tstep); const char* cB = (const char*)g.Bt + (size_t)cur.pn * tstep;
    if constexpr (GATHER) { PG8_GOFF(gaC, 0); }
    S.a_ready(cur);
    if constexpr (SP2) {
        PG8_STAGE(PG8_SB(0, 0), cB, voffB); PG8_STAGE(PG8_SB(0, 1), cB + hstep, voffB); PG8_STAGEA(PG8_SA(0, 0), cA, 0, false); PG8_STAGEA(PG8_SA(0, 1), cA, 1, false);
        if (wr == 1) PG8_BAR;
        PG8_WAIT_V(2); PG8_BAR;
        PG8_STAGE(PG8_SB(1, 0), cB + kstep, voffB); PG8_STAGEA(PG8_SA(1, 0), cA + kstep, 0, false); PG8_STAGE(PG8_SB(1, 1), cB + hstep + kstep, voffB);
        PG8_WAIT_V(6); PG8_BAR;
    } else {
        PG8_STAGE(PG8_SB(0, 0), cB, voffB); PG8_STAGEA(PG8_SA(0, 0), cA, 0, false); PG8_STAGE(PG8_SB(0, 1), cB + hstep, voffB); PG8_STAGEA(PG8_SA(0, 1), cA, 1, false);
        if (wr == 1) PG8_BAR;
        PG8_WAIT_V(4); PG8_BAR;
        PG8_STAGE(PG8_SB(1, 0), cB + kstep, voffB); PG8_STAGEA(PG8_SA(1, 0), cA + kstep, 0, false); PG8_STAGE(PG8_SB(1, 1), cB + hstep + kstep, voffB);
        PG8_WAIT_V(6); PG8_BAR;
    }
    for (;;) {
        const bool has_next = S.next(ui + 1, nxt);
        const char* nA = (has_next && !GATHER) ? (const char*)g.A + (size_t)nxt.pm * tstep : cA; const char* nB = has_next ? (const char*)g.Bt + (size_t)nxt.pn * tstep : cB;
        if constexpr (GATHER) { if (has_next) { PG8_GOFF(gaN, ui + 1); } else { _Pragma("unroll") for (int h_ = 0; h_ < 2; ++h_) _Pragma("unroll") for (int i_ = 0; i_ < 2; ++i_) gaN[h_][i_] = gaC[h_][i_]; } }
        for (int t = 0; t < nt; t += 2) {
            const bool last = (t == nt - 2);
            const char* a1 = cA + (size_t)(t + 1) * kstep;
            const char* a2 = last ? nA : cA + (size_t)(t + 2) * kstep; const char* b2 = last ? nB : cB + (size_t)(t + 2) * kstep;
            const char* a3 = a2 + kstep; const char* b3 = b2 + kstep;
            if (last && has_next) S.a_ready(nxt);
            if constexpr (SP2) {
            PG8_LDB(B0, 0, 0); PG8_LDB(B1, 0, 1); PG8_SCHED; PG8_LDA(At, 0, 0); PG8_STAGEA(PG8_SA(1, 1), a1, 1, false);
            PG8_WAIT_V(8); PG8_WAIT_L(0); PG8_BAR; PG8_MMA(0, 0, At, B0); PG8_MMA(0, 1, At, B1); PG8_BAR; PG8_SCHED;
            PG8_LDA(At, 0, 1); PG8_STAGE(PG8_SB(0, 0), b2, voffB); PG8_STAGE(PG8_SB(0, 1), b2 + hstep, voffB); PG8_STAGEA(PG8_SA(0, 0), a2, 0, last);
            PG8_WAIT_V(8); PG8_WAIT_L(0); PG8_BAR; PG8_MMA(1, 0, At, B0); PG8_MMA(1, 1, At, B1); PG8_BAR; PG8_SCHED;
            PG8_LDB(B0, 1, 0); PG8_LDB(B1, 1, 1); PG8_SCHED; PG8_LDA(At, 1, 0); PG8_STAGEA(PG8_SA(0, 1), a2, 1, last);
            PG8_WAIT_V(8); PG8_WAIT_L(0); PG8_BAR; PG8_MMA(0, 0, At, B0); PG8_MMA(0, 1, At, B1); PG8_BAR; PG8_SCHED;
            PG8_LDA(At, 1, 1); PG8_STAGE(PG8_SB(1, 0), b3, voffB); PG8_STAGE(PG8_SB(1, 1), b3 + hstep, voffB); PG8_STAGEA(PG8_SA(1, 0), a3, 0, last);
            PG8_WAIT_V(8); PG8_WAIT_L(0); PG8_BAR; PG8_MMA(1, 0, At, B0); PG8_MMA(1, 1, At, B1); PG8_BAR; PG8_SCHED;
            } else {
            PG8_LDB(B0, 0, 0); PG8_SCHED; PG8_LDA(At, 0, 0); PG8_STAGEA(PG8_SA(1, 1), a1, 1, false);
            PG8_WAIT_L(8); PG8_BAR; PG8_WAIT_L(0); PG8_MMA(0, 0, At, B0); PG8_BAR; PG8_SCHED;
            PG8_LDB(B1, 0, 1); PG8_STAGE(PG8_SB(0, 0), b2, voffB);
            PG8_BAR; PG8_WAIT_L(0); PG8_MMA(0, 1, At, B1); PG8_BAR;
            PG8_LDA(At, 0, 1); PG8_STAGEA(PG8_SA(0, 0), a2, 0, last);
            PG8_BAR; PG8_WAIT_L(0); PG8_MMA(1, 0, At, B0); PG8_BAR; PG8_SCHED;
            PG8_STAGE(PG8_SB(0, 1), b2 + hstep, voffB);
            PG8_WAIT_V(6); PG8_BAR; PG8_MMA(1, 1, At, B1); PG8_BAR;
            PG8_LDB(B0, 1, 0); PG8_SCHED; PG8_LDA(At, 1, 0); PG8_STAGEA(PG8_SA(0, 1), a2, 1, last);
            PG8_WAIT_L(8); PG8_BAR; PG8_WAIT_L(0); PG8_MMA(0, 0, At, B0); PG8_BAR; PG8_SCHED;
            PG8_LDB(B1, 1, 1); PG8_STAGE(PG8_SB(1, 0), b3, voffB);
            PG8_BAR; PG8_WAIT_L(0); PG8_MMA(0, 1, At, B1); PG8_BAR;
            PG8_LDA(At, 1, 1); PG8_STAGEA(PG8_SA(1, 0), a3, 0, last);
            PG8_BAR; PG8_WAIT_L(0); PG8_MMA(1, 0, At, B0); PG8_BAR; PG8_SCHED;
            PG8_STAGE(PG8_SB(1, 1), b3 + hstep, voffB);
            PG8_WAIT_V(6); PG8_BAR; PG8_MMA(1, 1, At, B1); PG8_BAR;
            }
        }
        if constexpr (ALIGN_EPI) { if (wr == 0) PG8_BAR; }
        if constexpr (!Epi::AFTER_DRAIN) { E(acc, cur, wr, wc, fr, fq); S.done(cur); }
        if (!has_next) break;
#pragma unroll
        for (int a = 0; a < 2; ++a)
#pragma unroll
            for (int b = 0; b < 2; ++b)
#pragma unroll
                for (int m = 0; m < 4; ++m)
#pragma unroll
                    for (int n = 0; n < 2; ++n) acc[a][b][m][n] = (f32x4){0.f, 0.f, 0.f, 0.f};
        cur = nxt; cA = nA; cB = nB; ++ui;
        if constexpr (GATHER) { _Pragma("unroll") for (int h_ = 0; h_ < 2; ++h_) _Pragma("unroll") for (int i_ = 0; i_ < 2; ++i_) gaC[h_][i_] = gaN[h_][i_]; }
        if constexpr (ALIGN_EPI) { if (wr == 1) PG8_BAR; }
    }
    PG8_WAIT_V(0);
    if constexpr (!ALIGN_EPI) { if (wr == 0) PG8_BAR; }
    PG8_BAR;
    if constexpr (Epi::AFTER_DRAIN) { E.fused(acc, cur, wr, wc, fr, fq, lds, wid, lane); S.done(cur); }
#undef PG8_SA
#undef PG8_SB
#undef PG8_STAGE
#undef PG8_STAGEA
#undef PG8_GOFF
#undef PG8_LDA
#undef PG8_LDB
#undef PG8_MMA
#undef PG8_WAIT_V
#undef PG8_WAIT_L
#undef PG8_BAR
#undef PG8_SCHED
}
}

#define GAS __attribute__((address_space(1)))
#define LAS __attribute__((address_space(3)))
typedef unsigned short bf16;
typedef float f32x4 __attribute__((ext_vector_type(4)));
typedef float f32x2 __attribute__((ext_vector_type(2)));
typedef short bf16x8 __attribute__((ext_vector_type(8)));
typedef unsigned u32x4 __attribute__((ext_vector_type(4)));
typedef unsigned u32x2 __attribute__((ext_vector_type(2)));

constexpr int NB = 4, SEQ = 8192, T = NB * SEQ, DM = 1024;
constexpr int NW_IN = 7168;
constexpr int NCHUNK = 64, NUNIT_M = NB * 8 * NCHUNK;
constexpr float ALPHA = 1.189207115002721f;
constexpr float QSCALE2 = 0.125f * 1.4426950408889634f;
constexpr float LN_EPS = 1e-5f, GN_EPS = 1e-6f;
#ifdef IDX_NOCLAMP
constexpr float IDX_QSCALE = 1.0f, IDX_WSCALE = 1.0f;
#else
constexpr float IDX_QSCALE = 9.313225746154785e-10f, IDX_WSCALE = 1073741824.0f;
#endif
constexpr int MOE_MAXROWS = 65536 + 16 * 256;

constexpr size_t MiB = 1u << 20;
constexpr size_t WS_CTL = 0;
constexpr size_t WS_WIN = 1 * MiB;
constexpr size_t WS_WBA = 15 * MiB;
constexpr size_t WS_WBM = 16 * MiB;
constexpr size_t WS_WOUT = 18 * MiB;
constexpr size_t WS_COS = 20 * MiB, WS_SIN = 21 * MiB;
constexpr size_t WS_BIAS = 22 * MiB;
constexpr size_t WS_TE = 22 * MiB + 64 * 1024;
constexpr size_t WS_TW = WS_TE + (size_t)T * 16;
constexpr size_t WS_POS = WS_TW + (size_t)T * 8;
constexpr size_t WS_CST = 24 * MiB;
constexpr size_t WS_DSC = 60 * MiB;
constexpr size_t WS_MC = 60 * MiB + 64 * 1024;
constexpr size_t WS_DN = 61 * MiB;
constexpr size_t WS_WGU = 24 * MiB;
constexpr size_t WS_WD = 56 * MiB;
constexpr size_t WS_AQ = 72 * MiB, WS_AK = 104 * MiB, WS_AV = 136 * MiB;
constexpr size_t WS_IQ = 168 * MiB;
constexpr size_t WS_IK = 184 * MiB;
constexpr size_t WS_IW = 188 * MiB;
constexpr size_t WS_MI = 189 * MiB, WS_MF = 190 * MiB;
constexpr size_t WS_MQ = 192 * MiB, WS_MK = 224 * MiB;
constexpr size_t WS_MV = 256 * MiB;
constexpr size_t WS_MO = 320 * MiB;
constexpr size_t WS_GA = 384 * MiB;
constexpr size_t WS_MASK = 448 * MiB;
constexpr size_t WS_YA = 480 * MiB;
constexpr size_t WS_MERGED = 192 * MiB;
constexpr size_t WS_X1B = 72 * MiB;
constexpr size_t WS_INV = 136 * MiB;
constexpr size_t WS_H = 208 * MiB;
constexpr size_t WS_Y = 276 * MiB;
constexpr size_t WS_END = 512 * MiB;
constexpr size_t DO_XN = 0;
constexpr size_t DO_GM = 64 * MiB;
constexpr size_t DO_DC = 0;
constexpr size_t DO_YM = 0;
constexpr int CW_CURSOR = 64;
constexpr int CW_MISMATCH = 96;

struct Params { const float* in[19]; float* out; unsigned char* ws; };

__device__ __forceinline__ float bf2f(unsigned h) { return __uint_as_float(h << 16); }
typedef float f32x2_t_ __attribute__((ext_vector_type(2))); typedef __bf16 bf16x2_t_ __attribute__((ext_vector_type(2)));
__device__ __forceinline__ unsigned pk2(float lo, float hi) { const f32x2_t_ v = {lo, hi}; const bf16x2_t_ b = __builtin_convertvector(v, bf16x2_t_); return __builtin_bit_cast(unsigned, b); }
__device__ __forceinline__ unsigned f2bf(float f) { return pk2(f, 0.f) & 0xffffu; }
__device__ __forceinline__ float rcpf_(float x) { return __builtin_amdgcn_rcpf(x); }
__device__ __forceinline__ float sigmoidf_(float x) { return __builtin_amdgcn_rcpf(1.0f + __builtin_amdgcn_exp2f(-1.4426950408889634f * x)); }
__device__ __forceinline__ float siluf_(float x) { return x * __builtin_amdgcn_rcpf(1.0f + __builtin_amdgcn_exp2f(-1.4426950408889634f * x)); }
__device__ __forceinline__ float logsigmoidf_(float x) { return fminf(x, 0.f) - log1pf(__expf(-fabsf(x))); }
__device__ __forceinline__ float wave_sum(float v) {
#pragma unroll
    for (int o = 1; o < 64; o <<= 1) v += __shfl_xor(v, o);
    return v;
}
__device__ __forceinline__ float wave_max(float v) {
#pragma unroll
    for (int o = 1; o < 64; o <<= 1) v = fmaxf(v, __shfl_xor(v, o));
    return v;
}
__host__ __device__ __forceinline__ int ropeil(int d) { return d < 32 ? 2 * d : 2 * (d - 32) + 1; }
__host__ __device__ __forceinline__ int win_newcol(int c) {
    if (c < 1024) return (c & ~63) + ropeil(c & 63);
    if (c < 1536) return c;
    if (c < 1792) return (c & ~63) + ropeil(c & 63);
    if (c < 1856) return 1792 + ropeil(c - 1792);
    if (c < 1860) return 1792 + 64 + (c - 1856);
    if (c < 2372) return 2048 + (c - 1860);
    if (c < 2884) return 2560 + (c - 2372);
    if (c < 3908) return 3072 + (c - 2884);
    if (c < 3916) return 1792 + 72 + (c - 3908);
    if (c < 3924) return 1792 + 80 + (c - 3916);
    if (c < 4948) return 4096 + (c - 3924);
    if (c < 5972) return 5120 + (c - 4948);
    return 6144 + (c - 5972);
}
typedef GAS unsigned gu32;
typedef GAS unsigned long long gu64;
#define RLX_AGENT __ATOMIC_RELAXED, __HIP_MEMORY_SCOPE_AGENT
#define LDS_WAIT() asm volatile("s_waitcnt lgkmcnt(0)" ::: "memory")
#define VM_WAIT() asm volatile("s_waitcnt vmcnt(0)" ::: "memory")
__device__ __forceinline__ unsigned long long rt() { return __builtin_amdgcn_s_memrealtime(); }
#define XB_TMO      128
#define XB_XCNT(j)  (256  + 64 * (j))
#define XB_XSUB(j)  (1280 + 64 * (j))
#define XB_XGEN(j)  (2304 + 64 * (j))
#define XB_TOP      3328
#define XB_TOPGEN   3392
#define XCD_BAR_WORDS 3456
#define XB_SPIN_CAP (1u << 18)

__device__ __forceinline__ unsigned xb_ld(unsigned* p)              { return __hip_atomic_load(p, __ATOMIC_RELAXED, __HIP_MEMORY_SCOPE_AGENT); }
__device__ __forceinline__ unsigned xb_add(unsigned* p, unsigned v) { return __hip_atomic_fetch_add(p, v, __ATOMIC_RELAXED, __HIP_MEMORY_SCOPE_AGENT); }
__device__ __forceinline__ unsigned xb_xcc_id() { return (unsigned)__builtin_amdgcn_s_getreg((3 << 11) | 20) & 0xFu; }
#define XB_SPIN(cond, bar) do { unsigned _sp = 0; while (cond) { __builtin_amdgcn_s_sleep(1); \
    if ((++_sp & 255u) == 0u) { if (xb_ld(&(bar)[XB_TMO])) break; if (_sp > XB_SPIN_CAP) { atomicAdd(&(bar)[XB_TMO], 1u); break; } } } } while (0)

struct XcdBarrier {
    unsigned* bar; unsigned x;
    volatile LAS unsigned* st;
};

__device__ __forceinline__ XcdBarrier xcd_barrier_post(unsigned* bar, volatile LAS unsigned* st) {
    XcdBarrier b; b.bar = bar; b.x = xb_xcc_id(); b.st = st;
    if (threadIdx.x == 0) (void)xb_add(&bar[XB_XCNT(b.x)], 1u);
    return b;
}
__device__ __forceinline__ void xcd_barrier_complete(unsigned* bar, unsigned x, unsigned& nloc, unsigned& nx) {
    const unsigned G = gridDim.x * gridDim.y * gridDim.z;
    unsigned sum, cnt, mine, sp = 0u;
    for (;;) {
        sum = 0u; cnt = 0u; mine = 0u;
#pragma unroll
        for (unsigned j = 0; j < 16; ++j) { const unsigned c = xb_ld(&bar[XB_XCNT(j)]); sum += c; cnt += (c > 0u) ? 1u : 0u; mine = (j == x) ? c : mine; }
        if (sum == G) break;
        __builtin_amdgcn_s_sleep(1);
        if ((++sp & 255u) == 0u) { if (xb_ld(&bar[XB_TMO])) break; if (sp > XB_SPIN_CAP) { atomicAdd(&bar[XB_TMO], 1u); break; } }
    }
    nloc = mine > 0u ? mine : 1u; nx = cnt > 0u ? cnt : 1u;
}

__device__ __forceinline__ void xcd_barrier(const XcdBarrier& b) {
    asm volatile("s_waitcnt vmcnt(0)" ::: "memory");
    __syncthreads();
    if (threadIdx.x == 0) {
        unsigned* bar = b.bar;
        __builtin_amdgcn_s_waitcnt(0);
        unsigned nloc = b.st[0], nx = b.st[1];
        if (nloc == 0u) { xcd_barrier_complete(bar, b.x, nloc, nx); b.st[0] = nloc; b.st[1] = nx; }
        const unsigned old = xb_add(&bar[XB_XSUB(b.x)], 1u);
        const unsigned gen = old / nloc;
        if (old + 1u == (gen + 1u) * nloc) {
            __builtin_amdgcn_fence(__ATOMIC_RELEASE, "agent");
            asm volatile("s_waitcnt vmcnt(0)" ::: "memory");
            const unsigned og = xb_add(&bar[XB_TOP], 1u);
            const unsigned tg = og / nx;
            if (og + 1u == (tg + 1u) * nx) xb_add(&bar[XB_TOPGEN], 1u);
            else XB_SPIN(xb_ld(&bar[XB_TOPGEN]) == tg, bar);
            __builtin_amdgcn_fence(__ATOMIC_ACQUIRE, "agent");
            xb_add(&bar[XB_XGEN(b.x)], 1u);
            asm volatile("s_waitcnt vmcnt(0)" ::: "memory");
        } else {
            XB_SPIN(xb_ld(&bar[XB_XGEN(b.x)]) == gen, bar);
            __builtin_amdgcn_fence(__ATOMIC_ACQUIRE, "agent");
            asm volatile("s_waitcnt vmcnt(0)" ::: "memory");
        }
    }
    __syncthreads();
}

template <class F>
__device__ __forceinline__ void transpose_item(const float* W, int K, int N, bf16* WT, LAS float* scr, int item, int lane, F rowmap, int ldk = 0, int koff = 0) {
    if (ldk == 0) ldk = K;
    const int nblk = (N + 31) / 32, kb = item / nblk, nb = item % nblk, k0 = 64 * kb, n0 = 32 * nb;
    const int nsrc = n0 + (lane & 31);
    float wv[32];
#pragma unroll
    for (int i = 0; i < 32; ++i) { const int kk = 2 * i + (lane >> 5); wv[i] = nsrc < N ? W[(size_t)(k0 + kk) * N + nsrc] : 0.f; }
#pragma unroll
    for (int i = 0; i < 32; ++i) { const int kk = 2 * i + (lane >> 5); scr[kk * 33 + (lane & 31)] = wv[i]; }
    asm volatile("s_waitcnt lgkmcnt(0)" ::: "memory");
    const int c = lane & 7;
#pragma unroll
    for (int j = 0; j < 4; ++j) {
        const int nl = (lane >> 3) + 8 * j, n = n0 + nl;
        const LAS float* s = scr + (8 * c) * 33 + nl;
        u32x4 o; o.x = pk2(s[0 * 33], s[1 * 33]); o.y = pk2(s[2 * 33], s[3 * 33]); o.z = pk2(s[4 * 33], s[5 * 33]); o.w = pk2(s[6 * 33], s[7 * 33]);
        if (n < N) { const int dr = rowmap(n); *(u32x4*)(WT + (size_t)dr * ldk + koff + k0 + 8 * c) = o; }
    }
    asm volatile("s_waitcnt lgkmcnt(0)" ::: "memory");
}

struct MapId { __device__ __forceinline__ int operator()(int n) const { return n; } };
struct MapWin { __device__ __forceinline__ int operator()(int n) const { return win_newcol(n); } };
struct MapGU { int off; __device__ __forceinline__ int operator()(int n) const { return (n >> 7) * 256 + off + (n & 127); } };

__device__ __forceinline__ void row_to_bf16(const float* xrow, bf16* orow, int lane) {
    const f32x4* xr = (const f32x4*)xrow + lane;
    unsigned long long* o8 = (unsigned long long*)orow + lane;
#pragma unroll
    for (int j = 0; j < 4; ++j) { const f32x4 v = xr[64 * j]; o8[64 * j] = (unsigned long long)pk2(v.x, v.y) | ((unsigned long long)pk2(v.z, v.w) << 32); }
}

__device__ __forceinline__ void phase_prologue(const Params& p, LAS unsigned char* lds) {
    int tid_ = threadIdx.x; asm volatile("" : "+v"(tid_));
    const int tid = tid_, lane = tid & 63, wave = tid >> 6;
    const int gw = blockIdx.x * 8 + wave, NGW = gridDim.x * 8;
    LAS float* scr = (LAS float*)(lds + wave * 16384);
    unsigned char* ws = p.ws;
    constexpr int I_WIN = (1024 / 64) * 219, I_WBA = (512 / 64) * 32, I_WBM = 16 * 32, I_WOUT = 16 * 32;
    constexpr int NIT = I_WIN + I_WBA + I_WBM + I_WOUT;
    for (int it = gw; it < NIT; it += NGW) {
        int r = it;
        if (r < I_WIN) { transpose_item(p.in[1], 1024, 6996, (bf16*)(ws + WS_WIN), scr, r, lane, MapWin()); continue; } r -= I_WIN;
        if (r < I_WBA) { transpose_item(p.in[5], 512, 1024, (bf16*)(ws + WS_WBA), scr, r, lane, MapId()); continue; } r -= I_WBA;
        if (r < I_WBM) { transpose_item(p.in[6], 1024, 1024, (bf16*)(ws + WS_WBM), scr, r, lane, MapId()); continue; } r -= I_WBM;
        transpose_item(p.in[7], 1024, 1024, (bf16*)(ws + WS_WOUT), scr, r, lane, MapId());
    }
    {
        const int gt = blockIdx.x * 512 + tid, NGT = gridDim.x * 512;
        bf16* wt = (bf16*)(ws + WS_WIN); float* bp = (float*)(ws + WS_BIAS);
        for (int i = gt; i < 172 * 128; i += NGT) {
            const int pr = i / 128, ch = i % 128; const int row = pr < 4 ? 1860 + pr : 1880 + (pr - 4);
            *(u32x4*)(wt + (size_t)row * 1024 + ch * 8) = (u32x4){0u, 0u, 0u, 0u};
        }
        for (int i = gt; i < 172; i += NGT) { const int row = i < 4 ? 1860 + i : 1880 + (i - 4); bp[row] = 0.f; }
        for (int c = gt; c < 6996; c += NGT) bp[win_newcol(c)] = p.in[2][c];
    }
    bf16* xn = (bf16*)((unsigned char*)p.out + DO_XN);
    for (int m = gw; m < T; m += 4 * NGW) {
        f32x4 v[4][4];
#pragma unroll
        for (int r = 0; r < 4; ++r) { const int mr = m + r * NGW; if (mr < T) { const f32x4* xr = (const f32x4*)(p.in[0] + (size_t)mr * DM) + lane;
#pragma unroll
            for (int j = 0; j < 4; ++j) v[r][j] = xr[64 * j]; } }
#pragma unroll
        for (int r = 0; r < 4; ++r) { const int mr = m + r * NGW; if (mr < T) { unsigned long long* o8 = (unsigned long long*)(xn + (size_t)mr * DM) + lane;
#pragma unroll
            for (int j = 0; j < 4; ++j) o8[64 * j] = (unsigned long long)pk2(v[r][j].x, v[r][j].y) | ((unsigned long long)pk2(v[r][j].z, v[r][j].w) << 32); } }
    }
}

__device__ __forceinline__ void phase_expert_weights(const Params& p, LAS unsigned char* lds) {
    int tid_ = threadIdx.x; asm volatile("" : "+v"(tid_));
    const int tid = tid_, lane = tid & 63, wave = tid >> 6;
    const int gw = blockIdx.x * 8 + wave, NGW = gridDim.x * 8;
    LAS float* scr = (LAS float*)(lds + wave * 16384);
    constexpr int I_G = 16 * 16, I_D = 8 * 32;
    constexpr int NIT = 16 * (2 * I_G + I_D);
    for (int it = gw; it < NIT; it += NGW) {
        const int e = it / (2 * I_G + I_D); int r = it % (2 * I_G + I_D);
        bf16* wgu = (bf16*)(p.ws + WS_WGU) + (size_t)e * 1024 * 1024;
        if (r < I_G) { transpose_item(p.in[14] + (size_t)e * 1024 * 512, 1024, 512, wgu, scr, r, lane, MapGU{0}); continue; } r -= I_G;
        if (r < I_G) { transpose_item(p.in[15] + (size_t)e * 1024 * 512, 1024, 512, wgu, scr, r, lane, MapGU{128}); continue; } r -= I_G;
        transpose_item(p.in[16] + (size_t)e * 512 * 1024, 512, 1024, (bf16*)(p.ws + WS_WD) + (size_t)e * 1024 * 512, scr, r, lane, MapId());
    }
}

__device__ __forceinline__ void rope_cs(const LAS float* linv, int t, int d0, f32x4& c4, f32x4& s4) {
    const f32x4 fr4 = *(const LAS f32x4*)(linv + d0); const float tf = (float)t;
#pragma unroll
    for (int i = 0; i < 4; ++i) { const float rev = __builtin_amdgcn_fractf(tf * fr4[i]); c4[i] = __builtin_amdgcn_cosf(rev); s4[i] = __builtin_amdgcn_sinf(rev); }
}
struct EpiInProj {
    static constexpr bool PERM = true, AFTER_DRAIN = false;
    unsigned char* ws; unsigned char* dout; const LAS bf16* lbias; const LAS float* linv;
    __device__ __forceinline__ void operator()(const f32x4 (&acc)[2][2][4][2], const pg8::Unit& u, int wr, int wc, int fr, int fq) const {
        const int pn = u.pn;
        const int row0 = u.pm * 256 + wr * 64 + fr;
        const int cl0 = wc * 32 + 8 * fq;
        f32x4 bv[2][2];
#pragma unroll
        for (int bj = 0; bj < 2; ++bj) { const u32x4 bw = *(const LAS u32x4*)(lbias + pn * 256 + cl0 + bj * 128);
            bv[bj][0] = (f32x4){__uint_as_float(bw.x << 16), __uint_as_float(bw.x & 0xffff0000u), __uint_as_float(bw.y << 16), __uint_as_float(bw.y & 0xffff0000u)};
            bv[bj][1] = (f32x4){__uint_as_float(bw.z << 16), __uint_as_float(bw.z & 0xffff0000u), __uint_as_float(bw.w << 16), __uint_as_float(bw.w & 0xffff0000u)}; }
        int cat; bf16* dst = nullptr; int ld = 0, cb = 0; float sc = 1.f;
        if (pn < 2)       { cat = 0; dst = (bf16*)(ws + WS_AQ); ld = 512; cb = pn * 256; sc = QSCALE2; }
        else if (pn < 4)  { cat = 0; dst = (bf16*)(ws + WS_AK); ld = 512; cb = (pn - 2) * 256; }
        else if (pn < 6)  { cat = 1; dst = (bf16*)(ws + WS_AV); ld = 512; cb = (pn - 4) * 256; }
        else if (pn == 6) { cat = 0; dst = (bf16*)(ws + WS_IQ); ld = 256; cb = 0; sc = IDX_QSCALE; }
        else if (pn == 7) { cat = 3; }
        else if (pn < 10) { cat = 1; dst = (bf16*)(ws + WS_MQ); ld = 512; cb = (pn - 8) * 256; }
        else if (pn < 12) { cat = 1; dst = (bf16*)(ws + WS_MK); ld = 512; cb = (pn - 10) * 256; }
        else if (pn < 16) { cat = 1; dst = (bf16*)(ws + WS_MV); ld = 1024; cb = (pn - 12) * 256; }
        else if (pn < 20) { cat = 2; dst = (bf16*)(ws + WS_MO); ld = 1024; cb = (pn - 16) * 256; }
        else if (pn < 24) { cat = 2; dst = (bf16*)(ws + WS_GA); ld = 1024; cb = (pn - 20) * 256; }
        else              { cat = 2; dst = (bf16*)(dout + DO_GM); ld = 1024; cb = (pn - 24) * 256; }
#pragma unroll
        for (int ai = 0; ai < 2; ++ai)
#pragma unroll
            for (int m = 0; m < 4; ++m) {
                const int row = row0 + ai * 128 + m * 16;
                const int t = row & (SEQ - 1);
#pragma unroll
                for (int bj = 0; bj < 2; ++bj) {
                    f32x4 v0 = acc[ai][bj][m][0] + bv[bj][0], v1 = acc[ai][bj][m][1] + bv[bj][1];
                    const int cl = cl0 + bj * 128;
                    if (cat == 3) {
                        if (cl < 64) {
                            const int d0 = cl >> 1;
                            f32x4 c4, s4; rope_cs(linv, t, d0, c4, s4);
                            u32x4 w;
                            w.x = pk2(v0[0] * c4[0] - v0[1] * s4[0], v0[0] * s4[0] + v0[1] * c4[0]);
                            w.y = pk2(v0[2] * c4[1] - v0[3] * s4[1], v0[2] * s4[1] + v0[3] * c4[1]);
                            w.z = pk2(v1[0] * c4[2] - v1[1] * s4[2], v1[0] * s4[2] + v1[1] * c4[2]);
                            w.w = pk2(v1[2] * c4[3] - v1[3] * s4[3], v1[2] * s4[3] + v1[3] * c4[3]);
                            *(u32x4*)((bf16*)(ws + WS_IK) + (size_t)row * 64 + cl) = w;
                        } else if (cl == 64) {
                            *(f32x4*)((float*)(ws + WS_IW) + (size_t)row * 4) = v0 * (0.0625f * IDX_WSCALE);
                        } else if (cl == 72) {
                            float* d = (float*)(ws + WS_MI) + (size_t)row * 8; *(f32x4*)d = v0; *(f32x4*)(d + 4) = v1;
                        } else if (cl == 80) {
                            float* d = (float*)(ws + WS_MF) + (size_t)row * 8; *(f32x4*)d = v0; *(f32x4*)(d + 4) = v1;
                        }
                    } else {
                        u32x4 w;
                        if (cat == 0) {
                            const int d0 = (cl & 63) >> 1;
                            f32x4 c4, s4; rope_cs(linv, t, d0, c4, s4);
                            w.x = pk2((v0[0] * c4[0] - v0[1] * s4[0]) * sc, (v0[0] * s4[0] + v0[1] * c4[0]) * sc);
                            w.y = pk2((v0[2] * c4[1] - v0[3] * s4[1]) * sc, (v0[2] * s4[1] + v0[3] * c4[1]) * sc);
                            w.z = pk2((v1[0] * c4[2] - v1[1] * s4[2]) * sc, (v1[0] * s4[2] + v1[1] * c4[2]) * sc);
                            w.w = pk2((v1[2] * c4[3] - v1[3] * s4[3]) * sc, (v1[2] * s4[3] + v1[3] * c4[3]) * sc);
                        } else if (cat == 1) {
                            w.x = pk2(v0[0], v0[1]); w.y = pk2(v0[2], v0[3]); w.z = pk2(v1[0], v1[1]); w.w = pk2(v1[2], v1[3]);
                        } else {
                            w.x = pk2(sigmoidf_(v0[0]), sigmoidf_(v0[1])); w.y = pk2(sigmoidf_(v0[2]), sigmoidf_(v0[3]));
                            w.z = pk2(sigmoidf_(v1[0]), sigmoidf_(v1[1])); w.w = pk2(sigmoidf_(v1[2]), sigmoidf_(v1[3]));
                        }
                        *(u32x4*)(dst + (size_t)row * ld + cb + cl) = w;
                    }
                }
            }
    }
};

constexpr int INP_LBIAS = 131072, INP_LINV = 131072 + 14336;
__device__ __forceinline__ void phase_inproj(const Params& p, LAS unsigned char* lds) {
    {
        LAS bf16* lb = (LAS bf16*)(lds + INP_LBIAS); LAS float* li = (LAS float*)(lds + INP_LINV);
        const float* bp = (const float*)(p.ws + WS_BIAS);
        int tl_ = threadIdx.x; asm volatile("" : "+v"(tl_));
        for (int i = tl_; i < NW_IN; i += 512) lb[i] = (bf16)f2bf(bp[i]);
        if (tl_ < 32) li[tl_] = (float)(pow(10000.0, -(double)tl_ / 32.0)) * 0.15915494309189535f;
        __syncthreads();
    }
    pg8::Gemm g{(const bf16*)((unsigned char*)p.out + DO_XN), (const bf16*)(p.ws + WS_WIN), T, NW_IN, 1024};
    pg8::StaticOrder S; S.init(T, NW_IN, gridDim.x, (int)blockIdx.x);
    EpiInProj E{p.ws, (unsigned char*)p.out, (const LAS bf16*)(lds + INP_LBIAS), (const LAS float*)(lds + INP_LINV)};
    pg8::gemm_phase<EpiInProj, pg8::StaticOrder, true, true>(lds, g, S, E);
}

struct EpiDummy {
    static constexpr bool PERM = true, AFTER_DRAIN = false;
    bf16* O;
    __device__ __forceinline__ void operator()(const f32x4 (&acc)[2][2][4][2], const pg8::Unit& u, int wr, int wc, int fr, int fq) const {
        const int row0 = u.pm * 256 + wr * 64 + fr, col0 = wc * 32 + 8 * fq;
#pragma unroll
        for (int ai = 0; ai < 2; ++ai)
#pragma unroll
            for (int m = 0; m < 4; ++m)
#pragma unroll
                for (int bj = 0; bj < 2; ++bj) {
                    const f32x4 v0 = acc[ai][bj][m][0], v1 = acc[ai][bj][m][1];
                    u32x4 w; w.x = pk2(v0[0], v0[1]); w.y = pk2(v0[2], v0[3]); w.z = pk2(v1[0], v1[1]); w.w = pk2(v1[2], v1[3]);
                    *(u32x4*)(O + (size_t)(row0 + ai * 128 + m * 16) * 256 + col0 + bj * 128) = w;
                }
    }
};
__device__ __forceinline__ void phase_inproj_dummy(const Params& p, LAS unsigned char* lds) {
    pg8::Gemm g{(const bf16*)((unsigned char*)p.out + DO_XN), (const bf16*)(p.ws + WS_WIN), T, NW_IN, 1024};
    pg8::StaticOrder S; S.init(T, NW_IN, gridDim.x, (int)blockIdx.x);
    EpiDummy E{(bf16*)(p.ws + WS_MASK)};
    pg8::gemm_phase<EpiDummy, pg8::StaticOrder, true, true>(lds, g, S, E);
}

typedef float f32x16 __attribute__((ext_vector_type(16)));
struct IdxQ { bf16x8 qf[4][4]; float w[4]; };
__device__ __forceinline__ float relu_f(float x) { const int b = __float_as_int(x); return __int_as_float(b & ~(b >> 31)); }

__device__ __forceinline__ void idx_loadk(const bf16* IK, size_t keytok0, int lane, bf16x8 (&kf)[4]) {
    const bf16* kp = IK + (keytok0 + (lane & 31)) * 64 + 8 * (lane >> 5);
#pragma unroll
    for (int ks = 0; ks < 4; ++ks) kf[ks] = *(const bf16x8*)(kp + ks * 16);
}
#define IDX_RP(i_) "v_pk_mul_f32 %[t" #i_ "], %[a" #i_ "], 1.0 op_sel_hi:[1,0] clamp\n\tv_pk_fma_f32 %[s" #i_ "], %[w], %[t" #i_ "], %[s" #i_ "]\n\t"
__device__ __forceinline__ void idx_scores2(const bf16x8 (&kf)[4], const IdxQ& Q, f32x2 (&sc)[8]) {
#pragma unroll
    for (int i = 0; i < 8; ++i) sc[i] = (f32x2){0.f, 0.f};
#pragma unroll
    for (int h = 0; h < 4; ++h) {
        f32x16 acc = {0.f, 0.f, 0.f, 0.f, 0.f, 0.f, 0.f, 0.f, 0.f, 0.f, 0.f, 0.f, 0.f, 0.f, 0.f, 0.f};
#pragma unroll
        for (int ks = 0; ks < 4; ++ks) acc = __builtin_amdgcn_mfma_f32_32x32x16_bf16(kf[ks], Q.qf[h][ks], acc, 0, 0, 0);
        const f32x2 w2 = {Q.w[h], Q.w[h]};
#ifdef IDX_NOCLAMP
#pragma unroll
        for (int i = 0; i < 8; ++i) { const f32x2 rl = {relu_f(acc[2 * i]), relu_f(acc[2 * i + 1])}; sc[i] = __builtin_elementwise_fma(w2, rl, sc[i]); }
#else
        { const f32x2 rl = {relu_f(acc[0]), relu_f(acc[1])}; sc[0] = __builtin_elementwise_fma(w2, rl, sc[0]); }
        const f32x2 a1 = {acc[2], acc[3]}, a2 = {acc[4], acc[5]}, a3 = {acc[6], acc[7]}, a4 = {acc[8], acc[9]}, a5 = {acc[10], acc[11]}, a6 = {acc[12], acc[13]}, a7 = {acc[14], acc[15]};
        f32x2 t1, t2, t3, t4, t5, t6, t7;
        asm(IDX_RP(1) IDX_RP(2) IDX_RP(3) IDX_RP(4) IDX_RP(5) IDX_RP(6) IDX_RP(7)
            : [s1] "+v"(sc[1]), [s2] "+v"(sc[2]), [s3] "+v"(sc[3]), [s4] "+v"(sc[4]), [s5] "+v"(sc[5]), [s6] "+v"(sc[6]), [s7] "+v"(sc[7]),
              [t1] "=&v"(t1), [t2] "=&v"(t2), [t3] "=&v"(t3), [t4] "=&v"(t4), [t5] "=&v"(t5), [t6] "=&v"(t6), [t7] "=&v"(t7)
            : [a1] "v"(a1), [a2] "v"(a2), [a3] "v"(a3), [a4] "v"(a4), [a5] "v"(a5), [a6] "v"(a6), [a7] "v"(a7), [w] "v"(w2), [dep] "v"(sc[0]));
#endif
    }
}
#undef IDX_RP
#define IDX_CB(n_) "v_cmp_ge_f32_e32 vcc, %" #n_ ", %18\n\tv_addc_co_u32_e32 %0, vcc, %0, %0, vcc\n\tv_cmp_ge_f32_e32 vcc, %" #n_ ", %19\n\tv_addc_co_u32_e32 %1, vcc, %1, %1, vcc\n\t"
__device__ __forceinline__ void idx_cmpbits(const f32x2 (&sc)[8], float fH, float fL, unsigned& mh, unsigned& ml) {
    unsigned a = 0u, b = 0u;
    asm(IDX_CB(17) IDX_CB(16) IDX_CB(15) IDX_CB(14) IDX_CB(13) IDX_CB(12) IDX_CB(11) IDX_CB(10) IDX_CB(9) IDX_CB(8) IDX_CB(7) IDX_CB(6) IDX_CB(5) IDX_CB(4) IDX_CB(3) IDX_CB(2)
        : "+v"(a), "+v"(b)
        : "v"(sc[0][0]), "v"(sc[0][1]), "v"(sc[1][0]), "v"(sc[1][1]), "v"(sc[2][0]), "v"(sc[2][1]), "v"(sc[3][0]), "v"(sc[3][1]),
          "v"(sc[4][0]), "v"(sc[4][1]), "v"(sc[5][0]), "v"(sc[5][1]), "v"(sc[6][0]), "v"(sc[6][1]), "v"(sc[7][0]), "v"(sc[7][1]), "v"(fH), "v"(fL)
        : "vcc");
    mh = a; ml = b;
}
#undef IDX_CB

constexpr int IDX_HIST = 0, IDX_THR = 131072, IDX_NEED = 131072 + 128, IDX_CCNT = 131072 + 256, IDX_SEG = 131072 + 384, IDX_THRH = 131072 + 384 + 4096, IDX_LO = IDX_THRH + 128, IDX_SI = IDX_LO + 128, IDX_FLAG = IDX_SI + 128;
constexpr int IDX_BASE = 107 << 23;
constexpr int IDX_TOP = IDX_BASE + (1024 << 18) - 1;

template <bool FINE> __device__ __forceinline__ void idx_hadd(LAS unsigned char* histb, unsigned bb, int cF, unsigned q4) {
    if (FINE) {
        const int m = min(max((int)(bb & 0x7FFFFFFFu), IDX_BASE), IDX_TOP);
        const unsigned a = (((unsigned)m >> 18) << 7) + (unsigned)cF;
        __hip_atomic_fetch_add((LAS unsigned*)a, ((int)bb < 0) ? 65536u : 1u, __ATOMIC_RELAXED, __HIP_MEMORY_SCOPE_WORKGROUP);
    } else {
        __hip_atomic_fetch_add((LAS unsigned*)(histb + (((bb >> 14) & 0x1FF80u) | q4)), ((int)bb < 0) ? 65536u : 1u, __ATOMIC_RELAXED, __HIP_MEMORY_SCOPE_WORKGROUP);
    }
}

#define IDX_H1(n_, A_, B_) "v_med3_f32 %" #A_ ", |%" #n_ "|, %21, %22\n\tv_bfe_u32 %" #B_ ", %" #n_ ", 31, 1\n\tv_bfe_u32 %" #A_ ", %" #A_ ", 18, 14\n\tv_mad_u32_u24 %" #B_ ", %" #B_ ", %24, 1\n\tv_lshl_add_u32 %" #A_ ", %" #A_ ", 7, %23\n\tds_add_u32 %" #A_ ", %" #B_ "\n\t"
__device__ __forceinline__ void idx_hist16_fine(const f32x2 (&sc)[8], int cF) {
    unsigned t0, t1, t2, t3; const float lo = __int_as_float(IDX_BASE), hi = __int_as_float(IDX_TOP); const int c16 = 65535;
    asm volatile(IDX_H1(4, 0, 1) IDX_H1(5, 2, 3) IDX_H1(6, 0, 1) IDX_H1(7, 2, 3) IDX_H1(8, 0, 1) IDX_H1(9, 2, 3) IDX_H1(10, 0, 1) IDX_H1(11, 2, 3)
                 IDX_H1(12, 0, 1) IDX_H1(13, 2, 3) IDX_H1(14, 0, 1) IDX_H1(15, 2, 3) IDX_H1(16, 0, 1) IDX_H1(17, 2, 3) IDX_H1(18, 0, 1) IDX_H1(19, 2, 3)
        : "=&v"(t0), "=&v"(t1), "=&v"(t2), "=&v"(t3)
        : "v"(sc[0][0]), "v"(sc[0][1]), "v"(sc[1][0]), "v"(sc[1][1]), "v"(sc[2][0]), "v"(sc[2][1]), "v"(sc[3][0]), "v"(sc[3][1]),
          "v"(sc[4][0]), "v"(sc[4][1]), "v"(sc[5][0]), "v"(sc[5][1]), "v"(sc[6][0]), "v"(sc[6][1]), "v"(sc[7][0]), "v"(sc[7][1]),
          "v"(0), "v"(lo), "v"(hi), "v"(cF), "v"(c16)
        : "memory");
}
#undef IDX_H1
template <bool FINE> __device__ __forceinline__ void idx_pass1(const bf16* IK, size_t tokb, const IdxQ& Q, LAS unsigned char* histb, int qg, int ntl, int wave, int lane, int t) {
    const int q = lane & 31, hi = lane >> 5;
    const int cF = (int)(unsigned)(size_t)histb + 4 * q - ((IDX_BASE >> 18) << 7); const unsigned q4 = (unsigned)(4 * q);
#ifdef IDX_KPF
    bf16x8 kn[2][4];
    { const int t0 = min(wave, ntl - 1); idx_loadk(IK, tokb + (size_t)t0 * 64, lane, kn[0]); idx_loadk(IK, tokb + (size_t)t0 * 64 + 32, lane, kn[1]); }
#endif
#pragma unroll 1
    for (int tile = wave; tile < ntl; tile += 8) {
        bf16x8 kt[2][4];
#ifdef IDX_KPF
#pragma unroll
        for (int i = 0; i < 4; ++i) { kt[0][i] = kn[0][i]; kt[1][i] = kn[1][i]; }
        { const int t1 = min(tile + 8, ntl - 1); idx_loadk(IK, tokb + (size_t)t1 * 64, lane, kn[0]); idx_loadk(IK, tokb + (size_t)t1 * 64 + 32, lane, kn[1]); }
#else
        idx_loadk(IK, tokb + (size_t)tile * 64, lane, kt[0]);
        if (2 * tile + 1 <= qg) idx_loadk(IK, tokb + (size_t)tile * 64 + 32, lane, kt[1]);
#endif
#pragma unroll
        for (int pp = 0; pp < 2; ++pp) {
            const int blk = 2 * tile + pp;
            if (blk <= qg) {
                f32x2 sc2[8]; idx_scores2(kt[pp], Q, sc2);
                if (blk < qg) {
                    if (FINE) idx_hist16_fine(sc2, cF);
                    else {
#pragma unroll
                        for (int r = 0; r < 16; ++r) idx_hadd<FINE>(histb, __float_as_uint(sc2[r >> 1][r & 1]), cF, q4);
                    }
                } else {
#pragma unroll
                    for (int r = 0; r < 16; ++r) { const int key = blk * 32 + (r & 3) + 8 * (r >> 2) + 4 * hi;
                        if (key <= t) idx_hadd<FINE>(histb, __float_as_uint(sc2[r >> 1][r & 1]), cF, q4); }
                }
            }
        }
    }
    asm volatile("s_waitcnt lgkmcnt(0)" ::: "memory");
}

template <bool FINE> __device__ __forceinline__ void idx_find_thr(LAS unsigned* hist, LAS int* segsum, LAS int* thrb, LAS unsigned* thrh, LAS int* need, LAS unsigned* thrlo, LAS unsigned* thrsi, LAS int* flag, int tid) {
    { const int qq_ = tid & 31, seg_ = tid >> 5; int sp_ = 0, sn_ = 0;
#pragma unroll 8
      for (int i = 0; i < 64; ++i) { const unsigned wv = hist[(1023 - 64 * seg_ - i) * 32 + qq_]; sp_ += (int)(wv & 0xffffu); sn_ += (int)(wv >> 16); }
      segsum[seg_ * 32 + qq_] = sp_; segsum[(31 - seg_) * 32 + qq_] = sn_; }
    __syncthreads();
    {
        const int qq_ = tid >> 4, part = tid & 15, lane = tid & 63, grp = (lane >> 4) * 16;
        const int s0 = segsum[(2 * part) * 32 + qq_], s1 = segsum[(2 * part + 1) * 32 + qq_];
        int incl = s0 + s1;
#pragma unroll
        for (int o = 1; o < 16; o <<= 1) { const int v = __shfl_up(incl, o, 16); if (part >= o) incl += v; }
        const int excl = incl - s0 - s1;
        const int tot = __shfl(incl, 15, 16);
        bool h0 = (excl < 256 && excl + s0 >= 256), h1 = (excl + s0 < 256 && excl + s0 + s1 >= 256);
        if (tot < 256) { h0 = false; h1 = (part == 15); }
        const unsigned gm = (unsigned)((__ballot(h0 || h1) >> grp) & 0xFFFFull);
        const int src = gm ? (int)__builtin_ctz(gm) : 15;
        const int sgl = h0 ? 2 * part : 2 * part + 1, cml = h0 ? excl : excl + s0;
        const int sg = __shfl(sgl, src, 16), cums = __shfl(cml, src, 16);
        const bool neg_ = sg >= 16; const int base_ = neg_ ? 64 * (sg - 16) : 1023 - 64 * sg, dir_ = neg_ ? 1 : -1, sh_ = neg_ ? 16 : 0;
        int c_[4];
#pragma unroll
        for (int e = 0; e < 4; ++e) c_[e] = (int)((hist[(base_ + dir_ * (4 * part + e)) * 32 + qq_] >> sh_) & 0xffffu);
        const int ls = c_[0] + c_[1] + c_[2] + c_[3];
        int inc2 = ls;
#pragma unroll
        for (int o = 1; o < 16; o <<= 1) { const int v = __shfl_up(inc2, o, 16); if (part >= o) inc2 += v; }
        int cum = cums + inc2 - ls;
        int wsel_ = 0, above_ = 0, csel_ = 0; bool done_ = false;
#pragma unroll
        for (int e = 0; e < 4; ++e) { if (!done_ && cum < 256 && cum + c_[e] >= 256) { wsel_ = base_ + dir_ * (4 * part + e); above_ = cum; csel_ = c_[e]; done_ = true; } cum += c_[e]; }
        const bool any_ = ((__ballot(done_) >> grp) & 0xFFFFull) != 0ull;
        if (done_ || (!any_ && part == 0)) {
            unsigned L_, H_, lo_, s_;
            const unsigned w_ = (unsigned)wsel_;
            if (!done_) { L_ = 0xFF800000u; H_ = 0xFF800000u; above_ = 256; lo_ = 0u; s_ = 0u; }
            else if (FINE) {
                if (csel_ > 1024) flag[0] = 1;
                const unsigned bl_ = (unsigned)IDX_BASE + (w_ << 18), bh_ = bl_ + (1u << 18);
                lo_ = (w_ == 0u) ? 0u : bl_; s_ = (w_ == 0u || w_ == 1023u) ? 11u : 0u;
                if (!neg_) { L_ = lo_; H_ = (w_ == 1023u) ? 0x7F800000u : bh_; }
                else { H_ = (w_ == 0u) ? 0u : (0x80000000u | (bl_ - 1u)); L_ = (w_ == 1023u) ? 0xFF800000u : (0x80000000u | (bh_ - 1u)); s_ |= 0x80000000u; }
            } else {
                lo_ = w_ << 21; s_ = 2u;
                if (!neg_) { L_ = lo_; H_ = (w_ == 1023u) ? 0x7F800000u : ((w_ + 1u) << 21); }
                else { H_ = (w_ == 0u) ? 0u : (0x80000000u | (lo_ - 1u)); L_ = 0x80000000u | (((w_ + 1u) << 21) - 1u); s_ |= 0x80000000u; }
            }
            thrb[qq_] = (int)L_; thrh[qq_] = H_; need[qq_] = 256 - above_; thrlo[qq_] = lo_; thrsi[qq_] = s_;
        }
    }
    __syncthreads();
}

__device__ __forceinline__ void indexer_unit(const Params& p, LAS unsigned char* lds, int b, int qg) {
    int tid_ = threadIdx.x; asm volatile("" : "+v"(tid_));
    const int tid = tid_, lane = tid & 63, wave = __builtin_amdgcn_readfirstlane(tid >> 6), q = lane & 31, hi = lane >> 5;
    LAS unsigned* hist = (LAS unsigned*)(lds + IDX_HIST);
    LAS int* thrb = (LAS int*)(lds + IDX_THR);
    LAS unsigned* thrh = (LAS unsigned*)(lds + IDX_THRH);
    LAS int* need = (LAS int*)(lds + IDX_NEED);
    LAS unsigned* ccnt = (LAS unsigned*)(lds + IDX_CCNT);
    LAS int* segsum = (LAS int*)(lds + IDX_SEG);
    LAS int* flag = (LAS int*)(lds + IDX_FLAG);
    LAS unsigned* thrlo = (LAS unsigned*)(lds + IDX_LO); LAS unsigned* thrsi = (LAS unsigned*)(lds + IDX_SI);
    const bf16* IQ = (const bf16*)(p.ws + WS_IQ); const bf16* IK = (const bf16*)(p.ws + WS_IK); const float* IW = (const float*)(p.ws + WS_IW);
    unsigned* MASK = (unsigned*)(p.ws + WS_MASK) + ((size_t)(b * 256 + qg) * 128) * 64;
    const size_t tokb = (size_t)b * SEQ;
    const int t = qg * 32 + q;
    const int ntl = (qg >> 1) + 1;
    const int ntw = 4 * (qg >> 3) + 4;
    IdxQ Q;
    {
        const bf16* qp = IQ + (tokb + t) * 256 + 8 * hi;
#pragma unroll
        for (int h = 0; h < 4; ++h)
#pragma unroll
            for (int ks = 0; ks < 4; ++ks) Q.qf[h][ks] = *(const bf16x8*)(qp + h * 64 + ks * 16);
        const f32x4 w4 = *(const f32x4*)(IW + (tokb + t) * 4);
        Q.w[0] = w4[0]; Q.w[1] = w4[1]; Q.w[2] = w4[2]; Q.w[3] = w4[3];
    }
    const bool full = (qg < 8);
    if (tid < 32) { ccnt[tid] = 0u; thrb[tid] = (int)0xFF800000u; thrh[tid] = 0xFF800000u; need[tid] = 0; thrlo[tid] = 0u; thrsi[tid] = 0u; }
    if (tid == 0) flag[0] = 0;
    if (!full) {
        for (int i = tid; i < 8192; i += 512) ((LAS u32x4*)hist)[i] = (u32x4){0u, 0u, 0u, 0u};
        __syncthreads();
#ifndef IDX_REP_P1
#define IDX_REP_P1 1
#endif
        for (int rep1_ = 0; rep1_ < IDX_REP_P1; ++rep1_) {
            if (rep1_) { __syncthreads(); for (int i = tid; i < 8192; i += 512) ((LAS u32x4*)hist)[i] = (u32x4){0u, 0u, 0u, 0u}; __syncthreads(); }
            idx_pass1<true>(IK, tokb, Q, (LAS unsigned char*)hist, qg, ntl, wave, lane, t);
        }
        __syncthreads();
#ifndef IDX_REP_THR
#define IDX_REP_THR 1
#endif
        for (int rept_ = 0; rept_ < IDX_REP_THR; ++rept_) idx_find_thr<true>(hist, segsum, thrb, thrh, need, thrlo, thrsi, flag, tid);
        if (flag[0] != 0) {
            __syncthreads();
            for (int i = tid; i < 8192; i += 512) ((LAS u32x4*)hist)[i] = (u32x4){0u, 0u, 0u, 0u};
            __syncthreads();
            idx_pass1<false>(IK, tokb, Q, (LAS unsigned char*)hist, qg, ntl, wave, lane, t);
            __syncthreads();
            idx_find_thr<false>(hist, segsum, thrb, thrh, need, thrlo, thrsi, flag, tid);
        }
        __syncthreads();
    } else {
        __syncthreads();
    }
    LAS unsigned* rec = hist;
    const float fL = __int_as_float(thrb[q]), fH = __uint_as_float(thrh[q]);
#ifndef IDX_REP_P2
#define IDX_REP_P2 1
#endif
    for (int rep2_ = 0; rep2_ < IDX_REP_P2; ++rep2_) {
    if (rep2_) { __syncthreads(); if (tid < 32) ccnt[tid] = 0u; __syncthreads(); }
#ifdef IDX_KPF
    bf16x8 kn[2][4];
    { const int t0 = min(wave, ntl - 1); idx_loadk(IK, tokb + (size_t)t0 * 64, lane, kn[0]); idx_loadk(IK, tokb + (size_t)t0 * 64 + 32, lane, kn[1]); }
#endif
#pragma unroll 1
    for (int tile = wave; tile < ntw; tile += 8) {
        unsigned mw = 0u;
        if (tile < ntl) {
            bf16x8 kt[2][4];
#ifdef IDX_KPF
#pragma unroll
            for (int i = 0; i < 4; ++i) { kt[0][i] = kn[0][i]; kt[1][i] = kn[1][i]; }
            { const int t1 = min(tile + 8, ntl - 1); idx_loadk(IK, tokb + (size_t)t1 * 64, lane, kn[0]); idx_loadk(IK, tokb + (size_t)t1 * 64 + 32, lane, kn[1]); }
#else
            idx_loadk(IK, tokb + (size_t)tile * 64, lane, kt[0]);
            if (2 * tile + 1 <= qg) idx_loadk(IK, tokb + (size_t)tile * 64 + 32, lane, kt[1]);
#endif
#pragma unroll
            for (int pp = 0; pp < 2; ++pp) {
                const int blk = 2 * tile + pp;
                if (blk <= qg) {
                    f32x2 sc2[8];
                    idx_scores2(kt[pp], Q, sc2);
                    unsigned mh, ml;
                    idx_cmpbits(sc2, fH, fL, mh, ml);
                    if (blk == qg) {
                        unsigned vm = 0u;
#pragma unroll
                        for (int r = 0; r < 16; ++r) vm |= (blk * 32 + (r & 3) + 8 * (r >> 2) + 4 * hi <= t) ? (1u << r) : 0u;
                        mh &= vm; ml &= vm;
                    }
                    const unsigned cm = ml & ~mh;
                    mw |= mh << (16 * pp);
                    if (__ballot(cm != 0u)) {
                        unsigned slot = 0u;
                        if (cm) slot = __hip_atomic_fetch_add(ccnt + q, (unsigned)__popc(cm), __ATOMIC_RELAXED, __HIP_MEMORY_SCOPE_WORKGROUP);
                        const unsigned rlo = thrlo[q], rsi = thrsi[q];
#pragma unroll
                        for (int r = 0; r < 16; ++r) {
                            if (cm & (1u << r)) {
                                const int key = blk * 32 + (r & 3) + 8 * (r >> 2) + 4 * hi;
                                const unsigned mag = __float_as_uint(sc2[r >> 1][r & 1]) & 0x7FFFFFFFu;
                                const unsigned mid = (((mag - rlo) >> (rsi & 31u)) ^ (unsigned)((int)rsi >> 31)) & 0x7FFFFu;
                                if (slot < 1024u) rec[q * 1024 + slot] = (mid << 13) | (unsigned)(8191 - key);
                                ++slot;
                            }
                        }
                    }
                }
            }
        }
        MASK[(size_t)tile * 64 + lane] = mw;
    }
    }
    asm volatile("s_waitcnt vmcnt(0)" ::: "memory");
    __syncthreads();
    if (!full) {
#ifndef IDX_REP_BIS
#define IDX_REP_BIS 1
#endif
#pragma unroll 1
        for (int repb_ = 0; repb_ < IDX_REP_BIS; ++repb_) {
        int mq[4], ndq[4], rk[4]; unsigned rv0[4];
#pragma unroll
        for (int k = 0; k < 4; ++k) { mq[k] = __builtin_amdgcn_readfirstlane((int)min(ccnt[wave * 4 + k], 1024u)); ndq[k] = __builtin_amdgcn_readfirstlane(need[wave * 4 + k]); }
        int mmax = 0;
#pragma unroll
        for (int k = 0; k < 4; ++k) { const bool small = mq[k] <= 64; rv0[k] = (small && lane < mq[k]) ? rec[(wave * 4 + k) * 1024 + lane] : 0u; rk[k] = 0; if (small) mmax = max(mmax, mq[k]); }
#pragma unroll 1
        for (int j = 0; j < mmax; ++j) {
#pragma unroll
            for (int k = 0; k < 4; ++k) { const unsigned x = (unsigned)__builtin_amdgcn_readlane((int)rv0[k], j); rk[k] += (x > rv0[k]) ? 1 : 0; }
        }
#pragma unroll
        for (int k = 0; k < 4; ++k) {
            if (mq[k] <= 64 && lane < mq[k] && rk[k] < ndq[k]) {
                const int key = 8191 - (int)(rv0[k] & 8191u);
                const int tile = key >> 6, pp = (key >> 5) & 1, k5 = key & 31, khi = (k5 >> 2) & 1, r = (k5 & 3) + 4 * (k5 >> 3);
                atomicOr(MASK + (size_t)tile * 64 + (wave * 4 + k) + 32 * khi, 1u << (16 * pp + r));
            }
        }
#pragma unroll 1
        for (int k = 0; k < 4; ++k) {
            const int qq = wave * 4 + k;
            const int m = __builtin_amdgcn_readfirstlane((int)min(ccnt[qq], 1024u)), nd = __builtin_amdgcn_readfirstlane(need[qq]);
            if (m <= 64) continue;
            const int jmax = (m + 63) >> 6;
            unsigned rv[16];
#pragma unroll
            for (int j = 0; j < 16; ++j) rv[j] = (j < jmax && lane + 64 * j < m) ? rec[qq * 1024 + lane + 64 * j] : 0u;
            unsigned theta = 0u;
            if (jmax <= 4) {
#pragma unroll 1
                for (int bit = 31; bit >= 0; --bit) {
                    const unsigned cand = theta | (1u << bit);
                    const int cnt = __popcll(__ballot(rv[0] >= cand)) + __popcll(__ballot(rv[1] >= cand)) + __popcll(__ballot(rv[2] >= cand)) + __popcll(__ballot(rv[3] >= cand));
                    theta = (cnt >= nd) ? cand : theta;
                }
            } else {
#pragma unroll 1
                for (int bit = 31; bit >= 0; --bit) {
                    const unsigned cand = theta | (1u << bit);
                    int cnt = 0;
#pragma unroll
                    for (int j = 0; j < 16; ++j) cnt += __popcll(__ballot(rv[j] >= cand));
                    theta = (cnt >= nd) ? cand : theta;
                }
            }
#pragma unroll
            for (int j = 0; j < 16; ++j) {
                if (j < jmax && lane + 64 * j < m && rv[j] >= theta) {
                    const int key = 8191 - (int)(rv[j] & 8191u);
                    const int tile = key >> 6, pp = (key >> 5) & 1, k5 = key & 31, khi = (k5 >> 2) & 1, r = (k5 & 3) + 4 * (k5 >> 3);
                    atomicOr(MASK + (size_t)tile * 64 + qq + 32 * khi, 1u << (16 * pp + r));
                }
            }
        }
        }
    }
    __syncthreads();
}

__device__ __forceinline__ void phase_indexer(const Params& p, LAS unsigned char* lds) {
    for (int i = blockIdx.x; i < 256; i += gridDim.x) {
        const int b = (i & 7) >> 1, j = ((i & 1) << 5) + (i >> 3);
        indexer_unit(p, lds, b, 255 - j);
        indexer_unit(p, lds, b, 128 + j);
        indexer_unit(p, lds, b, 127 - j);
        indexer_unit(p, lds, b, j);
    }
}

#include <hip/hip_bf16.h>
#include <cmath>
namespace attn_body {
using bf16=__hip_bfloat16;
using bf16x8=__attribute__((ext_vector_type(8)))short;
using s16x4=__attribute__((ext_vector_type(4)))short;
using f32x16=__attribute__((ext_vector_type(16)))float;
using u32x4=__attribute__((ext_vector_type(4)))unsigned;
constexpr int BATCH=4,NHEAD=8,SEQ=8192,D=64,DM=NHEAD*D;
constexpr int NW=8,QBLK=32,QB=QBLK*NW,KVBLK=64,NQB=SEQ/QB;
constexpr int ATTN_PITCH=DM, ATTN_UNIT_ROWS=QB;
__device__ __forceinline__ int crow(int r,int hi){return (r&3)+8*(r>>2)+4*hi;}
#define SBAR() __builtin_amdgcn_sched_barrier(0)
__device__ __forceinline__ void cmask(f32x16&p0,f32x16&p1,int jb,int qrel,int hi){
  const float NEG=-INFINITY; int kb=64*jb+4*hi;
  #pragma unroll
  for(int r=0;r<16;++r){int kv=kb+(r&3)+8*(r>>2); if(kv>qrel)p0[r]=NEG; if(kv+32>qrel)p1[r]=NEG;}
}

constexpr int NSLOT=3, SLOTB=8192;
constexpr int LDS_K=0, LDS_V=NSLOT*SLOTB, LDS_WS=2*NSLOT*SLOTB, LDS_OST=LDS_WS+NW*64*4, LDS_BYTES=LDS_OST+NW*4096;
constexpr float C2=0.125f*1.4426950408889634f;
__device__ __forceinline__ void glds16(const void*gsrc,unsigned lds_dst){unsigned keep;
  asm volatile("s_mov_b32 %0, m0\n\ts_mov_b32 m0, %2\n\ts_nop 0\n\tglobal_load_lds_dwordx4 %1, off\n\ts_mov_b32 m0, %0":"=&s"(keep):"v"(gsrc),"s"(lds_dst):"memory");}
__device__ __forceinline__ float max3f(float a,float b,float c){float r;asm("v_max3_f32 %0, %1, %2, %3":"=v"(r):"v"(a),"v"(b),"v"(c));return r;}
__device__ __forceinline__ float max2f(float a,float b){float r;asm("v_max_f32_e32 %0, %1, %2":"=v"(r):"v"(a),"v"(b));return r;}
__device__ __forceinline__ float fadd_s(float a,float b){float r;asm("v_add_f32_e32 %0, %1, %2":"=v"(r):"v"(a),"v"(b));return r;}
__device__ __forceinline__ float fsub_s(float a,float b){float r;asm("v_sub_f32_e32 %0, %1, %2":"=v"(r):"v"(a),"v"(b));return r;}
typedef float f32x2_t __attribute__((ext_vector_type(2))); typedef __bf16 bf16x2_t __attribute__((ext_vector_type(2)));
__device__ __forceinline__ unsigned cvtpk_s(float lo,float hi){f32x2_t v={lo,hi};bf16x2_t b=__builtin_convertvector(v,bf16x2_t);return __builtin_bit_cast(unsigned,b);}
#define WAIT_BAR(N) asm volatile("s_waitcnt vmcnt(" #N ") lgkmcnt(0)\n\ts_barrier":::"memory")

__device__ __forceinline__ void qkt(f32x16&p0,f32x16&p1,const char*Kslot,const bf16x8*qr,const f32x16&negm,int r32,int hi){
  const char*kb=Kslot+hi*1024+r32*16;
  #pragma unroll
  for(int d0=0;d0<4;++d0){
    const bf16x8 b0=*reinterpret_cast<const bf16x8*>(kb+d0*2048);
    const bf16x8 b1=*reinterpret_cast<const bf16x8*>(kb+d0*2048+512);
    if(d0==0){p0=__builtin_amdgcn_mfma_f32_32x32x16_bf16(b0,qr[0],negm,0,0,0);p1=__builtin_amdgcn_mfma_f32_32x32x16_bf16(b1,qr[0],negm,0,0,0);}
    else{p0=__builtin_amdgcn_mfma_f32_32x32x16_bf16(b0,qr[d0],p0,0,0,0);p1=__builtin_amdgcn_mfma_f32_32x32x16_bf16(b1,qr[d0],p1,0,0,0);}}
}
typedef __attribute__((address_space(3))) const char* lds_cptr;
typedef short v4i16_t __attribute__((ext_vector_type(4)));
__device__ __forceinline__ void kload8(bf16x8*kf,lds_cptr kp){
  kf[0]=*(const __attribute__((address_space(3))) bf16x8*)(kp);      kf[1]=*(const __attribute__((address_space(3))) bf16x8*)(kp+512);
  kf[2]=*(const __attribute__((address_space(3))) bf16x8*)(kp+2048); kf[3]=*(const __attribute__((address_space(3))) bf16x8*)(kp+2560);
  kf[4]=*(const __attribute__((address_space(3))) bf16x8*)(kp+4096); kf[5]=*(const __attribute__((address_space(3))) bf16x8*)(kp+4608);
  kf[6]=*(const __attribute__((address_space(3))) bf16x8*)(kp+6144); kf[7]=*(const __attribute__((address_space(3))) bf16x8*)(kp+6656);
}
__device__ __forceinline__ void kload2(bf16x8*kf,lds_cptr kp,int j){ kf[2*j]=*(const __attribute__((address_space(3))) bf16x8*)(kp+j*2048); kf[2*j+1]=*(const __attribute__((address_space(3))) bf16x8*)(kp+j*2048+512); }
__device__ __forceinline__ s16x4 vtr(lds_cptr p){ return __builtin_bit_cast(s16x4,__builtin_amdgcn_ds_read_tr16_b64_v4i16((__attribute__((address_space(3))) v4i16_t*)p)); }
__device__ __forceinline__ float rowmax(const f32x16&p0,const f32x16&p1){
  float a=max3f(p0[0],p0[1],p1[0]),b=max3f(p0[2],p0[3],p1[1]);a=max3f(a,p1[2],p1[3]);
  #pragma unroll
  for(int r=4;r<16;r+=4){a=max3f(a,p0[r],p0[r+1]);b=max3f(b,p0[r+2],p0[r+3]);a=max3f(a,p1[r],p1[r+1]);b=max3f(b,p1[r+2],p1[r+3]);}
  const float m=max2f(a,b);
  auto rr=__builtin_amdgcn_permlane32_swap(__float_as_uint(m),__float_as_uint(m),false,false);
  return max2f(__uint_as_float(rr[0]),__uint_as_float(rr[1]));
}
__device__ __forceinline__ void pv(f32x16*o,int vb,bf16x8 pa0,bf16x8 pa1,bf16x8 pa2,bf16x8 pa3){
  #pragma unroll
  for(int d0=0;d0<2;++d0){s16x4 lo[4],hi[4];
    #pragma unroll
    for(int ks=0;ks<4;++ks){
      asm volatile("ds_read_b64_tr_b16 %0,%1 offset:%c2":"=&v"(lo[ks]):"v"(vb),"i"(d0*4096+ks*1024):"memory");
      asm volatile("ds_read_b64_tr_b16 %0,%1 offset:%c2":"=&v"(hi[ks]):"v"(vb),"i"(d0*4096+ks*1024+512):"memory");}
    asm volatile("s_waitcnt lgkmcnt(0)":::"memory");SBAR();
    #define PK(k) (bf16x8){lo[k][0],lo[k][1],lo[k][2],lo[k][3],hi[k][0],hi[k][1],hi[k][2],hi[k][3]}
    o[d0]=__builtin_amdgcn_mfma_f32_32x32x16_bf16(pa0,PK(0),o[d0],0,0,0);
    o[d0]=__builtin_amdgcn_mfma_f32_32x32x16_bf16(pa1,PK(1),o[d0],0,0,0);
    o[d0]=__builtin_amdgcn_mfma_f32_32x32x16_bf16(pa2,PK(2),o[d0],0,0,0);
    o[d0]=__builtin_amdgcn_mfma_f32_32x32x16_bf16(pa3,PK(3),o[d0],0,0,0);
    #undef PK
  }
}

#ifndef ATTN_STORE16
#define ATTN_STORE16(p,v) (*(u32x4*)(p)=(v))
#endif
template<int THRL> __device__ __forceinline__ void attn_unit(int b,int h,int qb,const bf16*Q,const bf16*__restrict__ K,const bf16*__restrict__ V,bf16*O,const unsigned long long*MASK64,char*shm){
  int tid_=threadIdx.x; asm volatile("":"+v"(tid_)); const int tid=tid_,lane=tid&63,r32=lane&31,hi=lane>>5; const int wid=__builtin_amdgcn_readfirstlane(tid>>6);
  const long rowbase=(long)b*SEQ; const int q0=qb*QB;
  const bf16*Qw=Q+(rowbase+q0+wid*QBLK)*DM+h*D;
  const bf16*Kh=K+rowbase*DM+h*D,*Vh=V+rowbase*DM+h*D;
  const unsigned lds0=(unsigned)(uintptr_t)shm;
  float*wsf=(float*)(shm+LDS_WS)+wid*64;
  const bf16*ksrc=Kh+(long)lane*DM+wid*8;
  const bf16*vsrc=Vh+(long)(16*(wid&3)+(lane>>2))*DM+(wid>>2)*32+(lane&3)*8;
  const unsigned kdst=lds0+LDS_K+wid*1024, vdst=lds0+LDS_V+wid*1024;
  #define DMA_K(t,slot) glds16(ksrc+(long)(t)*KVBLK*DM,(unsigned)__builtin_amdgcn_readfirstlane(kdst+(slot)))
  #define DMA_V(t,slot) glds16(vsrc+(long)(t)*KVBLK*DM,(unsigned)__builtin_amdgcn_readfirstlane(vdst+(slot)))
  const int vb0=(int)(lds0+LDS_V)+((lane>>4)&1)*32+(lane&3)*8+(4*hi+((lane&15)>>2))*64;
  const char*Kbase=shm+LDS_K; bf16x8 kf[8];
  const lds_cptr shm3=(lds_cptr)shm; const lds_cptr kp0=shm3+LDS_K+hi*1024+r32*16; const lds_cptr vp0=shm3+LDS_V+((lane>>4)&1)*32+(lane&3)*8+(4*hi+((lane&15)>>2))*64;
  const int NT=(q0+QB)/KVBLK;
  DMA_K(0,0);DMA_V(0,0);DMA_K(1,SLOTB);
  bf16x8 qr[4];
  #pragma unroll
  for(int d0=0;d0<4;++d0)qr[d0]=*reinterpret_cast<const bf16x8*>(&Qw[(long)r32*DM+d0*16+hi*8]);
  float mhat=0.f,l_reg=0.f;f32x16 o[2];o[0]=f32x16{};o[1]=f32x16{};f32x16 negm=f32x16{};asm volatile("":"+v"(negm));
  const int qrel=wid*QBLK+r32; (void)qrel;
  const char*mbase=(const char*)MASK64+((size_t)(b*256+qb*8+wid)*128)*256;
  const unsigned moff=(unsigned)lane*4u;
  unsigned mwcur=*(const unsigned*)(mbase+moff);
  #define MASK_NEXT(t) do{ if(((t)+1)<NT){ const unsigned long long ma_=(unsigned long long)(uintptr_t)(mbase+(size_t)((t)+1)*256); \
      asm volatile("s_nop 4\n\tglobal_load_dword %0, %1, %2":"=v"(mwcur):"v"(moff),"s"(ma_):"memory"); } }while(0)
#define MLOAD(t)
#define CMASK(P0,P1,t) do{ const unsigned w_=mwcur; \
    _Pragma("unroll") for(int r=0;r<16;++r){ const int m0_=((int)(w_<<(31-r)))>>31, m1_=((int)(w_<<(15-r)))>>31; \
      P0[r]=__uint_as_float((__float_as_uint(P0[r])&(unsigned)m0_)|(0xFF800000u&~(unsigned)m0_)); P1[r]=__uint_as_float((__float_as_uint(P1[r])&(unsigned)m1_)|(0xFF800000u&~(unsigned)m1_)); } \
    asm volatile("":"+v"(P0),"+v"(P1)); MASK_NEXT(t); }while(0)
  bool resc=false;
  #define START(P0,P1) do{ const float rm=rowmax(P0,P1); resc=false; \
    { const float dl=__builtin_fmaxf(rm,-60.f); mhat=fadd_s(mhat,dl); \
      _Pragma("unroll") for(int r=0;r<16;++r){P0[r]=fsub_s(P0[r],dl);P1[r]=fsub_s(P1[r],dl);} \
      _Pragma("unroll") for(int r=0;r<16;++r)negm[r]=-mhat; asm volatile("":"+v"(negm)); } \
    _Pragma("unroll") for(int r=0;r<16;++r)P0[r]=__builtin_amdgcn_exp2f(P0[r]); }while(0)
  #define RESC() do{ if(resc){ asm volatile("s_waitcnt lgkmcnt(0)":::"memory"); \
      _Pragma("unroll") for(int d_=0;d_<2;++d_) _Pragma("unroll") for(int r=0;r<16;++r)o[d_][r]*=wsf[crow(r,hi)]; } }while(0)
  f32x16 pA0,pA1,pB0,pB1;
  int sl_prev=0,sl_cur=0,sl_next=SLOTB;
  #define ROT() do{sl_prev=sl_cur;sl_cur=sl_next;sl_next=(sl_next==(NSLOT-1)*SLOTB)?0:sl_next+SLOTB;}while(0)
  DMA_K(2,2*SLOTB);
  WAIT_BAR(3);
  { qkt(pA0,pA1,Kbase,qr,negm,r32,hi);asm volatile("s_nop 15\n\ts_nop 7":"+v"(pA0),"+v"(pA1));CMASK(pA0,pA1,0); }
  START(pA0,pA1);
  _Pragma("unroll") for(int r=0;r<16;++r)pA1[r]=__builtin_amdgcn_exp2f(pA1[r]);
  WAIT_BAR(0);
  DMA_K(3,0);DMA_V(1,SLOTB);
  ROT();
  kload8(kf,kp0+sl_cur);
  WAIT_BAR(2);
  s16x4 vlo[8],vhi[8]; u32x4 pw0,pw1,pw2,pw3;
  #define PKW(P,B) cvtpk_s(P[B],P[B+1])
  #define PAF(k) __builtin_bit_cast(bf16x8,pw##k)
  #define VFR(i) (bf16x8){vlo[i][0],vlo[i][1],vlo[i][2],vlo[i][3],vhi[i][0],vhi[i][1],vhi[i][2],vhi[i][3]}
  #define PIN(x) asm volatile("":"+v"(x))
  #define MX3(a,b,c) __builtin_fmaxf(__builtin_fmaxf((a),(b)),(c))
  #define GAPA(MF,A0,A1,A2,A3,W0,W1,PW) do{ MF; sacc+=A0; sacc+=A1; sacc+=A2; sacc+=A3; PIN(sacc); W0; W1; PIN(PW); SBAR(); }while(0)
  #define EX(v) __builtin_amdgcn_exp2f(v)
  #define GAPB(MF,X,B) do{ MF; X[B]=EX(X[B]); X[B+1]=EX(X[B+1]); X[B+2]=EX(X[B+2]); X[B+3]=EX(X[B+3]); PIN(X); SBAR(); }while(0)
  #define VRD(i) do{ vlo[i]=vtr(vp_+(((i)>>2)*4096+((i)&3)*1024)); vhi[i]=vtr(vp_+(((i)>>2)*4096+((i)&3)*1024+512)); }while(0)
  #define KRD(G,j) do{ if(G){ kload2(kf,kp0+sl_next,j); SBAR(); } }while(0)
  #define STEP(C0,C1,P0,P1,t,GK,GV,GL) do{ SBAR(); \
    const lds_cptr vp_=vp0+sl_prev; \
    VRD(0); SBAR(); float sacc=(P0[0]+P0[1]); \
    GAPA(C0=__builtin_amdgcn_mfma_f32_32x32x16_bf16(kf[0],qr[0],negm,0,0,0), P0[2],P0[3],P0[4],P0[5],     pw0[0]=PKW(P0,0), pw0[1]=PKW(P0,2), pw0); \
    VRD(4); SBAR(); GAPA(C1=__builtin_amdgcn_mfma_f32_32x32x16_bf16(kf[1],qr[0],negm,0,0,0), P0[6],P0[7],P0[8],P0[9],     pw0[2]=PKW(P0,4), pw0[3]=PKW(P0,6), pw0); \
    VRD(1); SBAR(); GAPA(C0=__builtin_amdgcn_mfma_f32_32x32x16_bf16(kf[2],qr[1],C0,0,0,0),   P0[10],P0[11],P0[12],P0[13], pw1[0]=PKW(P0,8), pw1[1]=PKW(P0,10), pw1); \
    VRD(5); SBAR(); GAPA(C1=__builtin_amdgcn_mfma_f32_32x32x16_bf16(kf[3],qr[1],C1,0,0,0),   P0[14],P0[15],P1[0],P1[1],   pw1[2]=PKW(P0,12),pw1[3]=PKW(P0,14), pw1); \
    VRD(2); SBAR(); GAPA(C0=__builtin_amdgcn_mfma_f32_32x32x16_bf16(kf[4],qr[2],C0,0,0,0),   P1[2],P1[3],P1[4],P1[5],     pw2[0]=PKW(P1,0), pw2[1]=PKW(P1,2), pw2); \
    VRD(6); SBAR(); GAPA(C1=__builtin_amdgcn_mfma_f32_32x32x16_bf16(kf[5],qr[2],C1,0,0,0),   P1[6],P1[7],P1[8],P1[9],     pw2[2]=PKW(P1,4), pw2[3]=PKW(P1,6), pw2); \
    VRD(3); SBAR(); GAPA(C0=__builtin_amdgcn_mfma_f32_32x32x16_bf16(kf[6],qr[3],C0,0,0,0),   P1[10],P1[11],P1[12],P1[13], pw3[0]=PKW(P1,8), pw3[1]=PKW(P1,10), pw3); \
    VRD(7); SBAR(); GAPA(C1=__builtin_amdgcn_mfma_f32_32x32x16_bf16(kf[7],qr[3],C1,0,0,0),   P1[14],P1[15],0.f,0.f,       pw3[2]=PKW(P1,12),pw3[3]=PKW(P1,14), pw3); \
    l_reg+=sacc; \
    CMASK(C0,C1,t); \
    if(GK){DMA_K((t)+3,sl_cur);} if(GV){DMA_V((t)+1,sl_next);} \
    { float a=MX3(C0[0],C0[1],C1[0]),b=MX3(C0[2],C0[3],C1[1]); a=MX3(a,C1[2],C1[3]); \
      _Pragma("unroll") for(int r=4;r<16;r+=4){a=MX3(a,C0[r],C0[r+1]);b=MX3(b,C0[r+2],C0[r+3]);a=MX3(a,C1[r],C1[r+1]);b=MX3(b,C1[r+2],C1[r+3]);} \
      float rm=__builtin_fmaxf(a,b); { auto rr=__builtin_amdgcn_permlane32_swap(__float_as_uint(rm),__float_as_uint(rm),false,false); rm=__builtin_fmaxf(__uint_as_float(rr[0]),__uint_as_float(rr[1])); } \
      resc=false; \
      if(__builtin_expect(__any(rm>(float)THRL),0)){ const float dl=__builtin_fmaxf(rm,0.f); mhat+=dl; \
        _Pragma("unroll") for(int r=0;r<16;++r){C0[r]-=dl;C1[r]-=dl;} \
        _Pragma("unroll") for(int r=0;r<16;++r)negm[r]=-mhat; asm volatile("":"+v"(negm)); \
        const float f=__builtin_amdgcn_exp2f(-dl); l_reg*=f; if(hi==0)wsf[r32]=f; resc=true; } } \
    SBAR(); \
    GAPB(o[0]=__builtin_amdgcn_mfma_f32_32x32x16_bf16(PAF(0),VFR(0),o[0],0,0,0), C0,0); \
    GAPB(o[1]=__builtin_amdgcn_mfma_f32_32x32x16_bf16(PAF(0),VFR(4),o[1],0,0,0), C0,4); \
    KRD(GL,0); GAPB(o[0]=__builtin_amdgcn_mfma_f32_32x32x16_bf16(PAF(1),VFR(1),o[0],0,0,0), C0,8); \
    KRD(GL,1); GAPB(o[1]=__builtin_amdgcn_mfma_f32_32x32x16_bf16(PAF(1),VFR(5),o[1],0,0,0), C0,12); \
    KRD(GL,2); GAPB(o[0]=__builtin_amdgcn_mfma_f32_32x32x16_bf16(PAF(2),VFR(2),o[0],0,0,0), C1,0); \
    KRD(GL,3); GAPB(o[1]=__builtin_amdgcn_mfma_f32_32x32x16_bf16(PAF(2),VFR(6),o[1],0,0,0), C1,4); \
    GAPB(o[0]=__builtin_amdgcn_mfma_f32_32x32x16_bf16(PAF(3),VFR(3),o[0],0,0,0), C1,8); \
    GAPB(o[1]=__builtin_amdgcn_mfma_f32_32x32x16_bf16(PAF(3),VFR(7),o[1],0,0,0), C1,12); \
    }while(0)
  int t=1;
  for(;t+5<NT;t+=2){
    STEP(pB0,pB1,pA0,pA1,t,true,true,true);     WAIT_BAR(2); RESC(); ROT();
    STEP(pA0,pA1,pB0,pB1,t+1,true,true,true);   WAIT_BAR(2); RESC(); ROT();
  }
  #define ENDW(tt) do{ if((tt)+3<NT){WAIT_BAR(2);} else if((tt)+2<NT){WAIT_BAR(1);} else {WAIT_BAR(0);} }while(0)
  for(;t+1<NT;t+=2){
    STEP(pB0,pB1,pA0,pA1,t,(t+3<NT),(t+1<NT),(t+1<NT));       ENDW(t);   RESC(); ROT();
    STEP(pA0,pA1,pB0,pB1,t+1,(t+4<NT),(t+2<NT),(t+2<NT));     ENDW(t+1); RESC(); ROT();
  }
  STEP(pB0,pB1,pA0,pA1,NT-1,false,false,false); RESC();
  { float sacc=pB0[0]+pB0[1]; _Pragma("unroll") for(int r=2;r<16;++r)sacc+=pB0[r]; _Pragma("unroll") for(int r=0;r<16;++r)sacc+=pB1[r]; l_reg+=sacc;
    pw0=(u32x4){PKW(pB0,0),PKW(pB0,2),PKW(pB0,4),PKW(pB0,6)};pw1=(u32x4){PKW(pB0,8),PKW(pB0,10),PKW(pB0,12),PKW(pB0,14)};pw2=(u32x4){PKW(pB1,0),PKW(pB1,2),PKW(pB1,4),PKW(pB1,6)};pw3=(u32x4){PKW(pB1,8),PKW(pB1,10),PKW(pB1,12),PKW(pB1,14)};
    SBAR(); pv(o,vb0+sl_cur,PAF(0),PAF(1),PAF(2),PAF(3)); }
  #undef PKW
  #undef PAF
  #undef VFR
  #undef PIN
  #undef MX3
  #undef GAPA
  #undef GAPB
  #undef EX
  #undef VRD
  #undef KRD
  #undef STEP
  #undef ENDW
  {auto rr=__builtin_amdgcn_permlane32_swap(__float_as_uint(l_reg),__float_as_uint(l_reg),false,false);l_reg=__uint_as_float(rr[0])+__uint_as_float(rr[1]);}
  if(hi==0)wsf[32+r32]=l_reg;asm volatile("s_waitcnt lgkmcnt(0)":::"memory");
  float rli[16];
  #pragma unroll
  for(int r=0;r<16;++r)rli[r]=__builtin_amdgcn_rcpf(wsf[32+crow(r,hi)]);
  bf16*Ow=O+(rowbase+q0+wid*QBLK)*DM+h*D;
  { bf16*stg=(bf16*)(shm+LDS_OST)+wid*2048;
    #pragma unroll
    for(int r=0;r<16;++r){const int orow=crow(r,hi);
      #pragma unroll
      for(int d0=0;d0<2;++d0)stg[orow*64+d0*32+r32]=__float2bfloat16(o[d0][r]*rli[r]);}
    asm volatile("s_waitcnt lgkmcnt(0)":::"memory");
    #pragma unroll
    for(int i=0;i<4;++i){const int row=i*8+(lane>>3),ch=lane&7; const u32x4 v=*(const u32x4*)(stg+row*64+ch*8); ATTN_STORE16(Ow+(long)row*DM+ch*8,v);} }
  asm volatile("s_waitcnt lgkmcnt(0)\n\ts_barrier":::"memory");
  #undef DMA_K
  #undef DMA_V
  #undef CMASK
  #undef START
  #undef RESC
  #undef ROT
}
constexpr int ATTN_LDS_BYTES=LDS_BYTES;
struct AttnTensors { const bf16* Q; const bf16* K; const bf16* V; bf16* O; const unsigned long long* M; };
struct AttnUnit { int bh; int qb; };
struct StaticOrder {
  int vcu;
  __device__ __forceinline__ explicit StaticOrder(int grid,int block):vcu((block%8)*(grid/8)+block/8){}
  __device__ __forceinline__ bool next(int i,AttnUnit&u)const{ if(i>=4)return false; const int s=vcu&7; u.bh=vcu>>3; u.qb=(i==0)?s:(i==1)?15-s:(i==2)?16+s:31-s; return true; }
  __device__ __forceinline__ void a_ready(const AttnUnit&)const{}
  __device__ __forceinline__ void done(const AttnUnit&)const{}
};
template<class Sched,int THRL=8> __device__ __forceinline__ void attn_phase(char*lds,const AttnTensors&T,const Sched&S){
  AttnUnit u;
  for(int i=0;S.next(i,u);++i){ S.a_ready(u); attn_unit<THRL>(u.bh/NHEAD,u.bh%NHEAD,u.qb,T.Q,T.K,T.V,T.O,T.M,lds); S.done(u); }
}
#undef SBAR
#undef WAIT_BAR
}

__device__ __forceinline__ unsigned sortable_u32(float s) { const unsigned b = __float_as_uint(s); return (b & 0x80000000u) ? ~b : (b | 0x80000000u); }

__device__ __forceinline__ void attn_simple_body(const Params& p, unsigned* sc, float* qs, int wslot, int nslots, int lane) {
    const bf16* IQ = (const bf16*)(p.ws + WS_IQ); const bf16* IK = (const bf16*)(p.ws + WS_IK); const float* IW = (const float*)(p.ws + WS_IW);
    const bf16* AQ = (const bf16*)(p.ws + WS_AQ); const bf16* AK = (const bf16*)(p.ws + WS_AK); const bf16* AV = (const bf16*)(p.ws + WS_AV);
    bf16* YA = (bf16*)(p.ws + WS_YA);
    const int nq = T;
    for (int qi = wslot; qi < nq; qi += nslots) {
        const int b = qi >> 13; int t = qi & (SEQ - 1);
        t = (t & 1) ? (SEQ - 1 - (t >> 1)) : (t >> 1);
        const size_t tok = (size_t)b * SEQ + t; const int n = t + 1;
        for (int e = lane; e < 256; e += 64) { const int h = e >> 6, d = e & 63; qs[d * 4 + h] = bf2f(IQ[tok * 256 + e]); }
        const f32x4 w4 = *(const f32x4*)(IW + tok * 4);
        asm volatile("s_waitcnt lgkmcnt(0)" ::: "memory");
#ifndef MASK_ONLY
        for (int j0 = 0; j0 < n; j0 += 64) {
            const int s = j0 + lane;
            if (s < n) {
                const u32x4* kp = (const u32x4*)(IK + ((size_t)b * SEQ + s) * 64);
                float a0 = 0.f, a1 = 0.f, a2 = 0.f, a3 = 0.f;
#pragma unroll
                for (int c = 0; c < 8; ++c) {
                    const u32x4 kv = kp[c];
                    const unsigned kw[4] = {kv.x, kv.y, kv.z, kv.w};
#pragma unroll
                    for (int i = 0; i < 4; ++i) {
                        const float k0 = __uint_as_float(kw[i] << 16), k1 = __uint_as_float(kw[i] & 0xffff0000u);
                        const f32x4 q0 = *(const f32x4*)(qs + (c * 8 + 2 * i) * 4), q1 = *(const f32x4*)(qs + (c * 8 + 2 * i + 1) * 4);
                        a0 += q0[0] * k0 + q1[0] * k1; a1 += q0[1] * k0 + q1[1] * k1; a2 += q0[2] * k0 + q1[2] * k1; a3 += q0[3] * k0 + q1[3] * k1;
                    }
                }
                float score = w4[0] * fmaxf(a0, 0.f) + w4[1] * fmaxf(a1, 0.f) + w4[2] * fmaxf(a2, 0.f) + w4[3] * fmaxf(a3, 0.f);
                score += 0.0f;
                sc[s] = sortable_u32(score);
            }
        }
        asm volatile("s_waitcnt lgkmcnt(0)" ::: "memory");
        unsigned theta = 0u; int cut = SEQ;
        if (n > 256) {
            for (int bit = 31; bit >= 0; --bit) {
                const unsigned cand = theta | (1u << bit);
                int cnt = 0;
                for (int s = lane; s < n; s += 64) cnt += (sc[s] >= cand) ? 1 : 0;
                cnt = (int)wave_sum((float)cnt);
                if (cnt >= 256) theta = cand;
            }
            int cgt = 0;
            for (int s = lane; s < n; s += 64) cgt += (sc[s] > theta) ? 1 : 0;
            cgt = (int)wave_sum((float)cgt);
            const int r = 256 - cgt;
            int x = 0;
            for (int bit = 12; bit >= 0; --bit) {
                const int xc = x | (1 << bit);
                int cnt = 0;
                for (int s = lane; s < n; s += 64) cnt += (sc[s] == theta && s < xc) ? 1 : 0;
                cnt = (int)wave_sum((float)cnt);
                if (cnt < r) x = xc;
            }
            cut = x;
        }
#else
        const unsigned theta = 0u; const int cut = SEQ;
#endif
        float q[8], o[8];
        { const u32x4 qv = *(const u32x4*)(AQ + tok * 512 + lane * 8); const unsigned qw[4] = {qv.x, qv.y, qv.z, qv.w};
#pragma unroll
          for (int i = 0; i < 4; ++i) { q[2 * i] = __uint_as_float(qw[i] << 16); q[2 * i + 1] = __uint_as_float(qw[i] & 0xffff0000u); } }
#pragma unroll
        for (int i = 0; i < 8; ++i) o[i] = 0.f;
        float mrun = -INFINITY, lsum = 0.f;
        for (int j0 = 0; j0 < n; j0 += 64) {
            const int s = j0 + lane;
            bool sel = false;
#ifndef MASK_ONLY
            if (s < n) { const unsigned u = sc[s]; sel = (u > theta) || (u == theta && s <= cut); }
#endif
#if defined(CHECK_MASK) || defined(MASK_ONLY)
            {
                const unsigned* MB = (const unsigned*)(p.ws + WS_MASK) + (((size_t)(b * 256 + (t >> 5)) * 128) + (j0 >> 6)) * 64;
                const int pp = lane >> 5, k5 = lane & 31, khi = (k5 >> 2) & 1, rr = (k5 & 3) + 4 * (k5 >> 3);
                const bool selm = (MB[(t & 31) + 32 * khi] >> (16 * pp + rr)) & 1u;
#ifndef MASK_ONLY
                const unsigned long long diff = __ballot(selm != sel);
                if (diff && lane == 0) atomicAdd((unsigned*)(p.ws + WS_CTL) + CW_MISMATCH, (unsigned)__popcll(diff));
#endif
                sel = (s < n) && selm;
            }
#endif
            unsigned long long mask = __ballot(sel);
            while (mask) {
                const int bit = __builtin_ctzll(mask); mask &= mask - 1;
                const size_t kt = (size_t)b * SEQ + j0 + bit;
                const u32x4 kv = *(const u32x4*)(AK + kt * 512 + lane * 8);
                const u32x4 vv = *(const u32x4*)(AV + kt * 512 + lane * 8);
                const unsigned kw[4] = {kv.x, kv.y, kv.z, kv.w}, vw[4] = {vv.x, vv.y, vv.z, vv.w};
                float dot = 0.f;
#pragma unroll
                for (int i = 0; i < 4; ++i) dot += q[2 * i] * __uint_as_float(kw[i] << 16) + q[2 * i + 1] * __uint_as_float(kw[i] & 0xffff0000u);
                dot += __shfl_xor(dot, 1); dot += __shfl_xor(dot, 2); dot += __shfl_xor(dot, 4);
                const float mn = fmaxf(mrun, dot);
                const float scl = exp2f(mrun - mn), pr = exp2f(dot - mn);
                lsum = lsum * scl + pr;
#pragma unroll
                for (int i = 0; i < 4; ++i) {
                    o[2 * i] = o[2 * i] * scl + pr * __uint_as_float(vw[i] << 16);
                    o[2 * i + 1] = o[2 * i + 1] * scl + pr * __uint_as_float(vw[i] & 0xffff0000u);
                }
                mrun = mn;
            }
        }
        const float inv = 1.0f / lsum;
        u32x4 w; w.x = pk2(o[0] * inv, o[1] * inv); w.y = pk2(o[2] * inv, o[3] * inv); w.z = pk2(o[4] * inv, o[5] * inv); w.w = pk2(o[6] * inv, o[7] * inv);
#ifdef CHECK_YA
        {   const u32x4 y = *(const u32x4*)(YA + tok * 512 + lane * 8); const unsigned yw[4] = {y.x, y.y, y.z, y.w}; float dmax = 0.f;
#pragma unroll
            for (int i = 0; i < 4; ++i) { dmax = fmaxf(dmax, fabsf(o[2 * i] * inv - __uint_as_float(yw[i] << 16))); dmax = fmaxf(dmax, fabsf(o[2 * i + 1] * inv - __uint_as_float(yw[i] & 0xffff0000u))); }
            dmax = wave_max(dmax);
            if (lane == 0) atomicMax((unsigned*)(p.ws + WS_CTL) + CW_MISMATCH, __float_as_uint(dmax)); }
#else
        *(u32x4*)(YA + tok * 512 + lane * 8) = w;
#endif
    }
}

__global__ void __launch_bounds__(256) k_attn_simple(Params p) {
    extern __shared__ __attribute__((aligned(16))) unsigned char lds_raw[];
    const int tid = threadIdx.x, lane = tid & 63, wave = tid >> 6;
    attn_simple_body(p, (unsigned*)(lds_raw + wave * 32768), (float*)(lds_raw + 131072 + wave * 1024), blockIdx.x * 4 + wave, gridDim.x * 4, lane);
}

constexpr int LQ = 72, LS = 136;

__device__ __forceinline__ f32x4 mfma16(const LAS bf16* Arow, const LAS bf16* Brow, f32x4 acc) {
    const bf16x8 a = *(const LAS bf16x8*)Arow, b = *(const LAS bf16x8*)Brow;
    return __builtin_amdgcn_mfma_f32_16x16x32_bf16(a, b, acc, 0, 0, 0);
}

struct ConvRegs { u32x4 x[2][4]; };
__device__ __forceinline__ void conv_load(ConvRegs& R, int tid, const bf16* src, int b, int c, int h) {
#pragma unroll
    for (int k = 0; k < 2; ++k) {
        const int task = tid + 512 * k, r = task >> 3, ch = task & 7;
        const int t = c * 128 + r;
        const bf16* base = src + ((size_t)b * SEQ) * 512 + h * 64 + ch * 8;
#pragma unroll
        for (int j = 0; j < 4; ++j) { const int tt = t - 3 + j; R.x[k][j] = (tt >= 0) ? *(const u32x4*)(base + (size_t)tt * 512) : (u32x4){0u, 0u, 0u, 0u}; }
    }
}
template <class F>
__device__ __forceinline__ void conv_emit(const ConvRegs& R, int tid, const float* convw, int chbase, int h, F emit) {
#pragma unroll
    for (int k = 0; k < 2; ++k) {
        const int task = tid + 512 * k, r = task >> 3, ch = task & 7;
        const float* wp = convw + chbase + h * 64 + ch * 8;
        float y[8];
#pragma unroll
        for (int e = 0; e < 8; ++e) y[e] = 0.f;
#pragma unroll
        for (int j = 0; j < 4; ++j) {
            const f32x4 wa = *(const f32x4*)(wp + j * 1024), wb = *(const f32x4*)(wp + j * 1024 + 4);
            const unsigned xw[4] = {R.x[k][j].x, R.x[k][j].y, R.x[k][j].z, R.x[k][j].w};
            y[0] += wa[0] * __uint_as_float(xw[0] << 16); y[1] += wa[1] * __uint_as_float(xw[0] & 0xffff0000u);
            y[2] += wa[2] * __uint_as_float(xw[1] << 16); y[3] += wa[3] * __uint_as_float(xw[1] & 0xffff0000u);
            y[4] += wb[0] * __uint_as_float(xw[2] << 16); y[5] += wb[1] * __uint_as_float(xw[2] & 0xffff0000u);
            y[6] += wb[2] * __uint_as_float(xw[3] << 16); y[7] += wb[3] * __uint_as_float(xw[3] & 0xffff0000u);
        }
        const f32x4 ya = {siluf_(y[0]), siluf_(y[1]), siluf_(y[2]), siluf_(y[3])}, yb = {siluf_(y[4]), siluf_(y[5]), siluf_(y[6]), siluf_(y[7])};
        emit(r, ch, ya, yb);
    }
}
__device__ __forceinline__ int tsw(int v, int s) { return v * LS + ((((s >> 3) ^ (v >> 3)) & 15) << 3) + (s & 7); }
__device__ __forceinline__ int tswb(int v, int cb) { return v * LS + (((cb ^ (v >> 3)) & 15) << 3); }
struct VRegs { u32x4 x[4]; };
__device__ __forceinline__ void v_load(VRegs& R, int tid, const bf16* MV, int b, int c, int h) {
    const bf16* base = MV + ((size_t)b * SEQ + c * 128) * 1024 + h * 128;
#pragma unroll
    for (int k = 0; k < 4; ++k) { const int task = tid + 512 * k, s = task >> 4, ch = task & 15; R.x[k] = *(const u32x4*)(base + (size_t)s * 1024 + ch * 8); }
}
__device__ __forceinline__ void v_store_t(const VRegs& R, int tid, LAS bf16* VT) {
#pragma unroll
    for (int k = 0; k < 4; ++k) {
        const int task = tid + 512 * k, s = task >> 4, ch = task & 15;
        const unsigned w[4] = {R.x[k].x, R.x[k].y, R.x[k].z, R.x[k].w};
#pragma unroll
        for (int i = 0; i < 4; ++i) { VT[tsw(ch * 8 + 2 * i, s)] = (bf16)(w[i] & 0xffffu); VT[tsw(ch * 8 + 2 * i + 1, s)] = (bf16)(w[i] >> 16); }
    }
    for (int i = tid; i < 16 * 128; i += 512) { const int r = 128 + (i >> 7), s = i & 127; VT[r * LS + s] = (r == 128) ? (bf16)0x3F80 : (bf16)0; }
}
__device__ __forceinline__ void scan_add2(float x0, float x1, int lane, float& i0, float& i1) {
    float incl = x0 + x1;
#pragma unroll
    for (int o = 1; o < 64; o <<= 1) { const float v = __shfl_up(incl, o); if (lane >= o) incl += v; }
    i1 = incl; i0 = incl - x1;
}
__device__ __forceinline__ void scan_max2(float x0, float x1, int lane, float& i0, float& i1) {
    float incl = fmaxf(x0, x1);
#pragma unroll
    for (int o = 1; o < 64; o <<= 1) { const float v = __shfl_up(incl, o); if (lane >= o) incl = fmaxf(incl, v); }
    const float prev = __shfl_up(incl, 1);
    i1 = incl; i0 = (lane == 0) ? x0 : fmaxf(prev, x0);
}

struct KvRegs { ConvRegs KR; VRegs VR; float f0, f1, i0, i1; };
__device__ __forceinline__ void mlstm_kv_load(const Params& p, KvRegs& R, int tid, int lane, int u) {
    const int c = u & 63, h = (u >> 6) & 7, b = u >> 9;
    const float* MI = (const float*)(p.ws + WS_MI); const float* MF = (const float*)(p.ws + WS_MF);
    const size_t tok0 = (size_t)b * SEQ + c * 128;
    conv_load(R.KR, tid, (const bf16*)(p.ws + WS_MK), b, c, h);
    v_load(R.VR, tid, (const bf16*)(p.ws + WS_MV), b, c, h);
    R.f0 = MF[(tok0 + 2 * lane) * 8 + h]; R.f1 = MF[(tok0 + 2 * lane + 1) * 8 + h];
    R.i0 = MI[(tok0 + 2 * lane) * 8 + h]; R.i1 = MI[(tok0 + 2 * lane + 1) * 8 + h];
}
__device__ __forceinline__ void mlstm_kv_phase(const Params& p, LAS unsigned char* lds) {
    int tid_ = threadIdx.x; asm volatile("" : "+v"(tid_));
    const int tid = tid_, lane = tid & 63, wave = __builtin_amdgcn_readfirstlane(tid >> 6), fr = lane & 15, fq = lane >> 4;
    LAS bf16* VT = (LAS bf16*)lds;
    LAS bf16* WKT = VT + 144 * LS;
    LAS float* wg = (LAS float*)(WKT + 64 * LS);
    KvRegs R;
    int u = blockIdx.x;
    if (u < NUNIT_M) mlstm_kv_load(p, R, tid, lane, u);
#pragma unroll 1
    for (; u < NUNIT_M; u += gridDim.x) {
        const int h = (u >> 6) & 7;
        if (wave == 0) {
            const float lf0 = logsigmoidf_(R.f0), lf1 = logsigmoidf_(R.f1);
            const float i0 = R.i0, i1 = R.i1;
            float b0, b1; scan_add2(lf0, lf1, lane, b0, b1);
            const float blast = __shfl(b1, 63);
            const float g0 = blast - b0 + i0, g1 = blast - b1 + i1;
            const float gmax = wave_max(fmaxf(g0, g1));
            wg[2 * lane] = __expf(g0 - gmax); wg[2 * lane + 1] = __expf(g1 - gmax);
            if (lane == 0) { float* dsc = (float*)(p.ws + WS_DSC) + (size_t)u * 2; dsc[0] = blast; dsc[1] = gmax; }
        }
        __syncthreads();
        conv_emit(R.KR, tid, p.in[3], 512, h, [&](int r, int ch, f32x4 ya, f32x4 yb) { const float w = wg[r];
#pragma unroll
            for (int e = 0; e < 4; ++e) { WKT[tsw(ch * 8 + e, r)] = (bf16)f2bf(ya[e] * w); WKT[tsw(ch * 8 + 4 + e, r)] = (bf16)f2bf(yb[e] * w); } });
        v_store_t(R.VR, tid, VT);
        __syncthreads();
        if (u + (int)gridDim.x < NUNIT_M) { int tl_ = tid; asm volatile("" : "+v"(tl_));
            mlstm_kv_load(p, R, tl_, tl_ & 63, u + gridDim.x); }
        bf16* DC = (bf16*)((unsigned char*)p.out + DO_DC) + (size_t)u * 128 * 64;
        float* DN = (float*)(p.ws + WS_DN) + (size_t)u * 64;
#pragma unroll
        for (int ct = 0; ct < 4; ++ct) {
            f32x4 acc = {0.f, 0.f, 0.f, 0.f};
#pragma unroll
            for (int kk = 0; kk < 4; ++kk) acc = mfma16(WKT + tswb(ct * 16 + fr, kk * 4 + fq), VT + tswb(wave * 16 + fr, kk * 4 + fq), acc);
            *(u32x2*)(DC + (size_t)(wave * 16 + fr) * 64 + ct * 16 + 4 * fq) = (u32x2){pk2(acc[0], acc[1]), pk2(acc[2], acc[3])};
        }
        if (wave == 0) {
#pragma unroll
            for (int ct = 0; ct < 4; ++ct) {
                f32x4 acc = {0.f, 0.f, 0.f, 0.f};
#pragma unroll
                for (int kk = 0; kk < 4; ++kk) acc = mfma16(WKT + tswb(ct * 16 + fr, kk * 4 + fq), VT + (128 + fr) * LS + kk * 32 + 8 * fq, acc);
                if (fr == 0) *(f32x4*)(DN + ct * 16 + 4 * fq) = acc;
            }
        }
        __syncthreads();
    }
}

__device__ __forceinline__ void mlstm_scan(const Params& p) {
    int tid_ = threadIdx.x; asm volatile("" : "+v"(tid_));
    const int tid = tid_;
    for (int w = blockIdx.x; w < NB * 8 * 8; w += gridDim.x) {
        const int bh = w >> 3, part = w & 7;
        const unsigned* DC = (const unsigned*)((unsigned char*)p.out + DO_DC);
        const float* DN = (const float*)(p.ws + WS_DN);
        const float* DSC = (const float*)(p.ws + WS_DSC);
        bf16* CST = (bf16*)(p.ws + WS_CST);
        float* MC = (float*)(p.ws + WS_MC);
        const int e0 = part * 1024 + 2 * tid, e1 = e0 + 1;
        const bool hasn = (part == 0 && tid < 64);
        float c0 = 0.f, c1 = 0.f, nn = 0.f, m = 0.f;
        float d0n[8], d1n[8], dnn[8], bln[8], gmn[8];
#pragma unroll
        for (int k = 0; k < 8; ++k) {
            const size_t u = (size_t)bh * 64 + k;
            { const unsigned w_ = DC[(u * 8192 + e0) >> 1]; d0n[k] = __uint_as_float(w_ << 16); d1n[k] = __uint_as_float(w_ & 0xffff0000u); } dnn[k] = hasn ? DN[u * 64 + tid] : 0.f;
            bln[k] = DSC[u * 2]; gmn[k] = DSC[u * 2 + 1];
        }
#pragma unroll 1
        for (int cb = 0; cb < NCHUNK; cb += 8) {
            float d0[8], d1[8], dn[8], bl[8], gm[8];
#pragma unroll
            for (int k = 0; k < 8; ++k) { d0[k] = d0n[k]; d1[k] = d1n[k]; dn[k] = dnn[k]; bl[k] = bln[k]; gm[k] = gmn[k]; }
            if (cb + 8 < NCHUNK) {
#pragma unroll
                for (int k = 0; k < 8; ++k) {
                    const size_t u = (size_t)bh * 64 + cb + 8 + k;
                    { const unsigned w_ = DC[(u * 8192 + e0) >> 1]; d0n[k] = __uint_as_float(w_ << 16); d1n[k] = __uint_as_float(w_ & 0xffff0000u); } dnn[k] = hasn ? DN[u * 64 + tid] : 0.f;
                    bln[k] = DSC[u * 2]; gmn[k] = DSC[u * 2 + 1];
                }
            }
#pragma unroll
            for (int k = 0; k < 8; ++k) {
                const size_t u = (size_t)bh * 64 + cb + k;
                bf16* cs = CST + u * 144 * 64;
                *(unsigned*)(cs + e0) = pk2(c0, c1); (void)e1;
                if (hasn) cs[128 * 64 + tid] = (bf16)f2bf(nn);
                if (part == 0 && tid == 0) MC[u] = m;
                const float mn = fmaxf(bl[k] + m, gm[k]);
                const float a = __expf(bl[k] + m - mn), s = __expf(gm[k] - mn);
                c0 = a * c0 + s * d0[k]; c1 = a * c1 + s * d1[k]; nn = a * nn + s * dn[k];
                m = mn;
            }
        }
    }
}

struct OutRegs { ConvRegs QR, KR; VRegs VR; u32x4 cst[3]; float lf0, lf1, i0, i1, mc; };
__device__ __forceinline__ void mlstm_out_load(const Params& p, OutRegs& R, int tid, int lane, int u) {
    const int c = u & 63, h = (u >> 6) & 7, b = u >> 9;
    const float* MI = (const float*)(p.ws + WS_MI); const float* MF = (const float*)(p.ws + WS_MF);
    const size_t tok0 = (size_t)b * SEQ + c * 128;
    conv_load(R.QR, tid, (const bf16*)(p.ws + WS_MQ), b, c, h);
    conv_load(R.KR, tid, (const bf16*)(p.ws + WS_MK), b, c, h);
    v_load(R.VR, tid, (const bf16*)(p.ws + WS_MV), b, c, h);
    const bf16* cs = (const bf16*)(p.ws + WS_CST) + (size_t)u * 144 * 64;
#pragma unroll
    for (int k = 0; k < 3; ++k) { const int i = tid + 512 * k; R.cst[k] = (i < 129 * 8) ? *(const u32x4*)(cs + (size_t)i * 8) : (u32x4){0u, 0u, 0u, 0u}; }
    R.lf0 = MF[(tok0 + 2 * lane) * 8 + h]; R.lf1 = MF[(tok0 + 2 * lane + 1) * 8 + h];
    R.i0 = MI[(tok0 + 2 * lane) * 8 + h]; R.i1 = MI[(tok0 + 2 * lane + 1) * 8 + h];
    R.mc = ((const float*)(p.ws + WS_MC))[u];
}
__device__ __forceinline__ void mlstm_out_phase(const Params& p, LAS unsigned char* lds) {
    int tid_ = threadIdx.x; asm volatile("" : "+v"(tid_));
    const int tid = tid_, lane = tid & 63, wave = __builtin_amdgcn_readfirstlane(tid >> 6), fr = lane & 15, fq = lane >> 4;
    LAS bf16* Qs = (LAS bf16*)lds;
    LAS bf16* Ks = Qs + 128 * LQ;
    LAS bf16* VT = Ks + 128 * LQ;
    LAS bf16* Pm = VT + 144 * LS;
    LAS bf16* CT = Pm + 128 * LS;
    LAS float* fs = (LAS float*)(CT + 144 * LQ);
    LAS float* as_ = fs, *bsm = fs + 128, *wint = fs + 256, *nfl = fs + 384;
    OutRegs R;
#ifdef MOU_DB
    OutRegs RN;
#endif
    int u = blockIdx.x;
    if (u < NUNIT_M) mlstm_out_load(p, R, tid, lane, u);
#ifdef MOU_STAGGER
    if (blockIdx.x & 1) { for (int i_ = 0; i_ < MOU_STAGGER; ++i_) __builtin_amdgcn_s_sleep(127); }
#endif
#pragma unroll 1
    for (; u < NUNIT_M; u += gridDim.x) {
        const int c = u & 63, h = (u >> 6) & 7, b = u >> 9;
        const size_t tok0 = (size_t)b * SEQ + c * 128;
#ifdef MOU_DB
        if (u + (int)gridDim.x < NUNIT_M) { int tl_ = tid; asm volatile("" : "+v"(tl_));
            mlstm_out_load(p, RN, tl_, tl_ & 63, u + gridDim.x); }
#endif
        if (wave == 0) {
            const float mc = R.mc;
            const float lf0 = logsigmoidf_(R.lf0), lf1 = logsigmoidf_(R.lf1);
            const float i0 = R.i0, i1 = R.i1;
            float b0, b1; scan_add2(lf0, lf1, lane, b0, b1);
            const float a0 = i0 - b0, a1 = i1 - b1;
            float pm0, pm1; scan_max2(a0, a1, lane, pm0, pm1);
            const float mt0 = fmaxf(b0 + mc, b0 + pm0), mt1 = fmaxf(b1 + mc, b1 + pm1);
            as_[2 * lane] = a0; as_[2 * lane + 1] = a1;
            bsm[2 * lane] = b0 - mt0; bsm[2 * lane + 1] = b1 - mt1;
            wint[2 * lane] = __expf(b0 + mc - mt0); wint[2 * lane + 1] = __expf(b1 + mc - mt1);
            nfl[2 * lane] = __expf(-mt0); nfl[2 * lane + 1] = __expf(-mt1);
        }
        conv_emit(R.QR, tid, p.in[3], 0, h, [&](int r, int ch, f32x4 ya, f32x4 yb) { ya = ya * 0.125f; yb = yb * 0.125f;
            *(LAS u32x4*)(Qs + r * LQ + ch * 8) = (u32x4){pk2(ya[0], ya[1]), pk2(ya[2], ya[3]), pk2(yb[0], yb[1]), pk2(yb[2], yb[3])}; });
        conv_emit(R.KR, tid, p.in[3], 512, h, [&](int r, int ch, f32x4 ya, f32x4 yb) {
            *(LAS u32x4*)(Ks + r * LQ + ch * 8) = (u32x4){pk2(ya[0], ya[1]), pk2(ya[2], ya[3]), pk2(yb[0], yb[1]), pk2(yb[2], yb[3])}; });
        v_store_t(R.VR, tid, VT);
#pragma unroll
        for (int k = 0; k < 3; ++k) { const int i = tid + 512 * k; if (i < 144 * 8) { const int r = i >> 3, ch = i & 7; *(LAS u32x4*)(CT + r * LQ + ch * 8) = R.cst[k]; } }
        __syncthreads();
#ifndef MOU_DB
        if (u + (int)gridDim.x < NUNIT_M) { int tl_ = tid; asm volatile("" : "+v"(tl_));
            mlstm_out_load(p, R, tl_, tl_ & 63, u + gridDim.x); }
#endif
        const int j = wave * 16 + fr;
        const float bsmj = bsm[j];
#ifdef MOU_UNROLL
#pragma unroll MOU_UNROLL
#else
#pragma unroll 1
#endif
        for (int ct = 0; ct < 8; ++ct) {
            f32x4 acc = {0.f, 0.f, 0.f, 0.f};
#ifdef MOU_NOBR
            {
#else
            if (ct <= wave) {
#endif
#pragma unroll
                for (int kk = 0; kk < 2; ++kk) acc = mfma16(Ks + (ct * 16 + fr) * LQ + kk * 32 + 8 * fq, Qs + (wave * 16 + fr) * LQ + kk * 32 + 8 * fq, acc);
            }
            const int s0 = ct * 16 + 4 * fq; const f32x4 a4 = *(const LAS f32x4*)(as_ + s0);
            float v[4];
#pragma unroll
            for (int r = 0; r < 4; ++r) v[r] = (s0 + r <= j) ? acc[r] * __expf(bsmj + a4[r]) : 0.f;
            *(LAS u32x2*)(Pm + j * LS + s0) = (u32x2){pk2(v[0], v[1]), pk2(v[2], v[3])};
        }
        asm volatile("s_waitcnt lgkmcnt(0)" ::: "memory");
        const float wj = wint[j];
        f32x4 o[9];
#ifndef MOU_SB
#define MOU_SB __builtin_amdgcn_sched_barrier(0)
#endif
#ifdef MOU_BATCH
        {
            bf16x8 bq[2], bp[4];
#pragma unroll
            for (int kk = 0; kk < 2; ++kk) bq[kk] = *(const LAS bf16x8*)(Qs + (wave * 16 + fr) * LQ + kk * 32 + 8 * fq);
#pragma unroll
            for (int kk = 0; kk < 4; ++kk) bp[kk] = *(const LAS bf16x8*)(Pm + (wave * 16 + fr) * LS + kk * 32 + 8 * fq);
#pragma unroll
            for (int ct = 0; ct < 9; ++ct) {
                bf16x8 a[3];
#pragma unroll
                for (int kk = 0; kk < 2; ++kk) a[kk] = *(const LAS bf16x8*)(CT + (ct * 16 + fr) * LQ + kk * 32 + 8 * fq);
                a[2] = *(const LAS bf16x8*)(VT + (ct < 8 ? tswb(ct * 16 + fr, fq) : (128 + fr) * LS + 8 * fq));
                MOU_SB;
                f32x4 acc = {0.f, 0.f, 0.f, 0.f};
#pragma unroll
                for (int kk = 0; kk < 2; ++kk) acc = __builtin_amdgcn_mfma_f32_16x16x32_bf16(a[kk], bq[kk], acc, 0, 0, 0);
                acc = acc * wj;
                acc = __builtin_amdgcn_mfma_f32_16x16x32_bf16(a[2], bp[0], acc, 0, 0, 0);
#pragma unroll
                for (int kk = 1; kk < 4; ++kk) a[kk - 1] = *(const LAS bf16x8*)(VT + (ct < 8 ? tswb(ct * 16 + fr, kk * 4 + fq) : (128 + fr) * LS + kk * 32 + 8 * fq));
                MOU_SB;
#pragma unroll
                for (int kk = 1; kk < 4; ++kk) acc = __builtin_amdgcn_mfma_f32_16x16x32_bf16(a[kk - 1], bp[kk], acc, 0, 0, 0);
                o[ct] = acc;
            }
        }
#else
#pragma unroll
        for (int ct = 0; ct < 9; ++ct) {
            f32x4 acc = {0.f, 0.f, 0.f, 0.f};
#pragma unroll
            for (int kk = 0; kk < 2; ++kk) acc = mfma16(CT + (ct * 16 + fr) * LQ + kk * 32 + 8 * fq, Qs + (wave * 16 + fr) * LQ + kk * 32 + 8 * fq, acc);
            acc = acc * wj;
#pragma unroll
            for (int kk = 0; kk < 4; ++kk) acc = mfma16(VT + (ct < 8 ? tswb(ct * 16 + fr, kk * 4 + fq) : (128 + fr) * LS + kk * 32 + 8 * fq), Pm + (wave * 16 + fr) * LS + kk * 32 + 8 * fq, acc);
            o[ct] = acc;
        }
#endif
        const float den = __shfl(o[8][0], fr);
        const float rden = rcpf_(fmaxf(fabsf(den), nfl[j]));
        float s = 0.f;
#pragma unroll
        for (int ct = 0; ct < 8; ++ct) { o[ct] = o[ct] * rden; s += (o[ct][0] + o[ct][1]) + (o[ct][2] + o[ct][3]); }
        s += __shfl_xor(s, 16); s += __shfl_xor(s, 32);
        const float mean = s * (1.0f / 128.0f);
        float q = 0.f;
#pragma unroll
        for (int ct = 0; ct < 8; ++ct) { const f32x4 d = o[ct] - mean; q += (d[0] * d[0] + d[1] * d[1]) + (d[2] * d[2] + d[3] * d[3]); }
        q += __shfl_xor(q, 16); q += __shfl_xor(q, 32);
        const float rstd = rsqrtf(q * (1.0f / 128.0f) + GN_EPS);
        const bf16* MO = (const bf16*)(p.ws + WS_MO); bf16* YM = (bf16*)((unsigned char*)p.out + DO_YM);
        const float* gain = p.in[4];
        const size_t rowoff = (tok0 + j) * 1024 + h * 128 + 4 * fq;
#pragma unroll
        for (int ct = 0; ct < 8; ++ct) {
            const f32x4 g4 = *(const f32x4*)(gain + h * 128 + ct * 16 + 4 * fq);
            const u32x2 mo = *(const u32x2*)(MO + rowoff + ct * 16);
            const f32x4 y = (o[ct] - mean) * rstd * g4;
            u32x2 w; w.x = pk2(y[0] * __uint_as_float(mo.x << 16), y[1] * __uint_as_float(mo.x & 0xffff0000u));
            w.y = pk2(y[2] * __uint_as_float(mo.y << 16), y[3] * __uint_as_float(mo.y & 0xffff0000u));
            *(u32x2*)(YM + rowoff + ct * 16) = w;
        }
#ifdef MOU_DB
        R = RN;
#endif
        __syncthreads();
    }
}

struct EpiGate {
    static constexpr bool PERM = true, AFTER_DRAIN = false;
    const bf16* gate; bf16* out; int add;
    __device__ __forceinline__ void operator()(const f32x4 (&acc)[2][2][4][2], const pg8::Unit& u, int wr, int wc, int fr, int fq) const {
        const int row0 = u.pm * 256 + wr * 64 + fr, col0 = u.pn * 256 + wc * 32 + 8 * fq;
#pragma unroll
        for (int ai = 0; ai < 2; ++ai)
#pragma unroll
            for (int m = 0; m < 4; ++m)
#pragma unroll
                for (int bj = 0; bj < 2; ++bj) {
                    const size_t idx = (size_t)(row0 + ai * 128 + m * 16) * 1024 + col0 + bj * 128;
                    const u32x4 gv = *(const u32x4*)(gate + idx);
                    const unsigned gw[4] = {gv.x, gv.y, gv.z, gv.w};
                    const f32x4 v0 = acc[ai][bj][m][0], v1 = acc[ai][bj][m][1];
                    float r[8] = {v0[0], v0[1], v0[2], v0[3], v1[0], v1[1], v1[2], v1[3]};
#pragma unroll
                    for (int i = 0; i < 4; ++i) { r[2 * i] *= __uint_as_float(gw[i] << 16); r[2 * i + 1] *= __uint_as_float(gw[i] & 0xffff0000u); }
                    if (add) {
                        const u32x4 ov = *(const u32x4*)(out + idx); const unsigned ow[4] = {ov.x, ov.y, ov.z, ov.w};
#pragma unroll
                        for (int i = 0; i < 4; ++i) { r[2 * i] += __uint_as_float(ow[i] << 16); r[2 * i + 1] += __uint_as_float(ow[i] & 0xffff0000u); }
                    }
                    u32x4 w; w.x = pk2(r[0], r[1]); w.y = pk2(r[2], r[3]); w.z = pk2(r[4], r[5]); w.w = pk2(r[6], r[7]);
                    *(u32x4*)(out + idx) = w;
                }
    }
};
__device__ __forceinline__ void phase_merge(const Params& p, LAS unsigned char* lds) {
    bf16* merged = (bf16*)(p.ws + WS_MERGED);
    pg8::StaticOrder S; S.init(T, 1024, gridDim.x, (int)blockIdx.x);
    { pg8::Gemm g{(const bf16*)(p.ws + WS_YA), (const bf16*)(p.ws + WS_WBA), T, 1024, 512};
      EpiGate E{(const bf16*)(p.ws + WS_GA), merged, 0};
      pg8::gemm_phase<EpiGate, pg8::StaticOrder, true, true>(lds, g, S, E); }
    __syncthreads();
    { pg8::Gemm g{(const bf16*)((unsigned char*)p.out + DO_YM), (const bf16*)(p.ws + WS_WBM), T, 1024, 1024};
      EpiGate E{(const bf16*)((unsigned char*)p.out + DO_GM), merged, 1};
      pg8::gemm_phase<EpiGate, pg8::StaticOrder, true, true>(lds, g, S, E); }
}

struct EpiOutRes {
    static constexpr bool PERM = true, AFTER_DRAIN = false;
    const float* x; bf16* out;
    __device__ __forceinline__ void operator()(const f32x4 (&acc)[2][2][4][2], const pg8::Unit& u, int wr, int wc, int fr, int fq) const {
        const int row0 = u.pm * 256 + wr * 64 + fr, col0 = u.pn * 256 + wc * 32 + 8 * fq;
#pragma unroll
        for (int ai = 0; ai < 2; ++ai)
#pragma unroll
            for (int m = 0; m < 4; ++m)
#pragma unroll
                for (int bj = 0; bj < 2; ++bj) {
                    const size_t idx = (size_t)(row0 + ai * 128 + m * 16) * 1024 + col0 + bj * 128;
                    const f32x4 x0 = *(const f32x4*)(x + idx), x1 = *(const f32x4*)(x + idx + 4);
                    const f32x4 v0 = x0 * ALPHA + acc[ai][bj][m][0], v1 = x1 * ALPHA + acc[ai][bj][m][1];
                    u32x4 w; w.x = pk2(v0[0], v0[1]); w.y = pk2(v0[2], v0[3]); w.z = pk2(v1[0], v1[1]); w.w = pk2(v1[2], v1[3]);
                    *(u32x4*)(out + idx) = w;
                }
    }
};
__device__ __forceinline__ void phase_outproj(const Params& p, LAS unsigned char* lds) {
    pg8::Gemm g{(const bf16*)(p.ws + WS_MERGED), (const bf16*)(p.ws + WS_WOUT), T, 1024, 1024};
    pg8::StaticOrder S; S.init(T, 1024, gridDim.x, (int)blockIdx.x);
    EpiOutRes E{p.in[0], (bf16*)p.out};
    pg8::gemm_phase<EpiOutRes, pg8::StaticOrder, true, true>(lds, g, S, E);
}

__device__ __forceinline__ void phase_ln1_route(const Params& p, LAS unsigned char* lds) {
    int tid_ = threadIdx.x; asm volatile("" : "+v"(tid_));
    const int tid = tid_, lane = tid & 63, wave = __builtin_amdgcn_readfirstlane(tid >> 6);
    LAS int* cnt = (LAS int*)lds;
    LAS int* base = cnt + 16;
    LAS int* info = base + 16;
    LAS float* infw = (LAS float*)(info + 512);
    const float* gain = p.in[8]; const float* bias = p.in[9];
    const float* Wg = p.in[10]; const float* bg = p.in[11]; const float* We = p.in[12]; const float* be = p.in[13];
    unsigned* cursor = (unsigned*)(p.ws + WS_CTL) + CW_CURSOR;
    for (int blk = blockIdx.x; blk < T / 128; blk += gridDim.x) {
        if (tid < 16) cnt[tid] = 0;
        __syncthreads();
        u32x2 rwn[4];
        { const u32x2* row = (const u32x2*)((const bf16*)p.out + ((size_t)blk * 128 + wave * 16) * 1024) + lane;
#pragma unroll
          for (int j = 0; j < 4; ++j) rwn[j] = row[64 * j]; }
#pragma unroll 1
        for (int i = 0; i < 16; ++i) {
            const int tl = wave * 16 + i; const size_t tok = (size_t)blk * 128 + tl;
            u32x2 rwc[4];
#ifndef LN1_PF
            { const u32x2* row = (const u32x2*)((const bf16*)p.out + tok * 1024) + lane;
#pragma unroll
              for (int j = 0; j < 4; ++j) rwn[j] = row[64 * j]; }
#endif
#pragma unroll
            for (int j = 0; j < 4; ++j) rwc[j] = rwn[j];
#ifdef LN1_PF
            { const u32x2* row = (const u32x2*)((const bf16*)p.out + ((size_t)blk * 128 + wave * 16 + min(i + 1, 15)) * 1024) + lane;
#pragma unroll
              for (int j = 0; j < 4; ++j) rwn[j] = row[64 * j]; }
#endif
            f32x4 v[4]; float s = 0.f;
#pragma unroll
            for (int j = 0; j < 4; ++j) { const u32x2 rw = rwc[j];
                v[j] = (f32x4){__uint_as_float(rw.x << 16), __uint_as_float(rw.x & 0xffff0000u), __uint_as_float(rw.y << 16), __uint_as_float(rw.y & 0xffff0000u)};
                s += (v[j].x + v[j].y) + (v[j].z + v[j].w); }
            const float mean = wave_sum(s) * (1.f / 1024.f); float s2 = 0.f;
#pragma unroll
            for (int j = 0; j < 4; ++j) { v[j] = v[j] - mean; s2 += (v[j].x * v[j].x + v[j].y * v[j].y) + (v[j].z * v[j].z + v[j].w * v[j].w); }
            const float rstd = rsqrtf(wave_sum(s2) * (1.f / 1024.f) + LN_EPS);
            float lg[4] = {0.f, 0.f, 0.f, 0.f};
#pragma unroll
            for (int j = 0; j < 4; ++j) {
                const int e0 = (lane + 64 * j) * 4;
                const f32x4 g4 = *(const f32x4*)(gain + e0), b4 = *(const f32x4*)(bias + e0);
                v[j] = v[j] * rstd * g4 + b4;
                ((unsigned long long*)((bf16*)(p.ws + WS_X1B) + tok * 1024))[lane + 64 * j] = (unsigned long long)pk2(v[j].x, v[j].y) | ((unsigned long long)pk2(v[j].z, v[j].w) << 32);
                const float* wgj = Wg + (size_t)e0 * 4;
#pragma unroll
                for (int q = 0; q < 4; ++q) { const float xv = v[j][q]; const f32x4 wg4 = *(const f32x4*)(wgj + q * 4);
                    lg[0] += xv * wg4[0]; lg[1] += xv * wg4[1]; lg[2] += xv * wg4[2]; lg[3] += xv * wg4[3]; }
            }
#pragma unroll
            for (int k = 0; k < 4; ++k) lg[k] = wave_sum(lg[k]) + bg[k];
            int gs = 0; float gm = lg[0];
#pragma unroll
            for (int k = 1; k < 4; ++k) if (lg[k] > gm) { gm = lg[k]; gs = k; }
            float gsum = 0.f;
#pragma unroll
            for (int k = 0; k < 4; ++k) gsum += __expf(lg[k] - gm);
            const float gw = 1.0f / gsum;
            gs = __builtin_amdgcn_readfirstlane(gs);
            float el[4] = {0.f, 0.f, 0.f, 0.f};
#pragma unroll
            for (int j = 0; j < 4; ++j) {
                const float* wej = We + (size_t)(lane + 64 * j) * 64 + gs * 4;
#pragma unroll
                for (int q = 0; q < 4; ++q) { const float xv = v[j][q]; const f32x4 we4 = *(const f32x4*)(wej + q * 16);
                    el[0] += xv * we4[0]; el[1] += xv * we4[1]; el[2] += xv * we4[2]; el[3] += xv * we4[3]; }
            }
            { const f32x4 be4 = *(const f32x4*)(be + gs * 4);
#pragma unroll
              for (int k = 0; k < 4; ++k) el[k] = wave_sum(el[k]) + be4[k]; }
            int i0 = 0; float v0 = el[0];
#pragma unroll
            for (int k = 1; k < 4; ++k) if (el[k] > v0) { v0 = el[k]; i0 = k; }
            int i1 = -1; float v1 = -INFINITY;
#pragma unroll
            for (int k = 0; k < 4; ++k) if (k != i0 && el[k] > v1) { v1 = el[k]; i1 = k; }
            const float p1 = __expf(v1 - v0); const float w0 = gw / (1.f + p1), w1 = gw * p1 / (1.f + p1);
            if (lane == 0) {
                const int e0 = gs * 4 + i0, e1 = gs * 4 + i1;
                const int r0 = atomicAdd((int*)&cnt[e0], 1), r1 = atomicAdd((int*)&cnt[e1], 1);
                info[tl * 4 + 0] = e0; info[tl * 4 + 1] = r0; info[tl * 4 + 2] = e1; info[tl * 4 + 3] = r1;
                infw[tl * 2 + 0] = w0; infw[tl * 2 + 1] = w1;
            }
        }
        __syncthreads();
        if (tid < 16) base[tid] = (int)atomicAdd(&cursor[tid], (unsigned)cnt[tid]);
        __syncthreads();
        if (tid < 128) {
            const size_t tok = (size_t)blk * 128 + tid;
            int* te = (int*)(p.ws + WS_TE) + tok * 4; float* tw = (float*)(p.ws + WS_TW) + tok * 2;
            const int e0 = info[tid * 4 + 0], e1 = info[tid * 4 + 2];
            const int p0 = base[e0] + info[tid * 4 + 1], p1 = base[e1] + info[tid * 4 + 3];
            te[0] = e0; te[1] = p0; te[2] = e1; te[3] = p1;
            int* inv = (int*)(p.ws + WS_INV); inv[(size_t)e0 * T + p0] = (int)tok; inv[(size_t)e1 * T + p1] = (int)tok;
            tw[0] = infw[tid * 2 + 0]; tw[1] = infw[tid * 2 + 1];
        }
        __syncthreads();
    }
}

struct Segs {
    int st[17];
    __device__ __forceinline__ void init(const unsigned* cursor) {
        int a = 0;
#pragma unroll
        for (int e = 0; e < 16; ++e) { st[e] = a; a += ((int)cursor[e] + 255) & ~255; }
        st[16] = a;
    }
    __device__ __forceinline__ int start(int e) const {
        int r = 0;
#pragma unroll
        for (int k = 0; k < 16; ++k) r = (k == e) ? st[k] : r;
        return r;
    }
};

struct MoeOrder {
    Segs sg; int ntiles, R, x, slot;
    __device__ __forceinline__ void init(const unsigned* cursor, int G_, int c_) { sg.init(cursor); ntiles = sg.st[16] >> 8; R = (ntiles + 7) >> 3; x = c_ & 7; slot = c_ >> 3; (void)G_; }
    __device__ __forceinline__ bool next(int i, pg8::Unit& u) const {
        const int lu = i * 32 + slot;
        const int pm = x * R + (lu >> 2), j = lu & 3;
        if ((lu >> 2) >= R || pm >= ntiles) return false;
        int e = 0;
#pragma unroll
        for (int k = 1; k < 16; ++k) e += (sg.st[k] <= pm * 256) ? 1 : 0;
        u.pm = pm; u.pn = e * 4 + j; return true;
    }
    __device__ __forceinline__ void a_ready(const pg8::Unit&) const {}
    __device__ __forceinline__ void done(const pg8::Unit&) const {}
};
struct EpiSwiGLU {
    static constexpr bool PERM = true, AFTER_DRAIN = false;
    bf16* H;
    __device__ __forceinline__ void operator()(const f32x4 (&acc)[2][2][4][2], const pg8::Unit& u, int wr, int wc, int fr, int fq) const {
        const int row0 = u.pm * 256 + wr * 64 + fr, col0 = (u.pn & 3) * 128 + wc * 32 + 8 * fq;
#pragma unroll
        for (int ai = 0; ai < 2; ++ai)
#pragma unroll
            for (int m = 0; m < 4; ++m) {
                const f32x4 g0 = acc[ai][0][m][0], g1 = acc[ai][0][m][1], u0 = acc[ai][1][m][0], u1 = acc[ai][1][m][1];
                u32x4 w;
                w.x = pk2(siluf_(g0[0]) * u0[0], siluf_(g0[1]) * u0[1]); w.y = pk2(siluf_(g0[2]) * u0[2], siluf_(g0[3]) * u0[3]);
                w.z = pk2(siluf_(g1[0]) * u1[0], siluf_(g1[1]) * u1[1]); w.w = pk2(siluf_(g1[2]) * u1[2], siluf_(g1[3]) * u1[3]);
                *(u32x4*)(H + (size_t)(row0 + ai * 128 + m * 16) * 512 + col0) = w;
            }
    }
};
struct EpiPlain {
    static constexpr bool PERM = true, AFTER_DRAIN = false;
    bf16* Y;
    __device__ __forceinline__ void operator()(const f32x4 (&acc)[2][2][4][2], const pg8::Unit& u, int wr, int wc, int fr, int fq) const {
        const int row0 = u.pm * 256 + wr * 64 + fr, col0 = (u.pn & 3) * 256 + wc * 32 + 8 * fq;
#pragma unroll
        for (int ai = 0; ai < 2; ++ai)
#pragma unroll
            for (int m = 0; m < 4; ++m)
#pragma unroll
                for (int bj = 0; bj < 2; ++bj) {
                    const f32x4 v0 = acc[ai][bj][m][0], v1 = acc[ai][bj][m][1];
                    u32x4 w; w.x = pk2(v0[0], v0[1]); w.y = pk2(v0[2], v0[3]); w.z = pk2(v1[0], v1[1]); w.w = pk2(v1[2], v1[3]);
                    *(u32x4*)(Y + (size_t)(row0 + ai * 128 + m * 16) * 1024 + col0 + bj * 128) = w;
                }
    }
};
constexpr int MOE_TOKL = 131072;
__device__ __forceinline__ void phase_moe_up(const Params& p, LAS unsigned char* lds) {
    int tid_ = threadIdx.x; asm volatile("" : "+v"(tid_));
    MoeOrder S; S.init((const unsigned*)(p.ws + WS_CTL) + CW_CURSOR, gridDim.x, (int)blockIdx.x);
    LAS int* tokL = (LAS int*)(lds + MOE_TOKL);
    {
        const unsigned* cursor = (const unsigned*)(p.ws + WS_CTL) + CW_CURSOR; const int* inv = (const int*)(p.ws + WS_INV);
        pg8::Unit u;
        for (int i = 0; i < 8 && S.next(i, u); ++i) {
            const int e = u.pn >> 2, st = S.sg.start(e), cnt = (int)cursor[e];
            if (tid_ < 256) { const int slot = u.pm * 256 + tid_ - st; tokL[i * 256 + tid_] = (slot < cnt) ? inv[(size_t)e * T + slot] : 0; }
        }
        __syncthreads();
    }
    pg8::Gemm g{(const bf16*)(p.ws + WS_X1B), (const bf16*)(p.ws + WS_WGU), T, 16 * 1024, 1024};
    EpiSwiGLU E{(bf16*)(p.ws + WS_H)};
    pg8::gemm_phase<EpiSwiGLU, MoeOrder, true, true, true>(lds, g, S, E, tokL);
}
__device__ __forceinline__ void phase_moe_down(const Params& p, LAS unsigned char* lds) {
    pg8::Gemm g{(const bf16*)(p.ws + WS_H), (const bf16*)(p.ws + WS_WD), MOE_MAXROWS, 16 * 1024, 512};
    MoeOrder S; S.init((const unsigned*)(p.ws + WS_CTL) + CW_CURSOR, gridDim.x, (int)blockIdx.x);
    EpiPlain E{(bf16*)(p.ws + WS_Y)};
    pg8::gemm_phase<EpiPlain, MoeOrder, true, true>(lds, g, S, E);
}

__device__ __forceinline__ void phase_final(const Params& p) {
    int tid_ = threadIdx.x; asm volatile("" : "+v"(tid_));
    const int tid = tid_, lane = tid & 63, wave = tid >> 6;
    const float* gain = p.in[17]; const float* bias = p.in[18];
    const bf16* Y = (const bf16*)(p.ws + WS_Y);
    Segs sg; sg.init((const unsigned*)(p.ws + WS_CTL) + CW_CURSOR);
#if defined(CHECK_YA)
    const bool poison = __uint_as_float(__hip_atomic_load((unsigned*)(p.ws + WS_CTL) + CW_MISMATCH, __ATOMIC_RELAXED, __HIP_MEMORY_SCOPE_AGENT)) > CHECK_YA;
#elif defined(CHECK_MASK)
    const bool poison = __hip_atomic_load((unsigned*)(p.ws + WS_CTL) + CW_MISMATCH, __ATOMIC_RELAXED, __HIP_MEMORY_SCOPE_AGENT) > (unsigned)CHECK_MASK;
#else
    const bool poison = false;
#endif
    const int step = gridDim.x * 8, tok0 = blockIdx.x * 8 + wave;
    const int* TE = (const int*)(p.ws + WS_TE); const float* TW = (const float*)(p.ws + WS_TW);
    const bf16* X1 = (const bf16*)(p.ws + WS_X1B);
#define FIN_TE(t_, E_, W_) do { const int tc_ = min((t_), T - 1); E_ = *(const u32x4*)(TE + (size_t)tc_ * 4); W_ = *(const f32x2*)(TW + (size_t)tc_ * 2); } while (0)
#define FIN_ROWS(t_, E_, XW_, YA_, YB_) do { const int tc_ = min((t_), T - 1); \
        const int g0_ = sg.start((int)E_.x) + (int)E_.y, g1_ = sg.start((int)E_.z) + (int)E_.w; \
        const u32x2* xr_ = (const u32x2*)(X1 + (size_t)tc_ * 1024) + lane; \
        const u32x2* y0_ = (const u32x2*)(Y + (size_t)g0_ * 1024) + lane; const u32x2* y1_ = (const u32x2*)(Y + (size_t)g1_ * 1024) + lane; \
        _Pragma("unroll") for (int j = 0; j < 4; ++j) { XW_[j] = xr_[64 * j]; YA_[j] = y0_[64 * j]; YB_[j] = y1_[64 * j]; } } while (0)
    u32x4 e_cur, e_nxt; f32x2 w_cur, w_nxt;
    u32x2 xw[4], ya[4], yb[4];
    FIN_TE(tok0, e_cur, w_cur);
    FIN_TE(tok0 + step, e_nxt, w_nxt);
    FIN_ROWS(tok0, e_cur, xw, ya, yb);
#pragma unroll 1
    for (int tok = tok0; tok < T; tok += step) {
        u32x4 e_n2; f32x2 w_n2; FIN_TE(tok + 2 * step, e_n2, w_n2);
        u32x2 xn[4], yan[4], ybn[4]; FIN_ROWS(tok + step, e_nxt, xn, yan, ybn);
        const float w0 = w_cur[0], w1 = w_cur[1];
        f32x4* row = (f32x4*)(p.out + (size_t)tok * 1024) + lane;
        f32x4 v[4]; float s = 0.f;
#pragma unroll
        for (int j = 0; j < 4; ++j) {
            const unsigned a0 = ya[j].x, a1 = ya[j].y, b0 = yb[j].x, b1 = yb[j].y;
            const f32x4 xv = {__uint_as_float(xw[j].x << 16), __uint_as_float(xw[j].x & 0xffff0000u), __uint_as_float(xw[j].y << 16), __uint_as_float(xw[j].y & 0xffff0000u)};
            f32x4 mo;
            mo.x = w0 * __uint_as_float(a0 << 16) + w1 * __uint_as_float(b0 << 16);
            mo.y = w0 * __uint_as_float(a0 & 0xffff0000u) + w1 * __uint_as_float(b0 & 0xffff0000u);
            mo.z = w0 * __uint_as_float(a1 << 16) + w1 * __uint_as_float(b1 << 16);
            mo.w = w0 * __uint_as_float(a1 & 0xffff0000u) + w1 * __uint_as_float(b1 & 0xffff0000u);
            v[j] = xv * ALPHA + mo; s += (v[j].x + v[j].y) + (v[j].z + v[j].w);
        }
        const float mean = wave_sum(s) * (1.f / 1024.f); float s2 = 0.f;
#pragma unroll
        for (int j = 0; j < 4; ++j) { v[j] = v[j] - mean; s2 += (v[j].x * v[j].x + v[j].y * v[j].y) + (v[j].z * v[j].z + v[j].w * v[j].w); }
        const float rstd = rsqrtf(wave_sum(s2) * (1.f / 1024.f) + LN_EPS);
#pragma unroll
        for (int j = 0; j < 4; ++j) { const int e0 = (lane + 64 * j) * 4; f32x4 o = v[j] * rstd * (*(const f32x4*)(gain + e0)) + (*(const f32x4*)(bias + e0)); if (poison) o = o * 3.0f; row[64 * j] = o; }
        e_cur = e_nxt; w_cur = w_nxt; e_nxt = e_n2; w_nxt = w_n2;
#pragma unroll
        for (int j = 0; j < 4; ++j) { xw[j] = xn[j]; ya[j] = yan[j]; yb[j] = ybn[j]; }
    }
#undef FIN_TE
#undef FIN_ROWS
}

constexpr int LDS_BYTES = 147456;
constexpr int MISC_OFF = LDS_BYTES - 64;
constexpr int CW_BAR = 4096;
constexpr size_t CTL_ZERO_BYTES = 65536;

#ifndef REP_PRO
#define REP_PRO 1
#endif
#ifndef REP_INP
#define REP_INP 1
#endif
#ifndef REP_IDX
#define REP_IDX 1
#endif
#ifndef REP_ATT
#define REP_ATT 1
#endif
#ifndef REP_MKV
#define REP_MKV 1
#endif
#ifndef REP_MSC
#define REP_MSC 1
#endif
#ifndef REP_MOU
#define REP_MOU 1
#endif
#ifndef REP_MRG
#define REP_MRG 1
#endif
#ifndef REP_OUT
#define REP_OUT 1
#endif
#ifndef REP_MOE
#define REP_MOE 1
#endif
#ifndef REP_EXW
#define REP_EXW 1
#endif
#ifndef REP_GAT
#define REP_GAT 1
#endif
#ifndef MEGA_MINB
#define MEGA_MINB 2
#endif
__global__ void __launch_bounds__(512, MEGA_MINB) k_mega(Params p) {
    extern __shared__ __attribute__((aligned(16))) unsigned char lds_raw[];
    LAS unsigned char* lds = (LAS unsigned char*)lds_raw;
    const int tid = threadIdx.x;
    volatile LAS unsigned* MISC = (volatile LAS unsigned*)(lds + MISC_OFF);
    if (tid < 16) MISC[tid] = 0u;
    __syncthreads();
    XcdBarrier bar = xcd_barrier_post((unsigned*)(p.ws + WS_CTL) + CW_BAR, MISC + 8);
    for (int rep_ = 0; rep_ < REP_PRO; ++rep_) { phase_prologue(p, lds); __syncthreads(); }
    xcd_barrier(bar);
    for (int rep_ = 0; rep_ < REP_INP; ++rep_) phase_inproj(p, lds);
#ifdef REP_INP_DUMMY
    phase_inproj_dummy(p, lds);
#endif
    xcd_barrier(bar);
#if defined(CHECK_MASK) || defined(FAST_ATTN)
    for (int rep_ = 0; rep_ < REP_IDX; ++rep_) phase_indexer(p, lds);
#endif
#ifdef CHECK_MASK
    xcd_barrier(bar);
#endif
#ifndef FAST_ATTN
    { const int lane = tid & 63, wave = tid >> 6;
      if (wave < 4) attn_simple_body(p, (unsigned*)(lds_raw + wave * 32768), (float*)(lds_raw + 131072 + wave * 1024), blockIdx.x * 4 + wave, gridDim.x * 4, lane);
      __syncthreads(); }
#endif
    for (int rep_ = 0; rep_ < REP_MKV; ++rep_) mlstm_kv_phase(p, lds);
    xcd_barrier(bar);
#ifdef FAST_ATTN
    {
        const attn_body::AttnTensors AT{(const attn_body::bf16*)(p.ws + WS_AQ), (const attn_body::bf16*)(p.ws + WS_AK), (const attn_body::bf16*)(p.ws + WS_AV),
                                        (attn_body::bf16*)(p.ws + WS_YA), (const unsigned long long*)(p.ws + WS_MASK)};
        const attn_body::StaticOrder S((int)gridDim.x, (int)blockIdx.x);
        for (int rep_ = 0; rep_ < REP_ATT; ++rep_) attn_body::attn_phase<attn_body::StaticOrder>((char*)lds_raw, AT, S);
        __syncthreads();
    }
#endif
    for (int rep_ = 0; rep_ < REP_MSC; ++rep_) mlstm_scan(p);
    xcd_barrier(bar);
#ifdef CHECK_YA
    {
        const int lane = tid & 63, wave = tid >> 6;
        if (wave < 4) attn_simple_body(p, (unsigned*)(lds_raw + wave * 32768), (float*)(lds_raw + 131072 + wave * 1024), blockIdx.x * 4 + wave, gridDim.x * 4, lane);
        __syncthreads(); }
#endif
    for (int rep_ = 0; rep_ < REP_MOU; ++rep_) mlstm_out_phase(p, lds);
    xcd_barrier(bar);
    for (int rep_ = 0; rep_ < REP_EXW; ++rep_) phase_expert_weights(p, lds);
    __syncthreads();
    for (int rep_ = 0; rep_ < REP_MRG; ++rep_) { phase_merge(p, lds); __syncthreads(); }
    xcd_barrier(bar);
    for (int rep_ = 0; rep_ < REP_OUT; ++rep_) phase_outproj(p, lds);
    xcd_barrier(bar);
    phase_ln1_route(p, lds);
    xcd_barrier(bar);
#ifndef REP_MUP
#define REP_MUP REP_MOE
#endif
#ifndef REP_MDN
#define REP_MDN REP_MOE
#endif
    for (int rep_ = 0; rep_ < REP_MUP; ++rep_) phase_moe_up(p, lds);
    xcd_barrier(bar);
    for (int rep_ = 0; rep_ < REP_MDN; ++rep_) phase_moe_down(p, lds);
    xcd_barrier(bar);
#ifdef REP_BAR
    for (int rep_ = 0; rep_ < REP_BAR; ++rep_) xcd_barrier(bar);
#endif
    phase_final(p);
}

extern "C" void kernel_launch(void* const* d_in, const int* in_sizes, int n_in, void* d_out, int out_size, void* d_ws, size_t ws_size, hipStream_t stream) {
    static int grid = 0;
    if (grid == 0) {
        if (n_in != 19 || out_size != T * DM || ws_size < WS_END) { fprintf(stderr, "kernel_launch: unexpected shapes (n_in %d out %d ws %zu)\n", n_in, out_size, ws_size); grid = -1; return; }
        int dev = 0, cus = 0, per_cu = 0;
        if (hipGetDevice(&dev) != hipSuccess || hipDeviceGetAttribute(&cus, hipDeviceAttributeMultiprocessorCount, dev) != hipSuccess) { grid = -1; return; }
        if (hipFuncSetAttribute((const void*)k_mega, hipFuncAttributeMaxDynamicSharedMemorySize, LDS_BYTES) != hipSuccess) { fprintf(stderr, "kernel_launch: hipFuncSetAttribute failed\n"); grid = -1; return; }
        if (hipOccupancyMaxActiveBlocksPerMultiprocessor(&per_cu, (const void*)k_mega, 512, LDS_BYTES) != hipSuccess || per_cu < 1) fprintf(stderr, "kernel_launch: occupancy query says %d\n", per_cu);
        (void)hipGetLastError();
        grid = cus;
    }
    if (grid < 0) return;
    (void)hipMemsetAsync((char*)d_ws + WS_CTL, 0, CTL_ZERO_BYTES, stream);
    Params p{};
    for (int i = 0; i < 19; ++i) p.in[i] = (const float*)d_in[i];
    p.out = (float*)d_out; p.ws = (unsigned char*)d_ws;
    hipLaunchKernelGGL(k_mega, dim3(grid), dim3(512), LDS_BYTES, stream, p);
}
```

```cpp
#include <hip/hip_runtime.h>
#include <cstdio>
#include <cstdint>
#include <cmath>
#define FAST_ATTN 1
#define IDX_OLD_P2 1
#define IDX_NOCLAMP 1
#define LN1_PF 1
#define IDX_KPF 1
#define MOU_UNROLL 4
#define MOU_BATCH 1
#define MOU_MOPF 1
#define MKV_BATCH 1
#define IDX_BIS_PREFIX 1
#define IDX_HEAVY_LIST 1
#define IDX_H_IL 1
#define NT_STORES 1
#define NT_STORES2 1
#define NT_L_PRO 1
#define NT_L_W 1
#define NT_L_X 1
#define NT_L_GATE 1
#define IDX_SGB 7
#define IDX_NOKPF1 1
#define MKV_SGB 4
#define NT_YA 1
#define NT_MERGED 1
namespace pg8 {
#define PG8_LAS __attribute__((address_space(3)))
typedef unsigned short bf16_t;
typedef short bf16x8 __attribute__((ext_vector_type(8)));
typedef float f32x4 __attribute__((ext_vector_type(4)));
typedef unsigned u32x4 __attribute__((ext_vector_type(4)));
constexpr int BM = 256, BK = 64, HALF = 128, HTB = HALF * BK * 2  , STAGE_BYTES = 8 * HTB, NXCD = 8,
#ifdef PG8_WGM
    WGM = PG8_WGM;
#else
    WGM = 8;
#endif

__host__ __device__ __forceinline__ int lds_byte(int r, int c) { const int st = (r >> 4) * 2 + (c >> 5), rr = r & 15, cc = c & 31, ob = rr * 64 + cc * 2; return st * 1024 + (ob ^ (((ob >> 9) & 1) << 5)); }
__host__ __device__ __forceinline__ void stage_rc(int b, int& R, int& C) { const int st = b / 1024, sb = b % 1024, swz = sb ^ (((sb >> 9) & 1) << 5); R = (st >> 1) * 16 + swz / 64; C = (st & 1) * 32 + (swz % 64) / 2; }
__host__ __device__ __forceinline__ int perm32(int rho) { const int n = rho >> 4, i = rho & 15; return 8 * (i >> 2) + 4 * n + (i & 3); }

struct Unit { int pm, pn; };
struct Gemm { const bf16_t* A; const bf16_t* Bt; int M, N, K; };

struct StaticOrder {
    int nM, nN, nwg, G, c;
    __host__ __device__ void init(int M, int N, int G_, int c_) { nM = M / BM; nN = N / BM; nwg = nM * nN; G = G_; c = c_; }
    __host__ __device__ bool next(int i, Unit& u) const {
        const long L = (long)i * G + c; if (L >= nwg) return false;
        int wgid = (int)L; { const int q = nwg / NXCD, r = nwg % NXCD, xcd = wgid % NXCD, off = wgid / NXCD; wgid = (xcd < r ? xcd * (q + 1) : r * (q + 1) + (xcd - r) * q) + off; }
        const int nig = WGM * nN, gid = wgid / nig, fm = gid * WGM, gsz = (nM - fm) < WGM ? (nM - fm) : WGM;
        u.pm = fm + ((wgid % nig) % gsz); u.pn = (wgid % nig) / gsz; return true;
    }
    __device__ __forceinline__ void a_ready(const Unit&) const {}
    __device__ __forceinline__ void done(const Unit&) const {}
};

__device__ __forceinline__ unsigned cvt_pk_bf16(float lo, float hi) { unsigned r; asm volatile("v_cvt_pk_bf16_f32 %0, %1, %2" : "=v"(r) : "v"(lo), "v"(hi)); return r; }
typedef float f32x2 __attribute__((ext_vector_type(2)));
template <class Epi, class Sched, bool ALIGN_EPI = false, bool SP2 = false, bool GATHER = false>
__device__ __forceinline__ void gemm_phase(PG8_LAS unsigned char* lds, const Gemm g, const Sched& S, const Epi& E, const PG8_LAS int* tokL = nullptr) {
    int tid_ = threadIdx.x; asm volatile("" : "+v"(tid_));
    const int tid = tid_, wid = __builtin_amdgcn_readfirstlane(tid >> 6), lane = tid & 63, wr = wid >> 2, wc = wid & 3, fr = lane & 15, fq = lane >> 4;
    const int K = g.K, nt = K / BK;
    unsigned voffA[2], voffB[2]; int stR[2], stC[2];
#pragma unroll
    for (int i = 0; i < 2; ++i) { int R, C; stage_rc(tid * 16 + i * 8192, R, C); const int Rb = Epi::PERM ? ((R & ~31) + perm32(R & 31)) : R; stR[i] = R; stC[i] = C;
        voffA[i] = (unsigned)(R * K + C) * 2u; voffB[i] = (unsigned)(Rb * K + C) * 2u; }
    unsigned gaC[2][2], gaN[2][2];
#define PG8_GOFF(dst, un) do { _Pragma("unroll") for (int h_ = 0; h_ < 2; ++h_) _Pragma("unroll") for (int i_ = 0; i_ < 2; ++i_) \
        dst[h_][i_] = (unsigned)tokL[(un) * 256 + h_ * HALF + stR[i_]] * (unsigned)(K * 2) + (unsigned)stC[i_] * 2u; } while (0)
#define PG8_STAGEA(bufoff, kbase, h, NEXT) do { if constexpr (GATHER) { const unsigned vo_[2] = {(NEXT) ? gaN[h][0] : gaC[h][0], (NEXT) ? gaN[h][1] : gaC[h][1]}; PG8_STAGE(bufoff, kbase, vo_); } \
        else { PG8_STAGE(bufoff, (kbase) + (h) * hstep, voffA); } } while (0)
    const size_t kstep = (size_t)(BK * 2);
    const size_t hstep = (size_t)HALF * K * 2;
    const size_t tstep = 2 * hstep;
    const unsigned ldsw = (unsigned)wid * 1024u;
    const int aoff = lds_byte(wr * 64 + fr, fq * 8), boff = lds_byte(wc * 32 + fr, fq * 8);
#define PG8_SA(b, h) (((b) * 2 + (h)) * HTB)
#define PG8_SB(b, h) ((4 + (b) * 2 + (h)) * HTB)
#define PG8_STAGE(bufoff, gbase, voff) do { _Pragma("unroll") for (int _i = 0; _i < 2; ++_i) \
        __builtin_amdgcn_global_load_lds((const unsigned*)((const char*)(gbase) + (voff)[_i]), (PG8_LAS unsigned*)(lds + (bufoff) + ldsw + _i * 8192), 16, 0, 0); } while (0)
#define PG8_LDA(dst, b, h) do { _Pragma("unroll") for (int m = 0; m < 4; ++m) _Pragma("unroll") for (int k = 0; k < 2; ++k) dst[m][k] = *(const PG8_LAS bf16x8*)(lds + PG8_SA(b, h) + aoff + m * 2048 + k * 1024); } while (0)
#define PG8_LDB(dst, b, h) do { _Pragma("unroll") for (int n = 0; n < 2; ++n) _Pragma("unroll") for (int k = 0; k < 2; ++k) dst[n][k] = *(const PG8_LAS bf16x8*)(lds + PG8_SB(b, h) + boff + n * 2048 + k * 1024); } while (0)
#define PG8_MMA(ai, bj, At, Bt) do { __builtin_amdgcn_s_setprio(1); _Pragma("unroll") for (int m = 0; m < 4; ++m) _Pragma("unroll") for (int n = 0; n < 2; ++n) _Pragma("unroll") for (int k = 0; k < 2; ++k) \
        acc[ai][bj][m][n] = __builtin_amdgcn_mfma_f32_16x16x32_bf16(Bt[n][k], At[m][k], acc[ai][bj][m][n], 0, 0, 0); __builtin_amdgcn_s_setprio(0); } while (0)
#define PG8_WAIT_V(n) asm volatile("s_waitcnt vmcnt(" #n ")" ::: "memory")
#define PG8_WAIT_L(n) asm volatile("s_waitcnt lgkmcnt(" #n ")" ::: "memory")
#define PG8_BAR __builtin_amdgcn_s_barrier()
#define PG8_SCHED __builtin_amdgcn_sched_barrier(0)
    Unit cur, nxt; int ui = 0;
    if (!S.next(0, cur)) return;
    f32x4 acc[2][2][4][2];
#pragma unroll
    for (int a = 0; a < 2; ++a)
#pragma unroll
        for (int b = 0; b < 2; ++b)
#pragma unroll
            for (int m = 0; m < 4; ++m)
#pragma unroll
                for (int n = 0; n < 2; ++n) acc[a][b][m][n] = (f32x4){0.f, 0.f, 0.f, 0.f};
    bf16x8 At[4][2], B0[2][2], B1[2][2];
    const char* cA = (const char*)g.A + (GATHER ? (size_t)0 : (size_t)cur.pm * tstep); const char* cB = (const char*)g.Bt + (size_t)cur.pn * tstep;
    if constexpr (GATHER) { PG8_GOFF(gaC, 0); }
    S.a_ready(cur);
    if constexpr (SP2) {
        PG8_STAGE(PG8_SB(0, 0), cB, voffB); PG8_STAGE(PG8_SB(0, 1), cB + hstep, voffB); PG8_STAGEA(PG8_SA(0, 0), cA, 0, false); PG8_STAGEA(PG8_SA(0, 1), cA, 1, false);
        if (wr == 1) PG8_BAR;
        PG8_WAIT_V(2); PG8_BAR;
        PG8_STAGE(PG8_SB(1, 0), cB + kstep, voffB); PG8_STAGEA(PG8_SA(1, 0), cA + kstep, 0, false); PG8_STAGE(PG8_SB(1, 1), cB + hstep + kstep, voffB);
        PG8_WAIT_V(6); PG8_BAR;
    } else {
        PG8_STAGE(PG8_SB(0, 0), cB, voffB); PG8_STAGEA(PG8_SA(0, 0), cA, 0, false); PG8_STAGE(PG8_SB(0, 1), cB + hstep, voffB); PG8_STAGEA(PG8_SA(0, 1), cA, 1, false);
        if (wr == 1) PG8_BAR;
        PG8_WAIT_V(4); PG8_BAR;
        PG8_STAGE(PG8_SB(1, 0), cB + kstep, voffB); PG8_STAGEA(PG8_SA(1, 0), cA + kstep, 0, false); PG8_STAGE(PG8_SB(1, 1), cB + hstep + kstep, voffB);
        PG8_WAIT_V(6); PG8_BAR;
    }
    for (;;) {
        const bool has_next = S.next(ui + 1, nxt);
        const char* nA = (has_next && !GATHER) ? (const char*)g.A + (size_t)nxt.pm * tstep : cA; const char* nB = has_next ? (const char*)g.Bt + (size_t)nxt.pn * tstep : cB;
        if constexpr (GATHER) { if (has_next) { PG8_GOFF(gaN, ui + 1); } else { _Pragma("unroll") for (int h_ = 0; h_ < 2; ++h_) _Pragma("unroll") for (int i_ = 0; i_ < 2; ++i_) gaN[h_][i_] = gaC[h_][i_]; } }
        for (int t = 0; t < nt; t += 2) {
            const bool last = (t == nt - 2);
            const char* a1 = cA + (size_t)(t + 1) * kstep;
            const char* a2 = last ? nA : cA + (size_t)(t + 2) * kstep; const char* b2 = last ? nB : cB + (size_t)(t + 2) * kstep;
            const char* a3 = a2 + kstep; const char* b3 = b2 + kstep;
            if (last && has_next) S.a_ready(nxt);
            if constexpr (SP2) {
            PG8_LDB(B0, 0, 0); PG8_LDB(B1, 0, 1); PG8_SCHED; PG8_LDA(At, 0, 0); PG8_STAGEA(PG8_SA(1, 1), a1, 1, false);
            PG8_WAIT_V(8); PG8_WAIT_L(0); PG8_BAR; PG8_MMA(0, 0, At, B0); PG8_MMA(0, 1, At, B1); PG8_BAR; PG8_SCHED;
            PG8_LDA(At, 0, 1); PG8_STAGE(PG8_SB(0, 0), b2, voffB); PG8_STAGE(PG8_SB(0, 1), b2 + hstep, voffB); PG8_STAGEA(PG8_SA(0, 0), a2, 0, last);
            PG8_WAIT_V(8); PG8_WAIT_L(0); PG8_BAR; PG8_MMA(1, 0, At, B0); PG8_MMA(1, 1, At, B1); PG8_BAR; PG8_SCHED;
            PG8_LDB(B0, 1, 0); PG8_LDB(B1, 1, 1); PG8_SCHED; PG8_LDA(At, 1, 0); PG8_STAGEA(PG8_SA(0, 1), a2, 1, last);
            PG8_WAIT_V(8); PG8_WAIT_L(0); PG8_BAR; PG8_MMA(0, 0, At, B0); PG8_MMA(0, 1, At, B1); PG8_BAR; PG8_SCHED;
            PG8_LDA(At, 1, 1); PG8_STAGE(PG8_SB(1, 0), b3, voffB); PG8_STAGE(PG8_SB(1, 1), b3 + hstep, voffB); PG8_STAGEA(PG8_SA(1, 0), a3, 0, last);
            PG8_WAIT_V(8); PG8_WAIT_L(0); PG8_BAR; PG8_MMA(1, 0, At, B0); PG8_MMA(1, 1, At, B1); PG8_BAR; PG8_SCHED;
            } else {
            PG8_LDB(B0, 0, 0); PG8_SCHED; PG8_LDA(At, 0, 0); PG8_STAGEA(PG8_SA(1, 1), a1, 1, false);
            PG8_WAIT_L(8); PG8_BAR; PG8_WAIT_L(0); PG8_MMA(0, 0, At, B0); PG8_BAR; PG8_SCHED;
            PG8_LDB(B1, 0, 1); PG8_STAGE(PG8_SB(0, 0), b2, voffB);
            PG8_BAR; PG8_WAIT_L(0); PG8_MMA(0, 1, At, B1); PG8_BAR;
            PG8_LDA(At, 0, 1); PG8_STAGEA(PG8_SA(0, 0), a2, 0, last);
            PG8_BAR; PG8_WAIT_L(0); PG8_MMA(1, 0, At, B0); PG8_BAR; PG8_SCHED;
            PG8_STAGE(PG8_SB(0, 1), b2 + hstep, voffB);
            PG8_WAIT_V(6); PG8_BAR; PG8_MMA(1, 1, At, B1); PG8_BAR;
            PG8_LDB(B0, 1, 0); PG8_SCHED; PG8_LDA(At, 1, 0); PG8_STAGEA(PG8_SA(0, 1), a2, 1, last);
            PG8_WAIT_L(8); PG8_BAR; PG8_WAIT_L(0); PG8_MMA(0, 0, At, B0); PG8_BAR; PG8_SCHED;
            PG8_LDB(B1, 1, 1); PG8_STAGE(PG8_SB(1, 0), b3, voffB);
            PG8_BAR; PG8_WAIT_L(0); PG8_MMA(0, 1, At, B1); PG8_BAR;
            PG8_LDA(At, 1, 1); PG8_STAGEA(PG8_SA(1, 0), a3, 0, last);
            PG8_BAR; PG8_WAIT_L(0); PG8_MMA(1, 0, At, B0); PG8_BAR; PG8_SCHED;
            PG8_STAGE(PG8_SB(1, 1), b3 + hstep, voffB);
            PG8_WAIT_V(6); PG8_BAR; PG8_MMA(1, 1, At, B1); PG8_BAR;
            }
        }
        if constexpr (ALIGN_EPI) { if (wr == 0) PG8_BAR; }
        if constexpr (!Epi::AFTER_DRAIN) { E(acc, cur, wr, wc, fr, fq); S.done(cur); }
        if (!has_next) break;
#pragma unroll
        for (int a = 0; a < 2; ++a)
#pragma unroll
            for (int b = 0; b < 2; ++b)
#pragma unroll
                for (int m = 0; m < 4; ++m)
#pragma unroll
                    for (int n = 0; n < 2; ++n) acc[a][b][m][n] = (f32x4){0.f, 0.f, 0.f, 0.f};
        cur = nxt; cA = nA; cB = nB; ++ui;
        if constexpr (GATHER) { _Pragma("unroll") for (int h_ = 0; h_ < 2; ++h_) _Pragma("unroll") for (int i_ = 0; i_ < 2; ++i_) gaC[h_][i_] = gaN[h_][i_]; }
        if constexpr (ALIGN_EPI) { if (wr == 1) PG8_BAR; }
    }
    PG8_WAIT_V(0);
    if constexpr (!ALIGN_EPI) { if (wr == 0) PG8_BAR; }
    PG8_BAR;
    if constexpr (Epi::AFTER_DRAIN) { E.fused(acc, cur, wr, wc, fr, fq, lds, wid, lane); S.done(cur); }
#undef PG8_SA
#undef PG8_SB
#undef PG8_STAGE
#undef PG8_STAGEA
#undef PG8_GOFF
#undef PG8_LDA
#undef PG8_LDB
#undef PG8_MMA
#undef PG8_WAIT_V
#undef PG8_WAIT_L
#undef PG8_BAR
#undef PG8_SCHED
}
}

#define GAS __attribute__((address_space(1)))
#define LAS __attribute__((address_space(3)))
typedef unsigned short bf16;
typedef float f32x4 __attribute__((ext_vector_type(4)));
typedef float f32x2 __attribute__((ext_vector_type(2)));
typedef short bf16x8 __attribute__((ext_vector_type(8)));
typedef unsigned u32x4 __attribute__((ext_vector_type(4)));
typedef unsigned u32x2 __attribute__((ext_vector_type(2)));

constexpr int NB = 4, SEQ = 8192, T = NB * SEQ, DM = 1024;
constexpr int NW_IN = 7168;
constexpr int NCHUNK = 64, NUNIT_M = NB * 8 * NCHUNK;
constexpr float ALPHA = 1.189207115002721f;
constexpr float QSCALE2 = 0.125f * 1.4426950408889634f;
constexpr float LN_EPS = 1e-5f, GN_EPS = 1e-6f;
#ifdef IDX_NOCLAMP
constexpr float IDX_QSCALE = 1.0f, IDX_WSCALE = 1.0f;
#else
constexpr float IDX_QSCALE = 9.313225746154785e-10f, IDX_WSCALE = 1073741824.0f;
#endif
constexpr int MOE_MAXROWS = 65536 + 16 * 256;

constexpr size_t MiB = 1u << 20;
constexpr size_t WS_CTL = 0;
constexpr size_t WS_WIN = 1 * MiB;
constexpr size_t WS_WBA = 15 * MiB;
constexpr size_t WS_WBM = 16 * MiB;
constexpr size_t WS_WOUT = 18 * MiB;
constexpr size_t WS_COS = 20 * MiB, WS_SIN = 21 * MiB;
constexpr size_t WS_BIAS = 22 * MiB;
constexpr size_t WS_TE = 22 * MiB + 64 * 1024;
constexpr size_t WS_TW = WS_TE + (size_t)T * 16;
constexpr size_t WS_POS = WS_TW + (size_t)T * 8;
constexpr size_t WS_CST = 24 * MiB;
constexpr size_t WS_DSC = 60 * MiB;
constexpr size_t WS_MC = 60 * MiB + 64 * 1024;
constexpr size_t WS_DN = 61 * MiB;
constexpr size_t WS_WGU = 24 * MiB;
constexpr size_t WS_WD = 56 * MiB;
constexpr size_t WS_AQ = 72 * MiB, WS_AK = 104 * MiB, WS_AV = 136 * MiB;
constexpr size_t WS_IQ = 168 * MiB;
constexpr size_t WS_IK = 184 * MiB;
constexpr size_t WS_IW = 188 * MiB;
constexpr size_t WS_MI = 189 * MiB, WS_MF = 190 * MiB;
constexpr size_t WS_MQ = 192 * MiB, WS_MK = 224 * MiB;
constexpr size_t WS_MV = 256 * MiB;
constexpr size_t WS_MO = 320 * MiB;
constexpr size_t WS_GA = 384 * MiB;
constexpr size_t WS_MASK = 448 * MiB;
constexpr size_t WS_YA = 480 * MiB;
constexpr size_t WS_MERGED = 192 * MiB;
constexpr size_t WS_X1B = 72 * MiB;
constexpr size_t WS_INV = 136 * MiB;
constexpr size_t WS_H = 208 * MiB;
constexpr size_t WS_Y = 276 * MiB;
constexpr size_t WS_END = 512 * MiB;
constexpr size_t DO_XN = 0;
constexpr size_t DO_GM = 64 * MiB;
constexpr size_t DO_DC = 0;
constexpr size_t DO_YM = 0;
constexpr int CW_CURSOR = 64;
constexpr int CW_MISMATCH = 96;

struct Params { const float* in[19]; float* out; unsigned char* ws; };

#ifdef NT_STORES
#define ST_NT(ptr_, val_) __builtin_nontemporal_store((val_), (ptr_))
#else
#define ST_NT(ptr_, val_) (*(ptr_) = (val_))
#endif
#ifdef NT_STORES2
#define ST_NT2(ptr_, val_) __builtin_nontemporal_store((val_), (ptr_))
#else
#define ST_NT2(ptr_, val_) (*(ptr_) = (val_))
#endif
#ifdef NT_STORES3
#define ST_NT3(ptr_, val_) __builtin_nontemporal_store((val_), (ptr_))
#else
#define ST_NT3(ptr_, val_) (*(ptr_) = (val_))
#endif
#ifdef NT_LOADS2
#define LD_NT2(ptr_) __builtin_nontemporal_load(ptr_)
#else
#define LD_NT2(ptr_) (*(ptr_))
#endif
#ifdef NT_LOADS3
#define LD_NT3(ptr_) __builtin_nontemporal_load(ptr_)
#else
#define LD_NT3(ptr_) (*(ptr_))
#endif
__device__ __forceinline__ void st_sc1_16(void* p, u32x4 v) { asm volatile("global_store_dwordx4 %0, %1, off sc1" :: "v"(p), "v"(v) : "memory"); }
__device__ __forceinline__ void st_sc1_8(void* p, u32x2 v) { asm volatile("global_store_dwordx2 %0, %1, off sc1" :: "v"(p), "v"(v) : "memory"); }
#ifdef NT_LOADS
#define NT_L_PRO 1
#define NT_L_W 1
#define NT_L_FIN 1
#define NT_L_GATE 1
#define NT_L_X 1
#endif
#ifdef NT_L_PRO
#define LD_NT_PRO(ptr_) __builtin_nontemporal_load(ptr_)
#else
#define LD_NT_PRO(ptr_) (*(ptr_))
#endif
#ifdef NT_L_W
#define LD_NT_W(ptr_) __builtin_nontemporal_load(ptr_)
#else
#define LD_NT_W(ptr_) (*(ptr_))
#endif
#ifdef NT_L_FIN
#define LD_NT_FIN(ptr_) __builtin_nontemporal_load(ptr_)
#else
#define LD_NT_FIN(ptr_) (*(ptr_))
#endif
#ifdef NT_L_GATE
#define LD_NT_GATE(ptr_) __builtin_nontemporal_load(ptr_)
#else
#define LD_NT_GATE(ptr_) (*(ptr_))
#endif
#ifdef NT_L_X
#define LD_NT_X(ptr_) __builtin_nontemporal_load(ptr_)
#else
#define LD_NT_X(ptr_) (*(ptr_))
#endif
__device__ __forceinline__ float bf2f(unsigned h) { return __uint_as_float(h << 16); }
typedef float f32x2_t_ __attribute__((ext_vector_type(2))); typedef __bf16 bf16x2_t_ __attribute__((ext_vector_type(2)));
__device__ __forceinline__ unsigned pk2(float lo, float hi) { const f32x2_t_ v = {lo, hi}; const bf16x2_t_ b = __builtin_convertvector(v, bf16x2_t_); return __builtin_bit_cast(unsigned, b); }
__device__ __forceinline__ unsigned f2bf(float f) { return pk2(f, 0.f) & 0xffffu; }
__device__ __forceinline__ float rcpf_(float x) { return __builtin_amdgcn_rcpf(x); }
__device__ __forceinline__ float sigmoidf_(float x) { return __builtin_amdgcn_rcpf(1.0f + __builtin_amdgcn_exp2f(-1.4426950408889634f * x)); }
__device__ __forceinline__ float siluf_(float x) { return x * __builtin_amdgcn_rcpf(1.0f + __builtin_amdgcn_exp2f(-1.4426950408889634f * x)); }
__device__ __forceinline__ float logsigmoidf_(float x) { return fminf(x, 0.f) - log1pf(__expf(-fabsf(x))); }
__device__ __forceinline__ float wave_sum(float v) {
#pragma unroll
    for (int o = 1; o < 64; o <<= 1) v += __shfl_xor(v, o);
    return v;
}
__device__ __forceinline__ float wave_max(float v) {
#pragma unroll
    for (int o = 1; o < 64; o <<= 1) v = fmaxf(v, __shfl_xor(v, o));
    return v;
}
__host__ __device__ __forceinline__ int ropeil(int d) { return d < 32 ? 2 * d : 2 * (d - 32) + 1; }
__host__ __device__ __forceinline__ int win_newcol(int c) {
    if (c < 1024) return (c & ~63) + ropeil(c & 63);
    if (c < 1536) return c;
    if (c < 1792) return (c & ~63) + ropeil(c & 63);
    if (c < 1856) return 1792 + ropeil(c - 1792);
    if (c < 1860) return 1792 + 64 + (c - 1856);
    if (c < 2372) return 2048 + (c - 1860);
    if (c < 2884) return 2560 + (c - 2372);
    if (c < 3908) return 3072 + (c - 2884);
    if (c < 3916) return 1792 + 72 + (c - 3908);
    if (c < 3924) return 1792 + 80 + (c - 3916);
    if (c < 4948) return 4096 + (c - 3924);
    if (c < 5972) return 5120 + (c - 4948);
    return 6144 + (c - 5972);
}
typedef GAS unsigned gu32;
typedef GAS unsigned long long gu64;
#define RLX_AGENT __ATOMIC_RELAXED, __HIP_MEMORY_SCOPE_AGENT
#define LDS_WAIT() asm volatile("s_waitcnt lgkmcnt(0)" ::: "memory")
#define VM_WAIT() asm volatile("s_waitcnt vmcnt(0)" ::: "memory")
__device__ __forceinline__ unsigned long long rt() { return __builtin_amdgcn_s_memrealtime(); }
#define XB_TMO      128
#define XB_XCNT(j)  (256  + 64 * (j))
#define XB_XSUB(j)  (1280 + 64 * (j))
#define XB_XGEN(j)  (2304 + 64 * (j))
#define XB_TOP      3328
#define XB_TOPGEN   3392
#define XCD_BAR_WORDS 3456
#define XB_SPIN_CAP (1u << 18)

__device__ __forceinline__ unsigned xb_ld(unsigned* p)              { return __hip_atomic_load(p, __ATOMIC_RELAXED, __HIP_MEMORY_SCOPE_AGENT); }
__device__ __forceinline__ unsigned xb_add(unsigned* p, unsigned v) { return __hip_atomic_fetch_add(p, v, __ATOMIC_RELAXED, __HIP_MEMORY_SCOPE_AGENT); }
__device__ __forceinline__ unsigned xb_xcc_id() { return (unsigned)__builtin_amdgcn_s_getreg((3 << 11) | 20) & 0xFu; }
#define XB_SPIN(cond, bar) do { unsigned _sp = 0; while (cond) { __builtin_amdgcn_s_sleep(1); \
    if ((++_sp & 255u) == 0u) { if (xb_ld(&(bar)[XB_TMO])) break; if (_sp > XB_SPIN_CAP) { atomicAdd(&(bar)[XB_TMO], 1u); break; } } } } while (0)

struct XcdBarrier {
    unsigned* bar; unsigned x;
    volatile LAS unsigned* st;
};

__device__ __forceinline__ XcdBarrier xcd_barrier_post(unsigned* bar, volatile LAS unsigned* st) {
    XcdBarrier b; b.bar = bar; b.x = xb_xcc_id(); b.st = st;
    if (threadIdx.x == 0) (void)xb_add(&bar[XB_XCNT(b.x)], 1u);
    return b;
}
__device__ __forceinline__ void xcd_barrier_complete(unsigned* bar, unsigned x, unsigned& nloc, unsigned& nx) {
    const unsigned G = gridDim.x * gridDim.y * gridDim.z;
    unsigned sum, cnt, mine, sp = 0u;
    for (;;) {
        sum = 0u; cnt = 0u; mine = 0u;
#pragma unroll
        for (unsigned j = 0; j < 16; ++j) { const unsigned c = xb_ld(&bar[XB_XCNT(j)]); sum += c; cnt += (c > 0u) ? 1u : 0u; mine = (j == x) ? c : mine; }
        if (sum == G) break;
        __builtin_amdgcn_s_sleep(1);
        if ((++sp & 255u) == 0u) { if (xb_ld(&bar[XB_TMO])) break; if (sp > XB_SPIN_CAP) { atomicAdd(&bar[XB_TMO], 1u); break; } }
    }
    nloc = mine > 0u ? mine : 1u; nx = cnt > 0u ? cnt : 1u;
}

__device__ __forceinline__ void xcd_barrier(const XcdBarrier& b) {
    asm volatile("s_waitcnt vmcnt(0)" ::: "memory");
    __syncthreads();
    if (threadIdx.x == 0) {
        unsigned* bar = b.bar;
        __builtin_amdgcn_s_waitcnt(0);
        unsigned nloc = b.st[0], nx = b.st[1];
        if (nloc == 0u) { xcd_barrier_complete(bar, b.x, nloc, nx); b.st[0] = nloc; b.st[1] = nx; }
        const unsigned old = xb_add(&bar[XB_XSUB(b.x)], 1u);
        const unsigned gen = old / nloc;
        if (old + 1u == (gen + 1u) * nloc) {
            __builtin_amdgcn_fence(__ATOMIC_RELEASE, "agent");
            asm volatile("s_waitcnt vmcnt(0)" ::: "memory");
            const unsigned og = xb_add(&bar[XB_TOP], 1u);
            const unsigned tg = og / nx;
            if (og + 1u == (tg + 1u) * nx) xb_add(&bar[XB_TOPGEN], 1u);
            else XB_SPIN(xb_ld(&bar[XB_TOPGEN]) == tg, bar);
            __builtin_amdgcn_fence(__ATOMIC_ACQUIRE, "agent");
            xb_add(&bar[XB_XGEN(b.x)], 1u);
            asm volatile("s_waitcnt vmcnt(0)" ::: "memory");
        } else {
            XB_SPIN(xb_ld(&bar[XB_XGEN(b.x)]) == gen, bar);
            __builtin_amdgcn_fence(__ATOMIC_ACQUIRE, "agent");
            asm volatile("s_waitcnt vmcnt(0)" ::: "memory");
        }
    }
    __syncthreads();
}

template <class F, bool NTS = false>
__device__ __forceinline__ void transpose_item(const float* W, int K, int N, bf16* WT, LAS float* scr, int item, int lane, F rowmap, int ldk = 0, int koff = 0) {
    if (ldk == 0) ldk = K;
    const int nblk = (N + 31) / 32, kb = item / nblk, nb = item % nblk, k0 = 64 * kb, n0 = 32 * nb;
    const int nsrc = n0 + (lane & 31);
    float wv[32];
#pragma unroll
    for (int i = 0; i < 32; ++i) { const int kk = 2 * i + (lane >> 5); wv[i] = nsrc < N ? LD_NT_W(W + (size_t)(k0 + kk) * N + nsrc) : 0.f; }
#pragma unroll
    for (int i = 0; i < 32; ++i) { const int kk = 2 * i + (lane >> 5); scr[kk * 33 + (lane & 31)] = wv[i]; }
    asm volatile("s_waitcnt lgkmcnt(0)" ::: "memory");
    const int c = lane & 7;
#pragma unroll
    for (int j = 0; j < 4; ++j) {
        const int nl = (lane >> 3) + 8 * j, n = n0 + nl;
        const LAS float* s = scr + (8 * c) * 33 + nl;
        u32x4 o; o.x = pk2(s[0 * 33], s[1 * 33]); o.y = pk2(s[2 * 33], s[3 * 33]); o.z = pk2(s[4 * 33], s[5 * 33]); o.w = pk2(s[6 * 33], s[7 * 33]);
#ifdef NT_WSTORE
        if (n < N) { const int dr = rowmap(n); if (NTS) __builtin_nontemporal_store(o, (u32x4*)(WT + (size_t)dr * ldk + koff + k0 + 8 * c)); else *(u32x4*)(WT + (size_t)dr * ldk + koff + k0 + 8 * c) = o; }
#else
        if (n < N) { const int dr = rowmap(n); *(u32x4*)(WT + (size_t)dr * ldk + koff + k0 + 8 * c) = o; }
#endif
    }
    asm volatile("s_waitcnt lgkmcnt(0)" ::: "memory");
}

struct MapId { __device__ __forceinline__ int operator()(int n) const { return n; } };
struct MapWin { __device__ __forceinline__ int operator()(int n) const { return win_newcol(n); } };
struct MapGU { int off; __device__ __forceinline__ int operator()(int n) const { return (n >> 7) * 256 + off + (n & 127); } };

__device__ __forceinline__ void row_to_bf16(const float* xrow, bf16* orow, int lane) {
    const f32x4* xr = (const f32x4*)xrow + lane;
    unsigned long long* o8 = (unsigned long long*)orow + lane;
#pragma unroll
    for (int j = 0; j < 4; ++j) { const f32x4 v = xr[64 * j]; o8[64 * j] = (unsigned long long)pk2(v.x, v.y) | ((unsigned long long)pk2(v.z, v.w) << 32); }
}

__device__ __forceinline__ void phase_prologue(const Params& p, LAS unsigned char* lds) {
    int tid_ = threadIdx.x; asm volatile("" : "+v"(tid_));
    const int tid = tid_, lane = tid & 63, wave = tid >> 6;
    const int gw = blockIdx.x * 8 + wave, NGW = gridDim.x * 8;
    LAS float* scr = (LAS float*)(lds + wave * 16384);
    unsigned char* ws = p.ws;
#ifdef PRO_XFIRST
    bf16* xn = (bf16*)((unsigned char*)p.out + DO_XN);
#ifdef PRO_ROWS
    for (int m = gw; m < T; m += PRO_ROWS * NGW) {
        f32x4 v[PRO_ROWS][4];
#pragma unroll
        for (int r = 0; r < PRO_ROWS; ++r) { const int mr = m + r * NGW; if (mr < T) { const f32x4* xr = (const f32x4*)(p.in[0] + (size_t)mr * DM) + lane;
#pragma unroll
            for (int j = 0; j < 4; ++j) v[r][j] = LD_NT_PRO(xr + 64 * j); } }
#pragma unroll
        for (int r = 0; r < PRO_ROWS; ++r) { const int mr = m + r * NGW; if (mr < T) { unsigned long long* o8 = (unsigned long long*)(xn + (size_t)mr * DM) + lane;
#pragma unroll
            for (int j = 0; j < 4; ++j) o8[64 * j] = (unsigned long long)pk2(v[r][j].x, v[r][j].y) | ((unsigned long long)pk2(v[r][j].z, v[r][j].w) << 32); } }
    }
#else
    for (int m = gw; m < T; m += 4 * NGW) {
        f32x4 v[4][4];
#pragma unroll
        for (int r = 0; r < 4; ++r) { const int mr = m + r * NGW; if (mr < T) { const f32x4* xr = (const f32x4*)(p.in[0] + (size_t)mr * DM) + lane;
#pragma unroll
            for (int j = 0; j < 4; ++j) v[r][j] = LD_NT_PRO(xr + 64 * j); } }
#pragma unroll
        for (int r = 0; r < 4; ++r) { const int mr = m + r * NGW; if (mr < T) { unsigned long long* o8 = (unsigned long long*)(xn + (size_t)mr * DM) + lane;
#pragma unroll
            for (int j = 0; j < 4; ++j) o8[64 * j] = (unsigned long long)pk2(v[r][j].x, v[r][j].y) | ((unsigned long long)pk2(v[r][j].z, v[r][j].w) << 32); } }
    }
#endif
    constexpr int I_WIN = (1024 / 64) * 219, I_WBA = (512 / 64) * 32, I_WBM = 16 * 32, I_WOUT = 16 * 32;
    constexpr int NIT = I_WIN + I_WBA + I_WBM + I_WOUT;
    for (int it = gw; it < NIT; it += NGW) {
        int r = it;
        if (r < I_WIN) { transpose_item(p.in[1], 1024, 6996, (bf16*)(ws + WS_WIN), scr, r, lane, MapWin()); continue; } r -= I_WIN;
        if (r < I_WBA) { transpose_item(p.in[5], 512, 1024, (bf16*)(ws + WS_WBA), scr, r, lane, MapId()); continue; } r -= I_WBA;
        if (r < I_WBM) { transpose_item(p.in[6], 1024, 1024, (bf16*)(ws + WS_WBM), scr, r, lane, MapId()); continue; } r -= I_WBM;
        transpose_item(p.in[7], 1024, 1024, (bf16*)(ws + WS_WOUT), scr, r, lane, MapId());
    }
    {
        const int gt = blockIdx.x * 512 + tid, NGT = gridDim.x * 512;
        bf16* wt = (bf16*)(ws + WS_WIN); float* bp = (float*)(ws + WS_BIAS);
        for (int i = gt; i < 172 * 128; i += NGT) {
            const int pr = i / 128, ch = i % 128; const int row = pr < 4 ? 1860 + pr : 1880 + (pr - 4);
            *(u32x4*)(wt + (size_t)row * 1024 + ch * 8) = (u32x4){0u, 0u, 0u, 0u};
        }
        for (int i = gt; i < 172; i += NGT) { const int row = i < 4 ? 1860 + i : 1880 + (i - 4); bp[row] = 0.f; }
        for (int c = gt; c < 6996; c += NGT) bp[win_newcol(c)] = p.in[2][c];
    }
#else
    constexpr int I_WIN = (1024 / 64) * 219, I_WBA = (512 / 64) * 32, I_WBM = 16 * 32, I_WOUT = 16 * 32;
    constexpr int NIT = I_WIN + I_WBA + I_WBM + I_WOUT;
    for (int it = gw; it < NIT; it += NGW) {
        int r = it;
        if (r < I_WIN) { transpose_item(p.in[1], 1024, 6996, (bf16*)(ws + WS_WIN), scr, r, lane, MapWin()); continue; } r -= I_WIN;
        if (r < I_WBA) { transpose_item(p.in[5], 512, 1024, (bf16*)(ws + WS_WBA), scr, r, lane, MapId()); continue; } r -= I_WBA;
        if (r < I_WBM) { transpose_item(p.in[6], 1024, 1024, (bf16*)(ws + WS_WBM), scr, r, lane, MapId()); continue; } r -= I_WBM;
        transpose_item(p.in[7], 1024, 1024, (bf16*)(ws + WS_WOUT), scr, r, lane, MapId());
    }
    {
        const int gt = blockIdx.x * 512 + tid, NGT = gridDim.x * 512;
        bf16* wt = (bf16*)(ws + WS_WIN); float* bp = (float*)(ws + WS_BIAS);
        for (int i = gt; i < 172 * 128; i += NGT) {
            const int pr = i / 128, ch = i % 128; const int row = pr < 4 ? 1860 + pr : 1880 + (pr - 4);
            *(u32x4*)(wt + (size_t)row * 1024 + ch * 8) = (u32x4){0u, 0u, 0u, 0u};
        }
        for (int i = gt; i < 172; i += NGT) { const int row = i < 4 ? 1860 + i : 1880 + (i - 4); bp[row] = 0.f; }
        for (int c = gt; c < 6996; c += NGT) bp[win_newcol(c)] = p.in[2][c];
    }
    bf16* xn = (bf16*)((unsigned char*)p.out + DO_XN);
#ifdef PRO_ROWS
    for (int m = gw; m < T; m += PRO_ROWS * NGW) {
        f32x4 v[PRO_ROWS][4];
#pragma unroll
        for (int r = 0; r < PRO_ROWS; ++r) { const int mr = m + r * NGW; if (mr < T) { const f32x4* xr = (const f32x4*)(p.in[0] + (size_t)mr * DM) + lane;
#pragma unroll
            for (int j = 0; j < 4; ++j) v[r][j] = LD_NT_PRO(xr + 64 * j); } }
#pragma unroll
        for (int r = 0; r < PRO_ROWS; ++r) { const int mr = m + r * NGW; if (mr < T) { unsigned long long* o8 = (unsigned long long*)(xn + (size_t)mr * DM) + lane;
#pragma unroll
            for (int j = 0; j < 4; ++j) o8[64 * j] = (unsigned long long)pk2(v[r][j].x, v[r][j].y) | ((unsigned long long)pk2(v[r][j].z, v[r][j].w) << 32); } }
    }
#else
    for (int m = gw; m < T; m += 4 * NGW) {
        f32x4 v[4][4];
#pragma unroll
        for (int r = 0; r < 4; ++r) { const int mr = m + r * NGW; if (mr < T) { const f32x4* xr = (const f32x4*)(p.in[0] + (size_t)mr * DM) + lane;
#pragma unroll
            for (int j = 0; j < 4; ++j) v[r][j] = LD_NT_PRO(xr + 64 * j); } }
#pragma unroll
        for (int r = 0; r < 4; ++r) { const int mr = m + r * NGW; if (mr < T) { unsigned long long* o8 = (unsigned long long*)(xn + (size_t)mr * DM) + lane;
#pragma unroll
            for (int j = 0; j < 4; ++j) o8[64 * j] = (unsigned long long)pk2(v[r][j].x, v[r][j].y) | ((unsigned long long)pk2(v[r][j].z, v[r][j].w) << 32); } }
    }
#endif
#endif
}

__device__ __forceinline__ void phase_expert_weights(const Params& p, LAS unsigned char* lds) {
    int tid_ = threadIdx.x; asm volatile("" : "+v"(tid_));
    const int tid = tid_, lane = tid & 63, wave = tid >> 6;
    const int gw = blockIdx.x * 8 + wave, NGW = gridDim.x * 8;
    LAS float* scr = (LAS float*)(lds + wave * 16384);
    constexpr int I_G = 16 * 16, I_D = 8 * 32;
    constexpr int NIT = 16 * (2 * I_G + I_D);
    for (int it = gw; it < NIT; it += NGW) {
        const int e = it / (2 * I_G + I_D); int r = it % (2 * I_G + I_D);
        bf16* wgu = (bf16*)(p.ws + WS_WGU) + (size_t)e * 1024 * 1024;
        if (r < I_G) { transpose_item<MapGU, true>(p.in[14] + (size_t)e * 1024 * 512, 1024, 512, wgu, scr, r, lane, MapGU{0}); continue; } r -= I_G;
        if (r < I_G) { transpose_item<MapGU, true>(p.in[15] + (size_t)e * 1024 * 512, 1024, 512, wgu, scr, r, lane, MapGU{128}); continue; } r -= I_G;
        transpose_item<MapId, true>(p.in[16] + (size_t)e * 512 * 1024, 512, 1024, (bf16*)(p.ws + WS_WD) + (size_t)e * 1024 * 512, scr, r, lane, MapId());
    }
}

__device__ __forceinline__ void rope_cs(const LAS float* linv, int t, int d0, f32x4& c4, f32x4& s4) {
    const f32x4 fr4 = *(const LAS f32x4*)(linv + d0); const float tf = (float)t;
#pragma unroll
    for (int i = 0; i < 4; ++i) { const float rev = __builtin_amdgcn_fractf(tf * fr4[i]); c4[i] = __builtin_amdgcn_cosf(rev); s4[i] = __builtin_amdgcn_sinf(rev); }
}
struct EpiInProj {
    static constexpr bool PERM = true, AFTER_DRAIN = false;
    unsigned char* ws; unsigned char* dout; const LAS bf16* lbias; const LAS float* linv;
    __device__ __forceinline__ void operator()(const f32x4 (&acc)[2][2][4][2], const pg8::Unit& u, int wr, int wc, int fr, int fq) const {
        const int pn = u.pn;
        const int row0 = u.pm * 256 + wr * 64 + fr;
        const int cl0 = wc * 32 + 8 * fq;
        f32x4 bv[2][2];
#pragma unroll
        for (int bj = 0; bj < 2; ++bj) { const u32x4 bw = *(const LAS u32x4*)(lbias + pn * 256 + cl0 + bj * 128);
            bv[bj][0] = (f32x4){__uint_as_float(bw.x << 16), __uint_as_float(bw.x & 0xffff0000u), __uint_as_float(bw.y << 16), __uint_as_float(bw.y & 0xffff0000u)};
            bv[bj][1] = (f32x4){__uint_as_float(bw.z << 16), __uint_as_float(bw.z & 0xffff0000u), __uint_as_float(bw.w << 16), __uint_as_float(bw.w & 0xffff0000u)}; }
        int cat; bf16* dst = nullptr; int ld = 0, cb = 0; float sc = 1.f;
        if (pn < 2)       { cat = 0; dst = (bf16*)(ws + WS_AQ); ld = 512; cb = pn * 256; sc = QSCALE2; }
        else if (pn < 4)  { cat = 0; dst = (bf16*)(ws + WS_AK); ld = 512; cb = (pn - 2) * 256; }
        else if (pn < 6)  { cat = 1; dst = (bf16*)(ws + WS_AV); ld = 512; cb = (pn - 4) * 256; }
        else if (pn == 6) { cat = 0; dst = (bf16*)(ws + WS_IQ); ld = 256; cb = 0; sc = IDX_QSCALE; }
        else if (pn == 7) { cat = 3; }
        else if (pn < 10) { cat = 1; dst = (bf16*)(ws + WS_MQ); ld = 512; cb = (pn - 8) * 256; }
        else if (pn < 12) { cat = 1; dst = (bf16*)(ws + WS_MK); ld = 512; cb = (pn - 10) * 256; }
        else if (pn < 16) { cat = 1; dst = (bf16*)(ws + WS_MV); ld = 1024; cb = (pn - 12) * 256; }
        else if (pn < 20) { cat = 2; dst = (bf16*)(ws + WS_MO); ld = 1024; cb = (pn - 16) * 256; }
        else if (pn < 24) { cat = 2; dst = (bf16*)(ws + WS_GA); ld = 1024; cb = (pn - 20) * 256; }
        else              { cat = 2; dst = (bf16*)(dout + DO_GM); ld = 1024; cb = (pn - 24) * 256; }
#pragma unroll
        for (int ai = 0; ai < 2; ++ai)
#pragma unroll
            for (int m = 0; m < 4; ++m) {
                const int row = row0 + ai * 128 + m * 16;
                const int t = row & (SEQ - 1);
#pragma unroll
                for (int bj = 0; bj < 2; ++bj) {
                    f32x4 v0 = acc[ai][bj][m][0] + bv[bj][0], v1 = acc[ai][bj][m][1] + bv[bj][1];
                    const int cl = cl0 + bj * 128;
                    if (cat == 3) {
                        if (cl < 64) {
                            const int d0 = cl >> 1;
                            f32x4 c4, s4; rope_cs(linv, t, d0, c4, s4);
                            u32x4 w;
                            w.x = pk2(v0[0] * c4[0] - v0[1] * s4[0], v0[0] * s4[0] + v0[1] * c4[0]);
                            w.y = pk2(v0[2] * c4[1] - v0[3] * s4[1], v0[2] * s4[1] + v0[3] * c4[1]);
                            w.z = pk2(v1[0] * c4[2] - v1[1] * s4[2], v1[0] * s4[2] + v1[1] * c4[2]);
                            w.w = pk2(v1[2] * c4[3] - v1[3] * s4[3], v1[2] * s4[3] + v1[3] * c4[3]);
                            *(u32x4*)((bf16*)(ws + WS_IK) + (size_t)row * 64 + cl) = w;
                        } else if (cl == 64) {
                            *(f32x4*)((float*)(ws + WS_IW) + (size_t)row * 4) = v0 * (0.0625f * IDX_WSCALE);
                        } else if (cl == 72) {
                            float* d = (float*)(ws + WS_MI) + (size_t)row * 8; *(f32x4*)d = v0; *(f32x4*)(d + 4) = v1;
                        } else if (cl == 80) {
                            float* d = (float*)(ws + WS_MF) + (size_t)row * 8; *(f32x4*)d = v0; *(f32x4*)(d + 4) = v1;
                        }
                    } else {
                        u32x4 w;
                        if (cat == 0) {
                            const int d0 = (cl & 63) >> 1;
                            f32x4 c4, s4; rope_cs(linv, t, d0, c4, s4);
                            w.x = pk2((v0[0] * c4[0] - v0[1] * s4[0]) * sc, (v0[0] * s4[0] + v0[1] * c4[0]) * sc);
                            w.y = pk2((v0[2] * c4[1] - v0[3] * s4[1]) * sc, (v0[2] * s4[1] + v0[3] * c4[1]) * sc);
                            w.z = pk2((v1[0] * c4[2] - v1[1] * s4[2]) * sc, (v1[0] * s4[2] + v1[1] * c4[2]) * sc);
                            w.w = pk2((v1[2] * c4[3] - v1[3] * s4[3]) * sc, (v1[2] * s4[3] + v1[3] * c4[3]) * sc);
                        } else if (cat == 1) {
                            w.x = pk2(v0[0], v0[1]); w.y = pk2(v0[2], v0[3]); w.z = pk2(v1[0], v1[1]); w.w = pk2(v1[2], v1[3]);
                        } else {
                            w.x = pk2(sigmoidf_(v0[0]), sigmoidf_(v0[1])); w.y = pk2(sigmoidf_(v0[2]), sigmoidf_(v0[3]));
                            w.z = pk2(sigmoidf_(v1[0]), sigmoidf_(v1[1])); w.w = pk2(sigmoidf_(v1[2]), sigmoidf_(v1[3]));
                        }
#ifdef NT_INP_LATE
                        if (pn >= NT_INP_LATE) ST_NT((u32x4*)(dst + (size_t)row * ld + cb + cl), w); else *(u32x4*)(dst + (size_t)row * ld + cb + cl) = w;
#else
                        ST_NT((u32x4*)(dst + (size_t)row * ld + cb + cl), w);
#endif
                    }
                }
            }
    }
};

constexpr int INP_LBIAS = 131072, INP_LINV = 131072 + 14336;
__device__ __forceinline__ void phase_inproj(const Params& p, LAS unsigned char* lds) {
    {
        LAS bf16* lb = (LAS bf16*)(lds + INP_LBIAS); LAS float* li = (LAS float*)(lds + INP_LINV);
        const float* bp = (const float*)(p.ws + WS_BIAS);
        int tl_ = threadIdx.x; asm volatile("" : "+v"(tl_));
        for (int i = tl_; i < NW_IN; i += 512) lb[i] = (bf16)f2bf(bp[i]);
        if (tl_ < 32) li[tl_] = (float)(pow(10000.0, -(double)tl_ / 32.0)) * 0.15915494309189535f;
        __syncthreads();
    }
    pg8::Gemm g{(const bf16*)((unsigned char*)p.out + DO_XN), (const bf16*)(p.ws + WS_WIN), T, NW_IN, 1024};
    pg8::StaticOrder S; S.init(T, NW_IN, gridDim.x, (int)blockIdx.x);
    EpiInProj E{p.ws, (unsigned char*)p.out, (const LAS bf16*)(lds + INP_LBIAS), (const LAS float*)(lds + INP_LINV)};
#ifndef INP_ALIGN
#define INP_ALIGN true
#endif
#ifndef INP_SP2
#define INP_SP2 true
#endif
    pg8::gemm_phase<EpiInProj, pg8::StaticOrder, INP_ALIGN, INP_SP2>(lds, g, S, E);
}

struct EpiDummy {
    static constexpr bool PERM = true, AFTER_DRAIN = false;
    bf16* O;
    __device__ __forceinline__ void operator()(const f32x4 (&acc)[2][2][4][2], const pg8::Unit& u, int wr, int wc, int fr, int fq) const {
        const int row0 = u.pm * 256 + wr * 64 + fr, col0 = wc * 32 + 8 * fq;
#pragma unroll
        for (int ai = 0; ai < 2; ++ai)
#pragma unroll
            for (int m = 0; m < 4; ++m)
#pragma unroll
                for (int bj = 0; bj < 2; ++bj) {
                    const f32x4 v0 = acc[ai][bj][m][0], v1 = acc[ai][bj][m][1];
                    u32x4 w; w.x = pk2(v0[0], v0[1]); w.y = pk2(v0[2], v0[3]); w.z = pk2(v1[0], v1[1]); w.w = pk2(v1[2], v1[3]);
                    *(u32x4*)(O + (size_t)(row0 + ai * 128 + m * 16) * 256 + col0 + bj * 128) = w;
                }
    }
};
__device__ __forceinline__ void phase_inproj_dummy(const Params& p, LAS unsigned char* lds) {
    pg8::Gemm g{(const bf16*)((unsigned char*)p.out + DO_XN), (const bf16*)(p.ws + WS_WIN), T, NW_IN, 1024};
    pg8::StaticOrder S; S.init(T, NW_IN, gridDim.x, (int)blockIdx.x);
    EpiDummy E{(bf16*)(p.ws + WS_MASK)};
    pg8::gemm_phase<EpiDummy, pg8::StaticOrder, true, true>(lds, g, S, E);
}

typedef float f32x16 __attribute__((ext_vector_type(16)));
struct IdxQ { bf16x8 qf[4][4]; float w[4]; };
__device__ __forceinline__ float relu_f(float x) { const int b = __float_as_int(x); return __int_as_float(b & ~(b >> 31)); }

__device__ __forceinline__ void idx_loadk(const bf16* IK, size_t keytok0, int lane, bf16x8 (&kf)[4]) {
    const bf16* kp = IK + (keytok0 + (lane & 31)) * 64 + 8 * (lane >> 5);
#pragma unroll
    for (int ks = 0; ks < 4; ++ks) kf[ks] = *(const bf16x8*)(kp + ks * 16);
}
#define IDX_RP(i_) "v_pk_mul_f32 %[t" #i_ "], %[a" #i_ "], 1.0 op_sel_hi:[1,0] clamp\n\tv_pk_fma_f32 %[s" #i_ "], %[w], %[t" #i_ "], %[s" #i_ "]\n\t"
template <int ACCM = 0> __device__ __forceinline__ void idx_scores2(const bf16x8 (&kf)[4], const IdxQ& Q, f32x2 (&sc)[8]) {
#pragma unroll
    for (int i = 0; i < 8; ++i) sc[i] = (f32x2){0.f, 0.f};
#ifdef IDX_SGB
    if (ACCM == IDX_SGB) {
        f32x16 ac[2];
        const f32x16 z16 = {0.f, 0.f, 0.f, 0.f, 0.f, 0.f, 0.f, 0.f, 0.f, 0.f, 0.f, 0.f, 0.f, 0.f, 0.f, 0.f};
        ac[0] = z16;
#pragma unroll
        for (int ks = 0; ks < 4; ++ks) ac[0] = __builtin_amdgcn_mfma_f32_32x32x16_bf16(kf[ks], Q.qf[0][ks], ac[0], 0, 0, 0);
#pragma unroll
        for (int h = 0; h < 4; ++h) {
            if (h < 3) { ac[(h + 1) & 1] = z16;
#pragma unroll
                for (int ks = 0; ks < 4; ++ks) ac[(h + 1) & 1] = __builtin_amdgcn_mfma_f32_32x32x16_bf16(kf[ks], Q.qf[h + 1][ks], ac[(h + 1) & 1], 0, 0, 0); }
            const f32x2 w2 = {Q.w[h], Q.w[h]};
#pragma unroll
            for (int i = 0; i < 8; ++i) { const f32x2 rl = {relu_f(ac[h & 1][2 * i]), relu_f(ac[h & 1][2 * i + 1])}; sc[i] = __builtin_elementwise_fma(w2, rl, sc[i]); }
        }
        __builtin_amdgcn_sched_group_barrier(0x8, 4, 0);
#pragma unroll
        for (int g = 0; g < 12; ++g) { __builtin_amdgcn_sched_group_barrier(0x8, 1, 0); __builtin_amdgcn_sched_group_barrier(0x2, 6, 0); }
        __builtin_amdgcn_sched_group_barrier(0x2, 24, 0);
        return;
    }
#endif
#ifndef IDX_ACC4_SB
#define IDX_ACC4_SB __builtin_amdgcn_sched_barrier(0)
#endif
#if defined(IDX_ACC2) || defined(IDX_ACC2_P1) || defined(IDX_ACC2_P2)
    if (ACCM == 2) {
#pragma unroll
        for (int hp = 0; hp < 4; hp += 2) {
            f32x16 a0 = {0.f, 0.f, 0.f, 0.f, 0.f, 0.f, 0.f, 0.f, 0.f, 0.f, 0.f, 0.f, 0.f, 0.f, 0.f, 0.f}, a1 = a0;
#pragma unroll
            for (int ks = 0; ks < 4; ++ks) { a0 = __builtin_amdgcn_mfma_f32_32x32x16_bf16(kf[ks], Q.qf[hp][ks], a0, 0, 0, 0); a1 = __builtin_amdgcn_mfma_f32_32x32x16_bf16(kf[ks], Q.qf[hp + 1][ks], a1, 0, 0, 0); }
            const f32x2 w0 = {Q.w[hp], Q.w[hp]}, w1 = {Q.w[hp + 1], Q.w[hp + 1]};
#pragma unroll
            for (int i = 0; i < 8; ++i) { const f32x2 r0 = {relu_f(a0[2 * i]), relu_f(a0[2 * i + 1])}; sc[i] = __builtin_elementwise_fma(w0, r0, sc[i]); }
#pragma unroll
            for (int i = 0; i < 8; ++i) { const f32x2 r1 = {relu_f(a1[2 * i]), relu_f(a1[2 * i + 1])}; sc[i] = __builtin_elementwise_fma(w1, r1, sc[i]); }
        }
        return;
    }
#endif
#ifdef IDX_ACC4
    if (ACCM == 4) {
        f32x16 a4[4];
#pragma unroll
        for (int h = 0; h < 4; ++h) a4[h] = (f32x16){0.f, 0.f, 0.f, 0.f, 0.f, 0.f, 0.f, 0.f, 0.f, 0.f, 0.f, 0.f, 0.f, 0.f, 0.f, 0.f};
#pragma unroll
        for (int ks = 0; ks < 4; ++ks)
#pragma unroll
            for (int h = 0; h < 4; ++h) a4[h] = __builtin_amdgcn_mfma_f32_32x32x16_bf16(kf[ks], Q.qf[h][ks], a4[h], 0, 0, 0);
        IDX_ACC4_SB;
#pragma unroll
        for (int h = 0; h < 4; ++h) { const f32x2 w2 = {Q.w[h], Q.w[h]};
#pragma unroll
            for (int i = 0; i < 8; ++i) { const f32x2 rl = {relu_f(a4[h][2 * i]), relu_f(a4[h][2 * i + 1])}; sc[i] = __builtin_elementwise_fma(w2, rl, sc[i]); } }
        return;
    }
#endif
#pragma unroll
    for (int h = 0; h < 4; ++h) {
        f32x16 acc = {0.f, 0.f, 0.f, 0.f, 0.f, 0.f, 0.f, 0.f, 0.f, 0.f, 0.f, 0.f, 0.f, 0.f, 0.f, 0.f};
#ifdef IDX_SETPRIO
        __builtin_amdgcn_s_setprio(1);
#endif
#pragma unroll
        for (int ks = 0; ks < 4; ++ks) acc = __builtin_amdgcn_mfma_f32_32x32x16_bf16(kf[ks], Q.qf[h][ks], acc, 0, 0, 0);
#ifdef IDX_SETPRIO
        __builtin_amdgcn_s_setprio(0);
#endif
        const f32x2 w2 = {Q.w[h], Q.w[h]};
#ifdef IDX_NOCLAMP
#ifdef IDX_RELU_FIRST
        {
            f32x16 rl;
#pragma unroll
            for (int i = 0; i < 16; ++i) rl[i] = relu_f(acc[i]);
            asm volatile("" : "+v"(rl));
#pragma unroll
            for (int i = 0; i < 8; ++i) { const f32x2 r2 = {rl[2 * i], rl[2 * i + 1]}; sc[i] = __builtin_elementwise_fma(w2, r2, sc[i]); }
        }
#else
#pragma unroll
        for (int i = 0; i < 8; ++i) { const f32x2 rl = {relu_f(acc[2 * i]), relu_f(acc[2 * i + 1])}; sc[i] = __builtin_elementwise_fma(w2, rl, sc[i]); }
#endif
#else
        { const f32x2 rl = {relu_f(acc[0]), relu_f(acc[1])}; sc[0] = __builtin_elementwise_fma(w2, rl, sc[0]); }
        const f32x2 a1 = {acc[2], acc[3]}, a2 = {acc[4], acc[5]}, a3 = {acc[6], acc[7]}, a4 = {acc[8], acc[9]}, a5 = {acc[10], acc[11]}, a6 = {acc[12], acc[13]}, a7 = {acc[14], acc[15]};
        f32x2 t1, t2, t3, t4, t5, t6, t7;
        asm(IDX_RP(1) IDX_RP(2) IDX_RP(3) IDX_RP(4) IDX_RP(5) IDX_RP(6) IDX_RP(7)
            : [s1] "+v"(sc[1]), [s2] "+v"(sc[2]), [s3] "+v"(sc[3]), [s4] "+v"(sc[4]), [s5] "+v"(sc[5]), [s6] "+v"(sc[6]), [s7] "+v"(sc[7]),
              [t1] "=&v"(t1), [t2] "=&v"(t2), [t3] "=&v"(t3), [t4] "=&v"(t4), [t5] "=&v"(t5), [t6] "=&v"(t6), [t7] "=&v"(t7)
            : [a1] "v"(a1), [a2] "v"(a2), [a3] "v"(a3), [a4] "v"(a4), [a5] "v"(a5), [a6] "v"(a6), [a7] "v"(a7), [w] "v"(w2), [dep] "v"(sc[0]));
#endif
    }
}
#undef IDX_RP
#ifdef IDX_CB_SUB
#define IDX_SA(n1_, n0_) "v_sub_f32_e32 %4, %" #n1_ ", %24\n\tv_sub_f32_e32 %5, %" #n0_ ", %24\n\tv_sub_f32_e32 %6, %" #n1_ ", %25\n\tv_sub_f32_e32 %7, %" #n0_ ", %25\n\t" \
    "v_alignbit_b32 %0, %0, %4, 31\n\tv_alignbit_b32 %1, %1, %5, 31\n\tv_alignbit_b32 %2, %2, %6, 31\n\tv_alignbit_b32 %3, %3, %7, 31\n\t"
__device__ __forceinline__ void idx_cmpbits(const f32x2 (&sc)[8], float fH, float fL, unsigned& mh, unsigned& ml) {
    unsigned ah = 0u, al = 0u, bh = 0u, bl = 0u, t0, t1, t2, t3;
    asm(IDX_SA(23, 15) IDX_SA(22, 14) IDX_SA(21, 13) IDX_SA(20, 12) IDX_SA(19, 11) IDX_SA(18, 10) IDX_SA(17, 9) IDX_SA(16, 8)
        : "+v"(ah), "+v"(al), "+v"(bh), "+v"(bl), "=&v"(t0), "=&v"(t1), "=&v"(t2), "=&v"(t3)
        : "v"(sc[0][0]), "v"(sc[0][1]), "v"(sc[1][0]), "v"(sc[1][1]), "v"(sc[2][0]), "v"(sc[2][1]), "v"(sc[3][0]), "v"(sc[3][1]),
          "v"(sc[4][0]), "v"(sc[4][1]), "v"(sc[5][0]), "v"(sc[5][1]), "v"(sc[6][0]), "v"(sc[6][1]), "v"(sc[7][0]), "v"(sc[7][1]), "v"(fH), "v"(fL));
    mh = ~((ah << 8) | al) & 0xFFFFu; ml = ~((bh << 8) | bl) & 0xFFFFu;
}
#undef IDX_SA
#elif defined(IDX_CB_IL)
#define IDX_CB2(n_, m_) "v_cmp_ge_f32_e64 %2, %" #n_ ", %22\n\tv_cmp_ge_f32_e64 %3, %" #n_ ", %23\n\tv_cmp_ge_f32_e64 %4, %" #m_ ", %22\n\tv_cmp_ge_f32_e64 %5, %" #m_ ", %23\n\t" \
    "v_addc_co_u32_e64 %0, %2, %0, %0, %2\n\tv_addc_co_u32_e64 %1, %3, %1, %1, %3\n\tv_addc_co_u32_e64 %0, %4, %0, %0, %4\n\tv_addc_co_u32_e64 %1, %5, %1, %1, %5\n\t"
__device__ __forceinline__ void idx_cmpbits(const f32x2 (&sc)[8], float fH, float fL, unsigned& mh, unsigned& ml) {
    unsigned a = 0u, b = 0u; unsigned long long s0, s1, s2, s3;
    asm(IDX_CB2(21, 20) IDX_CB2(19, 18) IDX_CB2(17, 16) IDX_CB2(15, 14) IDX_CB2(13, 12) IDX_CB2(11, 10) IDX_CB2(9, 8) IDX_CB2(7, 6)
        : "+v"(a), "+v"(b), "=&s"(s0), "=&s"(s1), "=&s"(s2), "=&s"(s3)
        : "v"(sc[0][0]), "v"(sc[0][1]), "v"(sc[1][0]), "v"(sc[1][1]), "v"(sc[2][0]), "v"(sc[2][1]), "v"(sc[3][0]), "v"(sc[3][1]),
          "v"(sc[4][0]), "v"(sc[4][1]), "v"(sc[5][0]), "v"(sc[5][1]), "v"(sc[6][0]), "v"(sc[6][1]), "v"(sc[7][0]), "v"(sc[7][1]), "v"(fH), "v"(fL)
        : "vcc");
    mh = a; ml = b;
}
#undef IDX_CB2
#else
#define IDX_CB(n_) "v_cmp_ge_f32_e32 vcc, %" #n_ ", %18\n\tv_addc_co_u32_e32 %0, vcc, %0, %0, vcc\n\tv_cmp_ge_f32_e32 vcc, %" #n_ ", %19\n\tv_addc_co_u32_e32 %1, vcc, %1, %1, vcc\n\t"
__device__ __forceinline__ void idx_cmpbits(const f32x2 (&sc)[8], float fH, float fL, unsigned& mh, unsigned& ml) {
    unsigned a = 0u, b = 0u;
    asm(IDX_CB(17) IDX_CB(16) IDX_CB(15) IDX_CB(14) IDX_CB(13) IDX_CB(12) IDX_CB(11) IDX_CB(10) IDX_CB(9) IDX_CB(8) IDX_CB(7) IDX_CB(6) IDX_CB(5) IDX_CB(4) IDX_CB(3) IDX_CB(2)
        : "+v"(a), "+v"(b)
        : "v"(sc[0][0]), "v"(sc[0][1]), "v"(sc[1][0]), "v"(sc[1][1]), "v"(sc[2][0]), "v"(sc[2][1]), "v"(sc[3][0]), "v"(sc[3][1]),
          "v"(sc[4][0]), "v"(sc[4][1]), "v"(sc[5][0]), "v"(sc[5][1]), "v"(sc[6][0]), "v"(sc[6][1]), "v"(sc[7][0]), "v"(sc[7][1]), "v"(fH), "v"(fL)
        : "vcc");
    mh = a; ml = b;
}
#undef IDX_CB
#endif

constexpr int IDX_HIST = 0, IDX_THR = 131072, IDX_NEED = 131072 + 128, IDX_CCNT = 131072 + 256, IDX_SEG = 131072 + 384, IDX_THRH = 131072 + 384 + 4096, IDX_LO = IDX_THRH + 128, IDX_SI = IDX_LO + 128, IDX_FLAG = IDX_SI + 128;
constexpr int IDX_BASE = 107 << 23;
constexpr int IDX_TOP = IDX_BASE + (1024 << 18) - 1;

__device__ __forceinline__ void idx_mfma4(const bf16x8 (&kf)[4], const IdxQ& Q, f32x16 (&a4)[4]) {
#pragma unroll
    for (int h = 0; h < 4; ++h) a4[h] = (f32x16){0.f, 0.f, 0.f, 0.f, 0.f, 0.f, 0.f, 0.f, 0.f, 0.f, 0.f, 0.f, 0.f, 0.f, 0.f, 0.f};
#pragma unroll
    for (int ks = 0; ks < 4; ++ks)
#pragma unroll
        for (int h = 0; h < 4; ++h) a4[h] = __builtin_amdgcn_mfma_f32_32x32x16_bf16(kf[ks], Q.qf[h][ks], a4[h], 0, 0, 0);
}
__device__ __forceinline__ void idx_finish4(const f32x16 (&a4)[4], const IdxQ& Q, f32x2 (&sc)[8]) {
#pragma unroll
    for (int i = 0; i < 8; ++i) sc[i] = (f32x2){0.f, 0.f};
#pragma unroll
    for (int h = 0; h < 4; ++h) { const f32x2 w2 = {Q.w[h], Q.w[h]};
#pragma unroll
        for (int i = 0; i < 8; ++i) { const f32x2 rl = {relu_f(a4[h][2 * i]), relu_f(a4[h][2 * i + 1])}; sc[i] = __builtin_elementwise_fma(w2, rl, sc[i]); } }
}
__device__ __forceinline__ f32x16 idx_chain0(const bf16x8 (&kf)[4], const IdxQ& Q) {
    f32x16 a = {0.f, 0.f, 0.f, 0.f, 0.f, 0.f, 0.f, 0.f, 0.f, 0.f, 0.f, 0.f, 0.f, 0.f, 0.f, 0.f};
#pragma unroll
    for (int ks = 0; ks < 4; ++ks) a = __builtin_amdgcn_mfma_f32_32x32x16_bf16(kf[ks], Q.qf[0][ks], a, 0, 0, 0);
    return a;
}
__device__ __forceinline__ void idx_finish_pre(const bf16x8 (&kf)[4], const IdxQ& Q, f32x16 a0, f32x2 (&sc)[8]) {
    const f32x16 z16 = {0.f, 0.f, 0.f, 0.f, 0.f, 0.f, 0.f, 0.f, 0.f, 0.f, 0.f, 0.f, 0.f, 0.f, 0.f, 0.f};
    f32x16 ac[2]; ac[0] = a0;
#pragma unroll
    for (int i = 0; i < 8; ++i) sc[i] = (f32x2){0.f, 0.f};
#pragma unroll
    for (int h = 0; h < 4; ++h) {
        if (h < 3) { ac[(h + 1) & 1] = z16;
#pragma unroll
            for (int ks = 0; ks < 4; ++ks) ac[(h + 1) & 1] = __builtin_amdgcn_mfma_f32_32x32x16_bf16(kf[ks], Q.qf[h + 1][ks], ac[(h + 1) & 1], 0, 0, 0); }
        const f32x2 w2 = {Q.w[h], Q.w[h]};
#pragma unroll
        for (int i = 0; i < 8; ++i) { const f32x2 rl = {relu_f(ac[h & 1][2 * i]), relu_f(ac[h & 1][2 * i + 1])}; sc[i] = __builtin_elementwise_fma(w2, rl, sc[i]); }
    }
#pragma unroll
    for (int g = 0; g < 12; ++g) { __builtin_amdgcn_sched_group_barrier(0x8, 1, 0); __builtin_amdgcn_sched_group_barrier(0x2, 6, 0); }
    __builtin_amdgcn_sched_group_barrier(0x2, 24, 0);
}
template <bool FINE> __device__ __forceinline__ void idx_hadd(LAS unsigned char* histb, unsigned bb, int cF, unsigned q4) {
    if (FINE) {
        const int m = min(max((int)(bb & 0x7FFFFFFFu), IDX_BASE), IDX_TOP);
        const unsigned a = (((unsigned)m >> 18) << 7) + (unsigned)cF;
        __hip_atomic_fetch_add((LAS unsigned*)a, ((int)bb < 0) ? 65536u : 1u, __ATOMIC_RELAXED, __HIP_MEMORY_SCOPE_WORKGROUP);
    } else {
        __hip_atomic_fetch_add((LAS unsigned*)(histb + (((bb >> 14) & 0x1FF80u) | q4)), ((int)bb < 0) ? 65536u : 1u, __ATOMIC_RELAXED, __HIP_MEMORY_SCOPE_WORKGROUP);
    }
}

#ifdef IDX_H_IL
#define IDX_H2(n_, m_) "v_med3_f32 %0, |%" #n_ "|, %21, %22\n\tv_med3_f32 %2, |%" #m_ "|, %21, %22\n\tv_bfe_u32 %1, %" #n_ ", 31, 1\n\tv_bfe_u32 %3, %" #m_ ", 31, 1\n\t" \
    "v_bfe_u32 %0, %0, 18, 14\n\tv_bfe_u32 %2, %2, 18, 14\n\tv_mad_u32_u24 %1, %1, %24, 1\n\tv_mad_u32_u24 %3, %3, %24, 1\n\t" \
    "v_lshl_add_u32 %0, %0, 7, %23\n\tv_lshl_add_u32 %2, %2, 7, %23\n\tds_add_u32 %0, %1\n\tds_add_u32 %2, %3\n\t"
__device__ __forceinline__ void idx_hist16_fine(const f32x2 (&sc)[8], int cF) {
    unsigned t0, t1, t2, t3; const float lo = __int_as_float(IDX_BASE), hi = __int_as_float(IDX_TOP); const int c16 = 65535;
    asm volatile(IDX_H2(4, 5) IDX_H2(6, 7) IDX_H2(8, 9) IDX_H2(10, 11) IDX_H2(12, 13) IDX_H2(14, 15) IDX_H2(16, 17) IDX_H2(18, 19)
        : "=&v"(t0), "=&v"(t1), "=&v"(t2), "=&v"(t3)
        : "v"(sc[0][0]), "v"(sc[0][1]), "v"(sc[1][0]), "v"(sc[1][1]), "v"(sc[2][0]), "v"(sc[2][1]), "v"(sc[3][0]), "v"(sc[3][1]),
          "v"(sc[4][0]), "v"(sc[4][1]), "v"(sc[5][0]), "v"(sc[5][1]), "v"(sc[6][0]), "v"(sc[6][1]), "v"(sc[7][0]), "v"(sc[7][1]),
          "v"(0), "v"(lo), "v"(hi), "v"(cF), "v"(c16)
        : "memory");
}
#undef IDX_H2
#else
#define IDX_H1(n_, A_, B_) "v_med3_f32 %" #A_ ", |%" #n_ "|, %21, %22\n\tv_bfe_u32 %" #B_ ", %" #n_ ", 31, 1\n\tv_bfe_u32 %" #A_ ", %" #A_ ", 18, 14\n\tv_mad_u32_u24 %" #B_ ", %" #B_ ", %24, 1\n\tv_lshl_add_u32 %" #A_ ", %" #A_ ", 7, %23\n\tds_add_u32 %" #A_ ", %" #B_ "\n\t"
__device__ __forceinline__ void idx_hist16_fine(const f32x2 (&sc)[8], int cF) {
    unsigned t0, t1, t2, t3; const float lo = __int_as_float(IDX_BASE), hi = __int_as_float(IDX_TOP); const int c16 = 65535;
    asm volatile(IDX_H1(4, 0, 1) IDX_H1(5, 2, 3) IDX_H1(6, 0, 1) IDX_H1(7, 2, 3) IDX_H1(8, 0, 1) IDX_H1(9, 2, 3) IDX_H1(10, 0, 1) IDX_H1(11, 2, 3)
                 IDX_H1(12, 0, 1) IDX_H1(13, 2, 3) IDX_H1(14, 0, 1) IDX_H1(15, 2, 3) IDX_H1(16, 0, 1) IDX_H1(17, 2, 3) IDX_H1(18, 0, 1) IDX_H1(19, 2, 3)
        : "=&v"(t0), "=&v"(t1), "=&v"(t2), "=&v"(t3)
        : "v"(sc[0][0]), "v"(sc[0][1]), "v"(sc[1][0]), "v"(sc[1][1]), "v"(sc[2][0]), "v"(sc[2][1]), "v"(sc[3][0]), "v"(sc[3][1]),
          "v"(sc[4][0]), "v"(sc[4][1]), "v"(sc[5][0]), "v"(sc[5][1]), "v"(sc[6][0]), "v"(sc[6][1]), "v"(sc[7][0]), "v"(sc[7][1]),
          "v"(0), "v"(lo), "v"(hi), "v"(cF), "v"(c16)
        : "memory");
}
#undef IDX_H1
#endif
template <bool FINE> __device__ __forceinline__ void idx_pass1(const bf16* IK, size_t tokb, const IdxQ& Q, LAS unsigned char* histb, int qg, int ntl, int wave, int lane, int t) {
    const int q = lane & 31, hi = lane >> 5;
    const int cF = (int)(unsigned)(size_t)histb + 4 * q - ((IDX_BASE >> 18) << 7); const unsigned q4 = (unsigned)(4 * q);
#ifdef IDX_KPF_HALF
    bf16x8 kn0[4];
    { const int t0 = min(wave, ntl - 1); idx_loadk(IK, tokb + (size_t)t0 * 64, lane, kn0); }
#else
#if defined(IDX_KPF) && !defined(IDX_NOKPF1)
    bf16x8 kn[2][4];
    { const int t0 = min(wave, ntl - 1); idx_loadk(IK, tokb + (size_t)t0 * 64, lane, kn[0]); idx_loadk(IK, tokb + (size_t)t0 * 64 + 32, lane, kn[1]); }
#endif
#endif
#pragma unroll 1
    for (int tile = wave; tile < ntl; tile += 8) {
        bf16x8 kt[2][4];
#ifdef IDX_KPF_HALF
#pragma unroll
        for (int i = 0; i < 4; ++i) kt[0][i] = kn0[i];
        if (2 * tile + 1 <= qg) idx_loadk(IK, tokb + (size_t)tile * 64 + 32, lane, kt[1]);
        { const int t1 = min(tile + 8, ntl - 1); idx_loadk(IK, tokb + (size_t)t1 * 64, lane, kn0); }
#else
#if defined(IDX_KPF) && !defined(IDX_NOKPF1)
#pragma unroll
        for (int i = 0; i < 4; ++i) { kt[0][i] = kn[0][i]; kt[1][i] = kn[1][i]; }
        { const int t1 = min(tile + 8, ntl - 1); idx_loadk(IK, tokb + (size_t)t1 * 64, lane, kn[0]); idx_loadk(IK, tokb + (size_t)t1 * 64 + 32, lane, kn[1]); }
#else
        idx_loadk(IK, tokb + (size_t)tile * 64, lane, kt[0]);
        if (2 * tile + 1 <= qg) idx_loadk(IK, tokb + (size_t)tile * 64 + 32, lane, kt[1]);
#endif
#endif
#ifdef IDX_P1_DP
        if (FINE && 2 * tile + 1 < qg) {
            f32x2 s0[8], s1[8];
            f32x16 a0 = idx_chain0(kt[0], Q);
            idx_finish_pre(kt[0], Q, a0, s0);
            a0 = idx_chain0(kt[1], Q);
            __builtin_amdgcn_sched_barrier(0);
            idx_hist16_fine(s0, cF);
            idx_finish_pre(kt[1], Q, a0, s1);
            idx_hist16_fine(s1, cF);
            continue;
        }
#endif
#ifdef IDX_P1_PIPE
        if (FINE && 2 * tile + 1 < qg) {
            f32x2 s0[8], s1[8];
            idx_scores2(kt[0], Q, s0);
            f32x16 b0 = {0.f, 0.f, 0.f, 0.f, 0.f, 0.f, 0.f, 0.f, 0.f, 0.f, 0.f, 0.f, 0.f, 0.f, 0.f, 0.f}, b1 = b0;
#pragma unroll
            for (int ks = 0; ks < 4; ++ks) { b0 = __builtin_amdgcn_mfma_f32_32x32x16_bf16(kt[1][ks], Q.qf[0][ks], b0, 0, 0, 0); b1 = __builtin_amdgcn_mfma_f32_32x32x16_bf16(kt[1][ks], Q.qf[1][ks], b1, 0, 0, 0); }
            __builtin_amdgcn_sched_barrier(0);
            idx_hist16_fine(s0, cF);
            { const f32x2 w0 = {Q.w[0], Q.w[0]}, w1 = {Q.w[1], Q.w[1]};
#pragma unroll
              for (int i = 0; i < 8; ++i) { const f32x2 r0 = {relu_f(b0[2 * i]), relu_f(b0[2 * i + 1])}; s1[i] = w0 * r0; }
#pragma unroll
              for (int i = 0; i < 8; ++i) { const f32x2 r1 = {relu_f(b1[2 * i]), relu_f(b1[2 * i + 1])}; s1[i] = __builtin_elementwise_fma(w1, r1, s1[i]); } }
            b0 = (f32x16){0.f, 0.f, 0.f, 0.f, 0.f, 0.f, 0.f, 0.f, 0.f, 0.f, 0.f, 0.f, 0.f, 0.f, 0.f, 0.f}; b1 = b0;
#pragma unroll
            for (int ks = 0; ks < 4; ++ks) { b0 = __builtin_amdgcn_mfma_f32_32x32x16_bf16(kt[1][ks], Q.qf[2][ks], b0, 0, 0, 0); b1 = __builtin_amdgcn_mfma_f32_32x32x16_bf16(kt[1][ks], Q.qf[3][ks], b1, 0, 0, 0); }
            { const f32x2 w2 = {Q.w[2], Q.w[2]}, w3 = {Q.w[3], Q.w[3]};
#pragma unroll
              for (int i = 0; i < 8; ++i) { const f32x2 r0 = {relu_f(b0[2 * i]), relu_f(b0[2 * i + 1])}; s1[i] = __builtin_elementwise_fma(w2, r0, s1[i]); }
#pragma unroll
              for (int i = 0; i < 8; ++i) { const f32x2 r1 = {relu_f(b1[2 * i]), relu_f(b1[2 * i + 1])}; s1[i] = __builtin_elementwise_fma(w3, r1, s1[i]); } }
            idx_hist16_fine(s1, cF);
            continue;
        }
#endif
#pragma unroll
        for (int pp = 0; pp < 2; ++pp) {
            const int blk = 2 * tile + pp;
            if (blk <= qg) {
#if defined(IDX_SGB) && (IDX_SGB == 6 || IDX_SGB == 7)
                f32x2 sc2[8]; idx_scores2<IDX_SGB>(kt[pp], Q, sc2);
#elif defined(IDX_ACC2_P1)
                f32x2 sc2[8]; idx_scores2<2>(kt[pp], Q, sc2);
#else
                f32x2 sc2[8]; idx_scores2(kt[pp], Q, sc2);
#endif
                if (blk < qg) {
                    if (FINE) idx_hist16_fine(sc2, cF);
                    else {
#pragma unroll
                        for (int r = 0; r < 16; ++r) idx_hadd<FINE>(histb, __float_as_uint(sc2[r >> 1][r & 1]), cF, q4);
                    }
                } else {
#pragma unroll
                    for (int r = 0; r < 16; ++r) { const int key = blk * 32 + (r & 3) + 8 * (r >> 2) + 4 * hi;
                        if (key <= t) idx_hadd<FINE>(histb, __float_as_uint(sc2[r >> 1][r & 1]), cF, q4); }
                }
            }
        }
    }
    asm volatile("s_waitcnt lgkmcnt(0)" ::: "memory");
}

template <bool FINE> __device__ __forceinline__ void idx_find_thr(LAS unsigned* hist, LAS int* segsum, LAS int* thrb, LAS unsigned* thrh, LAS int* need, LAS unsigned* thrlo, LAS unsigned* thrsi, LAS int* flag, int tid) {
    { const int qq_ = tid & 31, seg_ = tid >> 5; int sp_ = 0, sn_ = 0;
#pragma unroll 8
      for (int i = 0; i < 64; ++i) { const unsigned wv = hist[(1023 - 64 * seg_ - i) * 32 + qq_]; sp_ += (int)(wv & 0xffffu); sn_ += (int)(wv >> 16); }
      segsum[seg_ * 32 + qq_] = sp_; segsum[(31 - seg_) * 32 + qq_] = sn_; }
    __syncthreads();
    {
        const int qq_ = tid >> 4, part = tid & 15, lane = tid & 63, grp = (lane >> 4) * 16;
        const int s0 = segsum[(2 * part) * 32 + qq_], s1 = segsum[(2 * part + 1) * 32 + qq_];
        int incl = s0 + s1;
#pragma unroll
        for (int o = 1; o < 16; o <<= 1) { const int v = __shfl_up(incl, o, 16); if (part >= o) incl += v; }
        const int excl = incl - s0 - s1;
        const int tot = __shfl(incl, 15, 16);
        bool h0 = (excl < 256 && excl + s0 >= 256), h1 = (excl + s0 < 256 && excl + s0 + s1 >= 256);
        if (tot < 256) { h0 = false; h1 = (part == 15); }
        const unsigned gm = (unsigned)((__ballot(h0 || h1) >> grp) & 0xFFFFull);
        const int src = gm ? (int)__builtin_ctz(gm) : 15;
        const int sgl = h0 ? 2 * part : 2 * part + 1, cml = h0 ? excl : excl + s0;
        const int sg = __shfl(sgl, src, 16), cums = __shfl(cml, src, 16);
        const bool neg_ = sg >= 16; const int base_ = neg_ ? 64 * (sg - 16) : 1023 - 64 * sg, dir_ = neg_ ? 1 : -1, sh_ = neg_ ? 16 : 0;
        int c_[4];
#pragma unroll
        for (int e = 0; e < 4; ++e) c_[e] = (int)((hist[(base_ + dir_ * (4 * part + e)) * 32 + qq_] >> sh_) & 0xffffu);
        const int ls = c_[0] + c_[1] + c_[2] + c_[3];
        int inc2 = ls;
#pragma unroll
        for (int o = 1; o < 16; o <<= 1) { const int v = __shfl_up(inc2, o, 16); if (part >= o) inc2 += v; }
        int cum = cums + inc2 - ls;
        int wsel_ = 0, above_ = 0, csel_ = 0; bool done_ = false;
#pragma unroll
        for (int e = 0; e < 4; ++e) { if (!done_ && cum < 256 && cum + c_[e] >= 256) { wsel_ = base_ + dir_ * (4 * part + e); above_ = cum; csel_ = c_[e]; done_ = true; } cum += c_[e]; }
        const bool any_ = ((__ballot(done_) >> grp) & 0xFFFFull) != 0ull;
        if (done_ || (!any_ && part == 0)) {
            unsigned L_, H_, lo_, s_;
            const unsigned w_ = (unsigned)wsel_;
            if (!done_) { L_ = 0xFF800000u; H_ = 0xFF800000u; above_ = 256; lo_ = 0u; s_ = 0u; }
            else if (FINE) {
#ifdef IDX_FORCE_COARSE
                flag[0] = 1;
#else
                if (csel_ > 1024) flag[0] = 1;
#endif
                const unsigned bl_ = (unsigned)IDX_BASE + (w_ << 18), bh_ = bl_ + (1u << 18);
                lo_ = (w_ == 0u) ? 0u : bl_; s_ = (w_ == 0u || w_ == 1023u) ? 11u : 0u;
                if (!neg_) { L_ = lo_; H_ = (w_ == 1023u) ? 0x7F800000u : bh_; }
                else { H_ = (w_ == 0u) ? 0u : (0x80000000u | (bl_ - 1u)); L_ = (w_ == 1023u) ? 0xFF800000u : (0x80000000u | (bh_ - 1u)); s_ |= 0x80000000u; }
            } else {
                lo_ = w_ << 21; s_ = 2u;
                if (!neg_) { L_ = lo_; H_ = (w_ == 1023u) ? 0x7F800000u : ((w_ + 1u) << 21); }
                else { H_ = (w_ == 0u) ? 0u : (0x80000000u | (lo_ - 1u)); L_ = 0x80000000u | (((w_ + 1u) << 21) - 1u); s_ |= 0x80000000u; }
            }
            thrb[qq_] = (int)L_; thrh[qq_] = H_; need[qq_] = 256 - above_; thrlo[qq_] = lo_; thrsi[qq_] = s_;
        }
    }
    __syncthreads();
}

__device__ __forceinline__ void indexer_unit(const Params& p, LAS unsigned char* lds, int b, int qg) {
    int tid_ = threadIdx.x; asm volatile("" : "+v"(tid_));
    const int tid = tid_, lane = tid & 63, wave = __builtin_amdgcn_readfirstlane(tid >> 6), q = lane & 31, hi = lane >> 5;
    LAS unsigned* hist = (LAS unsigned*)(lds + IDX_HIST);
    LAS int* thrb = (LAS int*)(lds + IDX_THR);
    LAS unsigned* thrh = (LAS unsigned*)(lds + IDX_THRH);
    LAS int* need = (LAS int*)(lds + IDX_NEED);
    LAS unsigned* ccnt = (LAS unsigned*)(lds + IDX_CCNT);
    LAS int* segsum = (LAS int*)(lds + IDX_SEG);
    LAS int* flag = (LAS int*)(lds + IDX_FLAG);
    LAS unsigned* thrlo = (LAS unsigned*)(lds + IDX_LO); LAS unsigned* thrsi = (LAS unsigned*)(lds + IDX_SI);
    const bf16* IQ = (const bf16*)(p.ws + WS_IQ); const bf16* IK = (const bf16*)(p.ws + WS_IK); const float* IW = (const float*)(p.ws + WS_IW);
    unsigned* MASK = (unsigned*)(p.ws + WS_MASK) + ((size_t)(b * 256 + qg) * 128) * 64;
    const size_t tokb = (size_t)b * SEQ;
    const int t = qg * 32 + q;
    const int ntl = (qg >> 1) + 1;
    const int ntw = 4 * (qg >> 3) + 4;
    IdxQ Q;
    {
        const bf16* qp = IQ + (tokb + t) * 256 + 8 * hi;
#pragma unroll
        for (int h = 0; h < 4; ++h)
#pragma unroll
            for (int ks = 0; ks < 4; ++ks) Q.qf[h][ks] = *(const bf16x8*)(qp + h * 64 + ks * 16);
        const f32x4 w4 = *(const f32x4*)(IW + (tokb + t) * 4);
        Q.w[0] = w4[0]; Q.w[1] = w4[1]; Q.w[2] = w4[2]; Q.w[3] = w4[3];
    }
    const bool full = (qg < 8);
    if (tid < 32) { ccnt[tid] = 0u; thrb[tid] = (int)0xFF800000u; thrh[tid] = 0xFF800000u; need[tid] = 0; thrlo[tid] = 0u; thrsi[tid] = 0u; }
    if (tid == 0) { flag[0] = 0; flag[1] = 0; }
    if (!full) {
        for (int i = tid; i < 8192; i += 512) ((LAS u32x4*)hist)[i] = (u32x4){0u, 0u, 0u, 0u};
        __syncthreads();
#ifndef IDX_REP_P1
#define IDX_REP_P1 1
#endif
        for (int rep1_ = 0; rep1_ < IDX_REP_P1; ++rep1_) {
            if (rep1_) { __syncthreads(); for (int i = tid; i < 8192; i += 512) ((LAS u32x4*)hist)[i] = (u32x4){0u, 0u, 0u, 0u}; __syncthreads(); }
            idx_pass1<true>(IK, tokb, Q, (LAS unsigned char*)hist, qg, ntl, wave, lane, t);
        }
        __syncthreads();
#ifndef IDX_REP_THR
#define IDX_REP_THR 1
#endif
        for (int rept_ = 0; rept_ < IDX_REP_THR; ++rept_) idx_find_thr<true>(hist, segsum, thrb, thrh, need, thrlo, thrsi, flag, tid);
        if (flag[0] != 0) {
            __syncthreads();
            for (int i = tid; i < 8192; i += 512) ((LAS u32x4*)hist)[i] = (u32x4){0u, 0u, 0u, 0u};
            __syncthreads();
            idx_pass1<false>(IK, tokb, Q, (LAS unsigned char*)hist, qg, ntl, wave, lane, t);
            __syncthreads();
            idx_find_thr<false>(hist, segsum, thrb, thrh, need, thrlo, thrsi, flag, tid);
        }
        __syncthreads();
    } else {
        __syncthreads();
    }
    LAS unsigned* rec = hist;
    const float fL = __int_as_float(thrb[q]), fH = __uint_as_float(thrh[q]);
#ifndef IDX_REP_P2
#define IDX_REP_P2 1
#endif
    for (int rep2_ = 0; rep2_ < IDX_REP_P2; ++rep2_) {
    if (rep2_) { __syncthreads(); if (tid < 32) ccnt[tid] = 0u; __syncthreads(); }
#if defined(IDX_KPF) && !defined(IDX_NOKPF2)
    bf16x8 kn[2][4];
    { const int t0 = min(wave, ntl - 1); idx_loadk(IK, tokb + (size_t)t0 * 64, lane, kn[0]); idx_loadk(IK, tokb + (size_t)t0 * 64 + 32, lane, kn[1]); }
#endif
#pragma unroll 1
    for (int tile = wave; tile < ntw; tile += 8) {
        unsigned mw = 0u;
        if (tile < ntl) {
            bf16x8 kt[2][4];
#if defined(IDX_KPF) && !defined(IDX_NOKPF2)
#pragma unroll
            for (int i = 0; i < 4; ++i) { kt[0][i] = kn[0][i]; kt[1][i] = kn[1][i]; }
            { const int t1 = min(tile + 8, ntl - 1); idx_loadk(IK, tokb + (size_t)t1 * 64, lane, kn[0]); idx_loadk(IK, tokb + (size_t)t1 * 64 + 32, lane, kn[1]); }
#else
            idx_loadk(IK, tokb + (size_t)tile * 64, lane, kt[0]);
            if (2 * tile + 1 <= qg) idx_loadk(IK, tokb + (size_t)tile * 64 + 32, lane, kt[1]);
#endif
#pragma unroll
            for (int pp = 0; pp < 2; ++pp) {
                const int blk = 2 * tile + pp;
                if (blk <= qg) {
                    f32x2 sc2[8];
#if defined(IDX_SGB) && (IDX_SGB == 5 || IDX_SGB == 7)
                    idx_scores2<IDX_SGB>(kt[pp], Q, sc2);
#elif defined(IDX_ACC4)
                    idx_scores2<4>(kt[pp], Q, sc2);
#elif defined(IDX_ACC2_P2)
                    idx_scores2<2>(kt[pp], Q, sc2);
#else
                    idx_scores2(kt[pp], Q, sc2);
#endif
                    unsigned mh, ml;
                    idx_cmpbits(sc2, fH, fL, mh, ml);
                    if (blk == qg) {
                        unsigned vm = 0u;
#pragma unroll
                        for (int r = 0; r < 16; ++r) vm |= (blk * 32 + (r & 3) + 8 * (r >> 2) + 4 * hi <= t) ? (1u << r) : 0u;
                        mh &= vm; ml &= vm;
                    }
                    const unsigned cm = ml & ~mh;
                    mw |= mh << (16 * pp);
                    if (__ballot(cm != 0u)) {
                        unsigned slot = 0u;
                        if (cm) slot = __hip_atomic_fetch_add(ccnt + q, (unsigned)__popc(cm), __ATOMIC_RELAXED, __HIP_MEMORY_SCOPE_WORKGROUP);
                        const unsigned rlo = thrlo[q], rsi = thrsi[q];
#pragma unroll
                        for (int r = 0; r < 16; ++r) {
                            if (cm & (1u << r)) {
                                const int key = blk * 32 + (r & 3) + 8 * (r >> 2) + 4 * hi;
                                const unsigned mag = __float_as_uint(sc2[r >> 1][r & 1]) & 0x7FFFFFFFu;
                                const unsigned mid = (((mag - rlo) >> (rsi & 31u)) ^ (unsigned)((int)rsi >> 31)) & 0x7FFFFu;
                                if (slot < 1024u) rec[q * 1024 + slot] = (mid << 13) | (unsigned)(8191 - key);
                                ++slot;
                            }
                        }
                    }
                }
            }
        }
#ifdef NT_MASK
        __builtin_nontemporal_store(mw, MASK + (size_t)tile * 64 + lane);
#else
        MASK[(size_t)tile * 64 + lane] = mw;
#endif
    }
    }
    asm volatile("s_waitcnt vmcnt(0)" ::: "memory");
    __syncthreads();
    if (!full) {
#ifndef IDX_REP_BIS
#define IDX_REP_BIS 1
#endif
#pragma unroll 1
        for (int repb_ = 0; repb_ < IDX_REP_BIS; ++repb_) {
        if (repb_) { __syncthreads(); if (tid == 0) flag[1] = 0; __syncthreads(); }
        int mq[4], ndq[4], rk[4]; unsigned rv0[4];
#pragma unroll
        for (int k = 0; k < 4; ++k) { mq[k] = __builtin_amdgcn_readfirstlane((int)min(ccnt[wave * 4 + k], 1024u)); ndq[k] = __builtin_amdgcn_readfirstlane(need[wave * 4 + k]); }
        int mmax = 0;
#pragma unroll
        for (int k = 0; k < 4; ++k) { const bool small = mq[k] <= 64; rv0[k] = (small && lane < mq[k]) ? rec[(wave * 4 + k) * 1024 + lane] : 0u; rk[k] = 0; if (small) mmax = max(mmax, mq[k]); }
#pragma unroll 1
        for (int j = 0; j < mmax; ++j) {
#pragma unroll
            for (int k = 0; k < 4; ++k) { const unsigned x = (unsigned)__builtin_amdgcn_readlane((int)rv0[k], j); rk[k] += (x > rv0[k]) ? 1 : 0; }
        }
#pragma unroll
        for (int k = 0; k < 4; ++k) {
            if (mq[k] <= 64 && lane < mq[k] && rk[k] < ndq[k]) {
                const int key = 8191 - (int)(rv0[k] & 8191u);
                const int tile = key >> 6, pp = (key >> 5) & 1, k5 = key & 31, khi = (k5 >> 2) & 1, r = (k5 & 3) + 4 * (k5 >> 3);
                atomicOr(MASK + (size_t)tile * 64 + (wave * 4 + k) + 32 * khi, 1u << (16 * pp + r));
            }
        }
#ifdef IDX_HEAVY_LIST
        LAS int* hcnt = flag + 1; LAS int* hlist = flag + 2;
        if (lane == 0) {
#pragma unroll
            for (int k = 0; k < 4; ++k) if (mq[k] > 64) { const int ix = __hip_atomic_fetch_add(hcnt, 1, __ATOMIC_RELAXED, __HIP_MEMORY_SCOPE_WORKGROUP); hlist[ix] = wave * 4 + k; }
        }
        __syncthreads();
        const int nheavy = __builtin_amdgcn_readfirstlane(hcnt[0]);
#pragma unroll 1
        for (int hi_ = wave; hi_ < nheavy; hi_ += 8) {
            const int qq = __builtin_amdgcn_readfirstlane(hlist[hi_]);
            const int m = __builtin_amdgcn_readfirstlane((int)min(ccnt[qq], 1024u)), nd = __builtin_amdgcn_readfirstlane(need[qq]);
#else
#pragma unroll 1
        for (int k = 0; k < 4; ++k) {
            const int qq = wave * 4 + k;
            const int m = __builtin_amdgcn_readfirstlane((int)min(ccnt[qq], 1024u)), nd = __builtin_amdgcn_readfirstlane(need[qq]);
            if (m <= 64) continue;
#endif
            const int jmax = (m + 63) >> 6;
            unsigned rv[16];
#pragma unroll
            for (int j = 0; j < 16; ++j) rv[j] = (j < jmax && lane + 64 * j < m) ? rec[qq * 1024 + lane + 64 * j] : 0u;
            unsigned theta = 0u; int hb = 31;
#ifdef IDX_BIS_PREFIX
            {
                unsigned andv = 0xFFFFFFFFu, orv = 0u;
#pragma unroll
                for (int j = 0; j < 16; ++j) if (j < jmax) { andv &= (lane + 64 * j < m) ? rv[j] : 0xFFFFFFFFu; orv |= rv[j]; }
#pragma unroll
                for (int o = 1; o < 64; o <<= 1) { andv &= (unsigned)__shfl_xor((int)andv, o); orv |= (unsigned)__shfl_xor((int)orv, o); }
                const unsigned diff = (unsigned)__builtin_amdgcn_readfirstlane((int)(andv ^ orv));
                if (diff != 0u) { hb = 31 - __builtin_clz(diff); theta = (hb == 31) ? 0u : ((unsigned)__builtin_amdgcn_readfirstlane((int)andv) & ~((2u << hb) - 1u)); }
            }
#endif
            if (jmax <= 4) {
#pragma unroll 1
                for (int bit = hb; bit >= 0; --bit) {
                    const unsigned cand = theta | (1u << bit);
                    const int cnt = __popcll(__ballot(rv[0] >= cand)) + __popcll(__ballot(rv[1] >= cand)) + __popcll(__ballot(rv[2] >= cand)) + __popcll(__ballot(rv[3] >= cand));
                    theta = (cnt >= nd) ? cand : theta;
                }
            } else {
#pragma unroll 1
                for (int bit = hb; bit >= 0; --bit) {
                    const unsigned cand = theta | (1u << bit);
                    int cnt = 0;
#pragma unroll
                    for (int j = 0; j < 16; ++j) cnt += __popcll(__ballot(rv[j] >= cand));
                    theta = (cnt >= nd) ? cand : theta;
                }
            }
#pragma unroll
            for (int j = 0; j < 16; ++j) {
                if (j < jmax && lane + 64 * j < m && rv[j] >= theta) {
                    const int key = 8191 - (int)(rv[j] & 8191u);
                    const int tile = key >> 6, pp = (key >> 5) & 1, k5 = key & 31, khi = (k5 >> 2) & 1, r = (k5 & 3) + 4 * (k5 >> 3);
                    atomicOr(MASK + (size_t)tile * 64 + qq + 32 * khi, 1u << (16 * pp + r));
                }
            }
        }
        }
    }
    __syncthreads();
}

__device__ __forceinline__ void phase_indexer(const Params& p, LAS unsigned char* lds) {
#ifdef IDX_STATPRIO
    if (__builtin_amdgcn_readfirstlane(threadIdx.x) >= 256) __builtin_amdgcn_s_setprio(1);
#endif
    for (int i = blockIdx.x; i < 256; i += gridDim.x) {
        const int b = (i & 7) >> 1, j = ((i & 1) << 5) + (i >> 3);
        indexer_unit(p, lds, b, 255 - j);
        indexer_unit(p, lds, b, 128 + j);
        indexer_unit(p, lds, b, 127 - j);
        indexer_unit(p, lds, b, j);
    }
#ifdef IDX_STATPRIO
    __builtin_amdgcn_s_setprio(0);
#endif
}

#include <hip/hip_bf16.h>
#include <cmath>
namespace attn_body {
using bf16=__hip_bfloat16;
using bf16x8=__attribute__((ext_vector_type(8)))short;
using s16x4=__attribute__((ext_vector_type(4)))short;
using f32x16=__attribute__((ext_vector_type(16)))float;
using u32x4=__attribute__((ext_vector_type(4)))unsigned;
constexpr int BATCH=4,NHEAD=8,SEQ=8192,D=64,DM=NHEAD*D;
constexpr int NW=8,QBLK=32,QB=QBLK*NW,KVBLK=64,NQB=SEQ/QB;
constexpr int ATTN_PITCH=DM, ATTN_UNIT_ROWS=QB;
__device__ __forceinline__ int crow(int r,int hi){return (r&3)+8*(r>>2)+4*hi;}
#define SBAR() __builtin_amdgcn_sched_barrier(0)
__device__ __forceinline__ void cmask(f32x16&p0,f32x16&p1,int jb,int qrel,int hi){
  const float NEG=-INFINITY; int kb=64*jb+4*hi;
  #pragma unroll
  for(int r=0;r<16;++r){int kv=kb+(r&3)+8*(r>>2); if(kv>qrel)p0[r]=NEG; if(kv+32>qrel)p1[r]=NEG;}
}

constexpr int NSLOT=3, SLOTB=8192;
constexpr int LDS_K=0, LDS_V=NSLOT*SLOTB, LDS_WS=2*NSLOT*SLOTB, LDS_OST=LDS_WS+NW*64*4, LDS_BYTES=LDS_OST+NW*4096;
constexpr float C2=0.125f*1.4426950408889634f;
__device__ __forceinline__ void glds16(const void*gsrc,unsigned lds_dst){unsigned keep;
  asm volatile("s_mov_b32 %0, m0\n\ts_mov_b32 m0, %2\n\ts_nop 0\n\tglobal_load_lds_dwordx4 %1, off\n\ts_mov_b32 m0, %0":"=&s"(keep):"v"(gsrc),"s"(lds_dst):"memory");}
__device__ __forceinline__ float max3f(float a,float b,float c){float r;asm("v_max3_f32 %0, %1, %2, %3":"=v"(r):"v"(a),"v"(b),"v"(c));return r;}
__device__ __forceinline__ float max2f(float a,float b){float r;asm("v_max_f32_e32 %0, %1, %2":"=v"(r):"v"(a),"v"(b));return r;}
__device__ __forceinline__ float fadd_s(float a,float b){float r;asm("v_add_f32_e32 %0, %1, %2":"=v"(r):"v"(a),"v"(b));return r;}
__device__ __forceinline__ float fsub_s(float a,float b){float r;asm("v_sub_f32_e32 %0, %1, %2":"=v"(r):"v"(a),"v"(b));return r;}
typedef float f32x2_t __attribute__((ext_vector_type(2))); typedef __bf16 bf16x2_t __attribute__((ext_vector_type(2)));
__device__ __forceinline__ unsigned cvtpk_s(float lo,float hi){f32x2_t v={lo,hi};bf16x2_t b=__builtin_convertvector(v,bf16x2_t);return __builtin_bit_cast(unsigned,b);}
#define WAIT_BAR(N) asm volatile("s_waitcnt vmcnt(" #N ") lgkmcnt(0)\n\ts_barrier":::"memory")

__device__ __forceinline__ void qkt(f32x16&p0,f32x16&p1,const char*Kslot,const bf16x8*qr,const f32x16&negm,int r32,int hi){
  const char*kb=Kslot+hi*1024+r32*16;
  #pragma unroll
  for(int d0=0;d0<4;++d0){
    const bf16x8 b0=*reinterpret_cast<const bf16x8*>(kb+d0*2048);
    const bf16x8 b1=*reinterpret_cast<const bf16x8*>(kb+d0*2048+512);
    if(d0==0){p0=__builtin_amdgcn_mfma_f32_32x32x16_bf16(b0,qr[0],negm,0,0,0);p1=__builtin_amdgcn_mfma_f32_32x32x16_bf16(b1,qr[0],negm,0,0,0);}
    else{p0=__builtin_amdgcn_mfma_f32_32x32x16_bf16(b0,qr[d0],p0,0,0,0);p1=__builtin_amdgcn_mfma_f32_32x32x16_bf16(b1,qr[d0],p1,0,0,0);}}
}
typedef __attribute__((address_space(3))) const char* lds_cptr;
typedef short v4i16_t __attribute__((ext_vector_type(4)));
__device__ __forceinline__ void kload8(bf16x8*kf,lds_cptr kp){
  kf[0]=*(const __attribute__((address_space(3))) bf16x8*)(kp);      kf[1]=*(const __attribute__((address_space(3))) bf16x8*)(kp+512);
  kf[2]=*(const __attribute__((address_space(3))) bf16x8*)(kp+2048); kf[3]=*(const __attribute__((address_space(3))) bf16x8*)(kp+2560);
  kf[4]=*(const __attribute__((address_space(3))) bf16x8*)(kp+4096); kf[5]=*(const __attribute__((address_space(3))) bf16x8*)(kp+4608);
  kf[6]=*(const __attribute__((address_space(3))) bf16x8*)(kp+6144); kf[7]=*(const __attribute__((address_space(3))) bf16x8*)(kp+6656);
}
__device__ __forceinline__ void kload2(bf16x8*kf,lds_cptr kp,int j){ kf[2*j]=*(const __attribute__((address_space(3))) bf16x8*)(kp+j*2048); kf[2*j+1]=*(const __attribute__((address_space(3))) bf16x8*)(kp+j*2048+512); }
__device__ __forceinline__ s16x4 vtr(lds_cptr p){ return __builtin_bit_cast(s16x4,__builtin_amdgcn_ds_read_tr16_b64_v4i16((__attribute__((address_space(3))) v4i16_t*)p)); }
__device__ __forceinline__ float rowmax(const f32x16&p0,const f32x16&p1){
  float a=max3f(p0[0],p0[1],p1[0]),b=max3f(p0[2],p0[3],p1[1]);a=max3f(a,p1[2],p1[3]);
  #pragma unroll
  for(int r=4;r<16;r+=4){a=max3f(a,p0[r],p0[r+1]);b=max3f(b,p0[r+2],p0[r+3]);a=max3f(a,p1[r],p1[r+1]);b=max3f(b,p1[r+2],p1[r+3]);}
  const float m=max2f(a,b);
  auto rr=__builtin_amdgcn_permlane32_swap(__float_as_uint(m),__float_as_uint(m),false,false);
  return max2f(__uint_as_float(rr[0]),__uint_as_float(rr[1]));
}
__device__ __forceinline__ void pv(f32x16*o,int vb,bf16x8 pa0,bf16x8 pa1,bf16x8 pa2,bf16x8 pa3){
  #pragma unroll
  for(int d0=0;d0<2;++d0){s16x4 lo[4],hi[4];
    #pragma unroll
    for(int ks=0;ks<4;++ks){
      asm volatile("ds_read_b64_tr_b16 %0,%1 offset:%c2":"=&v"(lo[ks]):"v"(vb),"i"(d0*4096+ks*1024):"memory");
      asm volatile("ds_read_b64_tr_b16 %0,%1 offset:%c2":"=&v"(hi[ks]):"v"(vb),"i"(d0*4096+ks*1024+512):"memory");}
    asm volatile("s_waitcnt lgkmcnt(0)":::"memory");SBAR();
    #define PK(k) (bf16x8){lo[k][0],lo[k][1],lo[k][2],lo[k][3],hi[k][0],hi[k][1],hi[k][2],hi[k][3]}
    o[d0]=__builtin_amdgcn_mfma_f32_32x32x16_bf16(pa0,PK(0),o[d0],0,0,0);
    o[d0]=__builtin_amdgcn_mfma_f32_32x32x16_bf16(pa1,PK(1),o[d0],0,0,0);
    o[d0]=__builtin_amdgcn_mfma_f32_32x32x16_bf16(pa2,PK(2),o[d0],0,0,0);
    o[d0]=__builtin_amdgcn_mfma_f32_32x32x16_bf16(pa3,PK(3),o[d0],0,0,0);
    #undef PK
  }
}

#ifdef NT_YA
#define ATTN_STORE16(p,v) __builtin_nontemporal_store((v),(u32x4*)(p))
#endif
#ifndef ATTN_STORE16
#define ATTN_STORE16(p,v) (*(u32x4*)(p)=(v))
#endif
template<int THRL> __device__ __forceinline__ void attn_unit(int b,int h,int qb,const bf16*Q,const bf16*__restrict__ K,const bf16*__restrict__ V,bf16*O,const unsigned long long*MASK64,char*shm){
  int tid_=threadIdx.x; asm volatile("":"+v"(tid_)); const int tid=tid_,lane=tid&63,r32=lane&31,hi=lane>>5; const int wid=__builtin_amdgcn_readfirstlane(tid>>6);
  const long rowbase=(long)b*SEQ; const int q0=qb*QB;
  const bf16*Qw=Q+(rowbase+q0+wid*QBLK)*DM+h*D;
  const bf16*Kh=K+rowbase*DM+h*D,*Vh=V+rowbase*DM+h*D;
  const unsigned lds0=(unsigned)(uintptr_t)shm;
  float*wsf=(float*)(shm+LDS_WS)+wid*64;
  const bf16*ksrc=Kh+(long)lane*DM+wid*8;
  const bf16*vsrc=Vh+(long)(16*(wid&3)+(lane>>2))*DM+(wid>>2)*32+(lane&3)*8;
  const unsigned kdst=lds0+LDS_K+wid*1024, vdst=lds0+LDS_V+wid*1024;
  #define DMA_K(t,slot) glds16(ksrc+(long)(t)*KVBLK*DM,(unsigned)__builtin_amdgcn_readfirstlane(kdst+(slot)))
  #define DMA_V(t,slot) glds16(vsrc+(long)(t)*KVBLK*DM,(unsigned)__builtin_amdgcn_readfirstlane(vdst+(slot)))
  const int vb0=(int)(lds0+LDS_V)+((lane>>4)&1)*32+(lane&3)*8+(4*hi+((lane&15)>>2))*64;
  const char*Kbase=shm+LDS_K; bf16x8 kf[8];
  const lds_cptr shm3=(lds_cptr)shm; const lds_cptr kp0=shm3+LDS_K+hi*1024+r32*16; const lds_cptr vp0=shm3+LDS_V+((lane>>4)&1)*32+(lane&3)*8+(4*hi+((lane&15)>>2))*64;
  const int NT=(q0+QB)/KVBLK;
  DMA_K(0,0);DMA_V(0,0);DMA_K(1,SLOTB);
  bf16x8 qr[4];
  #pragma unroll
  for(int d0=0;d0<4;++d0)qr[d0]=*reinterpret_cast<const bf16x8*>(&Qw[(long)r32*DM+d0*16+hi*8]);
  float mhat=0.f,l_reg=0.f;f32x16 o[2];o[0]=f32x16{};o[1]=f32x16{};f32x16 negm=f32x16{};asm volatile("":"+v"(negm));
#ifdef ATT_ONES
  f32x16 osum=f32x16{}; const bf16x8 ONESF={(short)0x3F80,(short)0x3F80,(short)0x3F80,(short)0x3F80,(short)0x3F80,(short)0x3F80,(short)0x3F80,(short)0x3F80};
#endif
  const int qrel=wid*QBLK+r32; (void)qrel;
  const char*mbase=(const char*)MASK64+((size_t)(b*256+qb*8+wid)*128)*256;
  const unsigned moff=(unsigned)lane*4u;
  unsigned mwcur=*(const unsigned*)(mbase+moff);
  #define MASK_NEXT(t) do{ if(((t)+1)<NT){ const unsigned long long ma_=(unsigned long long)(uintptr_t)(mbase+(size_t)((t)+1)*256); \
      asm volatile("s_nop 4\n\tglobal_load_dword %0, %1, %2":"=v"(mwcur):"v"(moff),"s"(ma_):"memory"); } }while(0)
#define MLOAD(t)
#define CMASK(P0,P1,t) do{ const unsigned w_=mwcur; \
    _Pragma("unroll") for(int r=0;r<16;++r){ const int m0_=((int)(w_<<(31-r)))>>31, m1_=((int)(w_<<(15-r)))>>31; \
      P0[r]=__uint_as_float((__float_as_uint(P0[r])&(unsigned)m0_)|(0xFF800000u&~(unsigned)m0_)); P1[r]=__uint_as_float((__float_as_uint(P1[r])&(unsigned)m1_)|(0xFF800000u&~(unsigned)m1_)); } \
    asm volatile("":"+v"(P0),"+v"(P1)); MASK_NEXT(t); }while(0)
  bool resc=false;
#ifdef ATT_ONES
  #define RESC_SUM() do{ _Pragma("unroll") for(int r=0;r<16;++r)osum[r]*=wsf[crow(r,hi)]; }while(0)
#else
  #define RESC_SUM() do{}while(0)
#endif
  #define START(P0,P1) do{ const float rm=rowmax(P0,P1); resc=false; \
    { const float dl=__builtin_fmaxf(rm,-60.f); mhat=fadd_s(mhat,dl); \
      _Pragma("unroll") for(int r=0;r<16;++r){P0[r]=fsub_s(P0[r],dl);P1[r]=fsub_s(P1[r],dl);} \
      _Pragma("unroll") for(int r=0;r<16;++r)negm[r]=-mhat; asm volatile("":"+v"(negm)); } \
    _Pragma("unroll") for(int r=0;r<16;++r)P0[r]=__builtin_amdgcn_exp2f(P0[r]); }while(0)
  #define RESC() do{ if(resc){ asm volatile("s_waitcnt lgkmcnt(0)":::"memory"); \
      _Pragma("unroll") for(int d_=0;d_<2;++d_) _Pragma("unroll") for(int r=0;r<16;++r)o[d_][r]*=wsf[crow(r,hi)]; RESC_SUM(); } }while(0)
  f32x16 pA0,pA1,pB0,pB1;
  int sl_prev=0,sl_cur=0,sl_next=SLOTB;
  #define ROT() do{sl_prev=sl_cur;sl_cur=sl_next;sl_next=(sl_next==(NSLOT-1)*SLOTB)?0:sl_next+SLOTB;}while(0)
  DMA_K(2,2*SLOTB);
  WAIT_BAR(3);
  { qkt(pA0,pA1,Kbase,qr,negm,r32,hi);asm volatile("s_nop 15\n\ts_nop 7":"+v"(pA0),"+v"(pA1));CMASK(pA0,pA1,0); }
  START(pA0,pA1);
  _Pragma("unroll") for(int r=0;r<16;++r)pA1[r]=__builtin_amdgcn_exp2f(pA1[r]);
  WAIT_BAR(0);
  DMA_K(3,0);DMA_V(1,SLOTB);
  ROT();
  kload8(kf,kp0+sl_cur);
  WAIT_BAR(2);
  s16x4 vlo[8],vhi[8]; u32x4 pw0,pw1,pw2,pw3;
  #define PKW(P,B) cvtpk_s(P[B],P[B+1])
  #define PAF(k) __builtin_bit_cast(bf16x8,pw##k)
  #define VFR(i) (bf16x8){vlo[i][0],vlo[i][1],vlo[i][2],vlo[i][3],vhi[i][0],vhi[i][1],vhi[i][2],vhi[i][3]}
  #define PIN(x) asm volatile("":"+v"(x))
  #define MX3(a,b,c) __builtin_fmaxf(__builtin_fmaxf((a),(b)),(c))
#ifdef ATT_ONES
  #define GAPA(MF,A0,A1,A2,A3,W0,W1,PW) do{ MF; W0; W1; PIN(PW); SBAR(); }while(0)
#elif defined(ATT_PKSUM)
  typedef float f32x2a __attribute__((ext_vector_type(2)));
  #define GAPA(MF,A0,A1,A2,A3,W0,W1,PW) do{ MF; sacc2+=(f32x2a){A0,A1}; sacc2+=(f32x2a){A2,A3}; PIN(sacc2); W0; W1; PIN(PW); SBAR(); }while(0)
#else
  #define GAPA(MF,A0,A1,A2,A3,W0,W1,PW) do{ MF; sacc+=A0; sacc+=A1; sacc+=A2; sacc+=A3; PIN(sacc); W0; W1; PIN(PW); SBAR(); }while(0)
#endif
  #define EX(v) __builtin_amdgcn_exp2f(v)
  #define GAPB(MF,X,B) do{ MF; X[B]=EX(X[B]); X[B+1]=EX(X[B+1]); X[B+2]=EX(X[B+2]); X[B+3]=EX(X[B+3]); PIN(X); SBAR(); }while(0)
  #define VRD(i) do{ vlo[i]=vtr(vp_+(((i)>>2)*4096+((i)&3)*1024)); vhi[i]=vtr(vp_+(((i)>>2)*4096+((i)&3)*1024+512)); }while(0)
  #define KRD(G,j) do{ if(G){ kload2(kf,kp0+sl_next,j); SBAR(); } }while(0)
#ifdef ATT_ONES
  #define SACC_INIT(P0) do{}while(0)
  #define SACC_FIN() do{}while(0)
#elif defined(ATT_PKSUM)
  #define SACC_INIT(P0) f32x2a sacc2={P0[0],P0[1]}
  #define SACC_FIN() l_reg+=(sacc2[0]+sacc2[1])
#else
  #define SACC_INIT(P0) float sacc=(P0[0]+P0[1])
  #define SACC_FIN() l_reg+=sacc
#endif
#ifdef ATT_ONES
  #define LREG_SCALE(f) do{}while(0)
#else
  #define LREG_SCALE(f) l_reg*=(f)
#endif
#ifdef ATT_ONES
  #define GAPX3(MF,X,B) do{ MF; X[B]=EX(X[B]); X[B+1]=EX(X[B+1]); X[B+2]=EX(X[B+2]); PIN(X); SBAR(); }while(0)
  #define GAPX2(MF,X,B) do{ MF; X[B]=EX(X[B]); X[B+1]=EX(X[B+1]); PIN(X); SBAR(); }while(0)
  #define PHASEB(C0,C1,GL) do{ \
    GAPX3(o[0]=__builtin_amdgcn_mfma_f32_32x32x16_bf16(PAF(0),VFR(0),o[0],0,0,0), C0,0); \
    GAPX3(o[1]=__builtin_amdgcn_mfma_f32_32x32x16_bf16(PAF(0),VFR(4),o[1],0,0,0), C0,3); \
    GAPX2(osum=__builtin_amdgcn_mfma_f32_32x32x16_bf16(PAF(0),ONESF,osum,0,0,0), C0,6); \
    KRD(GL,0); GAPX3(o[0]=__builtin_amdgcn_mfma_f32_32x32x16_bf16(PAF(1),VFR(1),o[0],0,0,0), C0,8); \
    KRD(GL,1); GAPX3(o[1]=__builtin_amdgcn_mfma_f32_32x32x16_bf16(PAF(1),VFR(5),o[1],0,0,0), C0,11); \
    GAPX2(osum=__builtin_amdgcn_mfma_f32_32x32x16_bf16(PAF(1),ONESF,osum,0,0,0), C0,14); \
    KRD(GL,2); GAPX3(o[0]=__builtin_amdgcn_mfma_f32_32x32x16_bf16(PAF(2),VFR(2),o[0],0,0,0), C1,0); \
    KRD(GL,3); GAPX3(o[1]=__builtin_amdgcn_mfma_f32_32x32x16_bf16(PAF(2),VFR(6),o[1],0,0,0), C1,3); \
    GAPX2(osum=__builtin_amdgcn_mfma_f32_32x32x16_bf16(PAF(2),ONESF,osum,0,0,0), C1,6); \
    GAPX3(o[0]=__builtin_amdgcn_mfma_f32_32x32x16_bf16(PAF(3),VFR(3),o[0],0,0,0), C1,8); \
    GAPX3(o[1]=__builtin_amdgcn_mfma_f32_32x32x16_bf16(PAF(3),VFR(7),o[1],0,0,0), C1,11); \
    GAPX2(osum=__builtin_amdgcn_mfma_f32_32x32x16_bf16(PAF(3),ONESF,osum,0,0,0), C1,14); }while(0)
#else
  #define PHASEB(C0,C1,GL) do{ \
    GAPB(o[0]=__builtin_amdgcn_mfma_f32_32x32x16_bf16(PAF(0),VFR(0),o[0],0,0,0), C0,0); \
    GAPB(o[1]=__builtin_amdgcn_mfma_f32_32x32x16_bf16(PAF(0),VFR(4),o[1],0,0,0), C0,4); \
    KRD(GL,0); GAPB(o[0]=__builtin_amdgcn_mfma_f32_32x32x16_bf16(PAF(1),VFR(1),o[0],0,0,0), C0,8); \
    KRD(GL,1); GAPB(o[1]=__builtin_amdgcn_mfma_f32_32x32x16_bf16(PAF(1),VFR(5),o[1],0,0,0), C0,12); \
    KRD(GL,2); GAPB(o[0]=__builtin_amdgcn_mfma_f32_32x32x16_bf16(PAF(2),VFR(2),o[0],0,0,0), C1,0); \
    KRD(GL,3); GAPB(o[1]=__builtin_amdgcn_mfma_f32_32x32x16_bf16(PAF(2),VFR(6),o[1],0,0,0), C1,4); \
    GAPB(o[0]=__builtin_amdgcn_mfma_f32_32x32x16_bf16(PAF(3),VFR(3),o[0],0,0,0), C1,8); \
    GAPB(o[1]=__builtin_amdgcn_mfma_f32_32x32x16_bf16(PAF(3),VFR(7),o[1],0,0,0), C1,12); }while(0)
#endif
  #define STEP(C0,C1,P0,P1,t,GK,GV,GL) do{ SBAR(); \
    const lds_cptr vp_=vp0+sl_prev; \
    VRD(0); SBAR(); SACC_INIT(P0); \
    GAPA(C0=__builtin_amdgcn_mfma_f32_32x32x16_bf16(kf[0],qr[0],negm,0,0,0), P0[2],P0[3],P0[4],P0[5],     pw0[0]=PKW(P0,0), pw0[1]=PKW(P0,2), pw0); \
    VRD(4); SBAR(); GAPA(C1=__builtin_amdgcn_mfma_f32_32x32x16_bf16(kf[1],qr[0],negm,0,0,0), P0[6],P0[7],P0[8],P0[9],     pw0[2]=PKW(P0,4), pw0[3]=PKW(P0,6), pw0); \
    VRD(1); SBAR(); GAPA(C0=__builtin_amdgcn_mfma_f32_32x32x16_bf16(kf[2],qr[1],C0,0,0,0),   P0[10],P0[11],P0[12],P0[13], pw1[0]=PKW(P0,8), pw1[1]=PKW(P0,10), pw1); \
    VRD(5); SBAR(); GAPA(C1=__builtin_amdgcn_mfma_f32_32x32x16_bf16(kf[3],qr[1],C1,0,0,0),   P0[14],P0[15],P1[0],P1[1],   pw1[2]=PKW(P0,12),pw1[3]=PKW(P0,14), pw1); \
    VRD(2); SBAR(); GAPA(C0=__builtin_amdgcn_mfma_f32_32x32x16_bf16(kf[4],qr[2],C0,0,0,0),   P1[2],P1[3],P1[4],P1[5],     pw2[0]=PKW(P1,0), pw2[1]=PKW(P1,2), pw2); \
    VRD(6); SBAR(); GAPA(C1=__builtin_amdgcn_mfma_f32_32x32x16_bf16(kf[5],qr[2],C1,0,0,0),   P1[6],P1[7],P1[8],P1[9],     pw2[2]=PKW(P1,4), pw2[3]=PKW(P1,6), pw2); \
    VRD(3); SBAR(); GAPA(C0=__builtin_amdgcn_mfma_f32_32x32x16_bf16(kf[6],qr[3],C0,0,0,0),   P1[10],P1[11],P1[12],P1[13], pw3[0]=PKW(P1,8), pw3[1]=PKW(P1,10), pw3); \
    VRD(7); SBAR(); GAPA(C1=__builtin_amdgcn_mfma_f32_32x32x16_bf16(kf[7],qr[3],C1,0,0,0),   P1[14],P1[15],0.f,0.f,       pw3[2]=PKW(P1,12),pw3[3]=PKW(P1,14), pw3); \
    SACC_FIN(); \
    CMASK(C0,C1,t); \
    if(GK){DMA_K((t)+3,sl_cur);} if(GV){DMA_V((t)+1,sl_next);} \
    { float a=MX3(C0[0],C0[1],C1[0]),b=MX3(C0[2],C0[3],C1[1]); a=MX3(a,C1[2],C1[3]); \
      _Pragma("unroll") for(int r=4;r<16;r+=4){a=MX3(a,C0[r],C0[r+1]);b=MX3(b,C0[r+2],C0[r+3]);a=MX3(a,C1[r],C1[r+1]);b=MX3(b,C1[r+2],C1[r+3]);} \
      float rm=__builtin_fmaxf(a,b); { auto rr=__builtin_amdgcn_permlane32_swap(__float_as_uint(rm),__float_as_uint(rm),false,false); rm=__builtin_fmaxf(__uint_as_float(rr[0]),__uint_as_float(rr[1])); } \
      resc=false; \
      if(__builtin_expect(__any(rm>(float)THRL),0)){ const float dl=__builtin_fmaxf(rm,0.f); mhat+=dl; \
        _Pragma("unroll") for(int r=0;r<16;++r){C0[r]-=dl;C1[r]-=dl;} \
        _Pragma("unroll") for(int r=0;r<16;++r)negm[r]=-mhat; asm volatile("":"+v"(negm)); \
        const float f=__builtin_amdgcn_exp2f(-dl); LREG_SCALE(f); if(hi==0)wsf[r32]=f; resc=true; } } \
    SBAR(); \
    PHASEB(C0,C1,GL); \
    }while(0)
  int t=1;
  for(;t+5<NT;t+=2){
    STEP(pB0,pB1,pA0,pA1,t,true,true,true);     WAIT_BAR(2); RESC(); ROT();
    STEP(pA0,pA1,pB0,pB1,t+1,true,true,true);   WAIT_BAR(2); RESC(); ROT();
  }
  #define ENDW(tt) do{ if((tt)+3<NT){WAIT_BAR(2);} else if((tt)+2<NT){WAIT_BAR(1);} else {WAIT_BAR(0);} }while(0)
  for(;t+1<NT;t+=2){
    STEP(pB0,pB1,pA0,pA1,t,(t+3<NT),(t+1<NT),(t+1<NT));       ENDW(t);   RESC(); ROT();
    STEP(pA0,pA1,pB0,pB1,t+1,(t+4<NT),(t+2<NT),(t+2<NT));     ENDW(t+1); RESC(); ROT();
  }
  STEP(pB0,pB1,pA0,pA1,NT-1,false,false,false); RESC();
  {
#ifndef ATT_ONES
    { float sacc=pB0[0]+pB0[1]; _Pragma("unroll") for(int r=2;r<16;++r)sacc+=pB0[r]; _Pragma("unroll") for(int r=0;r<16;++r)sacc+=pB1[r]; l_reg+=sacc; }
#endif
    pw0=(u32x4){PKW(pB0,0),PKW(pB0,2),PKW(pB0,4),PKW(pB0,6)};pw1=(u32x4){PKW(pB0,8),PKW(pB0,10),PKW(pB0,12),PKW(pB0,14)};pw2=(u32x4){PKW(pB1,0),PKW(pB1,2),PKW(pB1,4),PKW(pB1,6)};pw3=(u32x4){PKW(pB1,8),PKW(pB1,10),PKW(pB1,12),PKW(pB1,14)};
    SBAR(); pv(o,vb0+sl_cur,PAF(0),PAF(1),PAF(2),PAF(3));
#ifdef ATT_ONES
    osum=__builtin_amdgcn_mfma_f32_32x32x16_bf16(PAF(0),ONESF,osum,0,0,0); osum=__builtin_amdgcn_mfma_f32_32x32x16_bf16(PAF(1),ONESF,osum,0,0,0);
    osum=__builtin_amdgcn_mfma_f32_32x32x16_bf16(PAF(2),ONESF,osum,0,0,0); osum=__builtin_amdgcn_mfma_f32_32x32x16_bf16(PAF(3),ONESF,osum,0,0,0);
#endif
  }
  #undef PKW
  #undef PAF
  #undef VFR
  #undef PIN
  #undef MX3
  #undef GAPA
  #undef GAPB
  #undef EX
  #undef VRD
  #undef KRD
  #undef STEP
  #undef PHASEB
  #undef ENDW
  float rli[16];
#ifdef ATT_ONES
  (void)l_reg;
  #pragma unroll
  for(int r=0;r<16;++r)rli[r]=__builtin_amdgcn_rcpf(osum[r]);
#else
  {auto rr=__builtin_amdgcn_permlane32_swap(__float_as_uint(l_reg),__float_as_uint(l_reg),false,false);l_reg=__uint_as_float(rr[0])+__uint_as_float(rr[1]);}
  if(hi==0)wsf[32+r32]=l_reg;asm volatile("s_waitcnt lgkmcnt(0)":::"memory");
  #pragma unroll
  for(int r=0;r<16;++r)rli[r]=__builtin_amdgcn_rcpf(wsf[32+crow(r,hi)]);
#endif
  bf16*Ow=O+(rowbase+q0+wid*QBLK)*DM+h*D;
  { bf16*stg=(bf16*)(shm+LDS_OST)+wid*2048;
    #pragma unroll
    for(int r=0;r<16;++r){const int orow=crow(r,hi);
      #pragma unroll
      for(int d0=0;d0<2;++d0)stg[orow*64+d0*32+r32]=__float2bfloat16(o[d0][r]*rli[r]);}
    asm volatile("s_waitcnt lgkmcnt(0)":::"memory");
    #pragma unroll
    for(int i=0;i<4;++i){const int row=i*8+(lane>>3),ch=lane&7; const u32x4 v=*(const u32x4*)(stg+row*64+ch*8); ATTN_STORE16(Ow+(long)row*DM+ch*8,v);} }
  asm volatile("s_waitcnt lgkmcnt(0)\n\ts_barrier":::"memory");
  #undef DMA_K
  #undef DMA_V
  #undef CMASK
  #undef START
  #undef RESC
  #undef ROT
}
constexpr int ATTN_LDS_BYTES=LDS_BYTES;
struct AttnTensors { const bf16* Q; const bf16* K; const bf16* V; bf16* O; const unsigned long long* M; };
struct AttnUnit { int bh; int qb; };
struct StaticOrder {
  int vcu;
  __device__ __forceinline__ explicit StaticOrder(int grid,int block):vcu((block%8)*(grid/8)+block/8){}
  __device__ __forceinline__ bool next(int i,AttnUnit&u)const{ if(i>=4)return false; const int s=vcu&7; u.bh=vcu>>3; u.qb=(i==0)?s:(i==1)?15-s:(i==2)?16+s:31-s; return true; }
  __device__ __forceinline__ void a_ready(const AttnUnit&)const{}
  __device__ __forceinline__ void done(const AttnUnit&)const{}
};
template<class Sched,int THRL=8> __device__ __forceinline__ void attn_phase(char*lds,const AttnTensors&T,const Sched&S){
  AttnUnit u;
  for(int i=0;S.next(i,u);++i){ S.a_ready(u); attn_unit<THRL>(u.bh/NHEAD,u.bh%NHEAD,u.qb,T.Q,T.K,T.V,T.O,T.M,lds); S.done(u); }
}
#undef SBAR
#undef WAIT_BAR
}

__device__ __forceinline__ unsigned sortable_u32(float s) { const unsigned b = __float_as_uint(s); return (b & 0x80000000u) ? ~b : (b | 0x80000000u); }

__device__ __forceinline__ void attn_simple_body(const Params& p, unsigned* sc, float* qs, int wslot, int nslots, int lane) {
    const bf16* IQ = (const bf16*)(p.ws + WS_IQ); const bf16* IK = (const bf16*)(p.ws + WS_IK); const float* IW = (const float*)(p.ws + WS_IW);
    const bf16* AQ = (const bf16*)(p.ws + WS_AQ); const bf16* AK = (const bf16*)(p.ws + WS_AK); const bf16* AV = (const bf16*)(p.ws + WS_AV);
    bf16* YA = (bf16*)(p.ws + WS_YA);
    const int nq = T;
    for (int qi = wslot; qi < nq; qi += nslots) {
        const int b = qi >> 13; int t = qi & (SEQ - 1);
        t = (t & 1) ? (SEQ - 1 - (t >> 1)) : (t >> 1);
        const size_t tok = (size_t)b * SEQ + t; const int n = t + 1;
        for (int e = lane; e < 256; e += 64) { const int h = e >> 6, d = e & 63; qs[d * 4 + h] = bf2f(IQ[tok * 256 + e]); }
        const f32x4 w4 = *(const f32x4*)(IW + tok * 4);
        asm volatile("s_waitcnt lgkmcnt(0)" ::: "memory");
#ifndef MASK_ONLY
        for (int j0 = 0; j0 < n; j0 += 64) {
            const int s = j0 + lane;
            if (s < n) {
                const u32x4* kp = (const u32x4*)(IK + ((size_t)b * SEQ + s) * 64);
                float a0 = 0.f, a1 = 0.f, a2 = 0.f, a3 = 0.f;
#pragma unroll
                for (int c = 0; c < 8; ++c) {
                    const u32x4 kv = kp[c];
                    const unsigned kw[4] = {kv.x, kv.y, kv.z, kv.w};
#pragma unroll
                    for (int i = 0; i < 4; ++i) {
                        const float k0 = __uint_as_float(kw[i] << 16), k1 = __uint_as_float(kw[i] & 0xffff0000u);
                        const f32x4 q0 = *(const f32x4*)(qs + (c * 8 + 2 * i) * 4), q1 = *(const f32x4*)(qs + (c * 8 + 2 * i + 1) * 4);
                        a0 += q0[0] * k0 + q1[0] * k1; a1 += q0[1] * k0 + q1[1] * k1; a2 += q0[2] * k0 + q1[2] * k1; a3 += q0[3] * k0 + q1[3] * k1;
                    }
                }
                float score = w4[0] * fmaxf(a0, 0.f) + w4[1] * fmaxf(a1, 0.f) + w4[2] * fmaxf(a2, 0.f) + w4[3] * fmaxf(a3, 0.f);
                score += 0.0f;
                sc[s] = sortable_u32(score);
            }
        }
        asm volatile("s_waitcnt lgkmcnt(0)" ::: "memory");
        unsigned theta = 0u; int cut = SEQ;
        if (n > 256) {
            for (int bit = 31; bit >= 0; --bit) {
                const unsigned cand = theta | (1u << bit);
                int cnt = 0;
                for (int s = lane; s < n; s += 64) cnt += (sc[s] >= cand) ? 1 : 0;
                cnt = (int)wave_sum((float)cnt);
                if (cnt >= 256) theta = cand;
            }
            int cgt = 0;
            for (int s = lane; s < n; s += 64) cgt += (sc[s] > theta) ? 1 : 0;
            cgt = (int)wave_sum((float)cgt);
            const int r = 256 - cgt;
            int x = 0;
            for (int bit = 12; bit >= 0; --bit) {
                const int xc = x | (1 << bit);
                int cnt = 0;
                for (int s = lane; s < n; s += 64) cnt += (sc[s] == theta && s < xc) ? 1 : 0;
                cnt = (int)wave_sum((float)cnt);
                if (cnt < r) x = xc;
            }
            cut = x;
        }
#else
        const unsigned theta = 0u; const int cut = SEQ;
#endif
        float q[8], o[8];
        { const u32x4 qv = *(const u32x4*)(AQ + tok * 512 + lane * 8); const unsigned qw[4] = {qv.x, qv.y, qv.z, qv.w};
#pragma unroll
          for (int i = 0; i < 4; ++i) { q[2 * i] = __uint_as_float(qw[i] << 16); q[2 * i + 1] = __uint_as_float(qw[i] & 0xffff0000u); } }
#pragma unroll
        for (int i = 0; i < 8; ++i) o[i] = 0.f;
        float mrun = -INFINITY, lsum = 0.f;
        for (int j0 = 0; j0 < n; j0 += 64) {
            const int s = j0 + lane;
            bool sel = false;
#ifndef MASK_ONLY
            if (s < n) { const unsigned u = sc[s]; sel = (u > theta) || (u == theta && s <= cut); }
#endif
#if defined(CHECK_MASK) || defined(MASK_ONLY)
            {
                const unsigned* MB = (const unsigned*)(p.ws + WS_MASK) + (((size_t)(b * 256 + (t >> 5)) * 128) + (j0 >> 6)) * 64;
                const int pp = lane >> 5, k5 = lane & 31, khi = (k5 >> 2) & 1, rr = (k5 & 3) + 4 * (k5 >> 3);
                const bool selm = (MB[(t & 31) + 32 * khi] >> (16 * pp + rr)) & 1u;
#ifndef MASK_ONLY
                const unsigned long long diff = __ballot(selm != sel);
                if (diff && lane == 0) atomicAdd((unsigned*)(p.ws + WS_CTL) + CW_MISMATCH, (unsigned)__popcll(diff));
#endif
                sel = (s < n) && selm;
            }
#endif
            unsigned long long mask = __ballot(sel);
            while (mask) {
                const int bit = __builtin_ctzll(mask); mask &= mask - 1;
                const size_t kt = (size_t)b * SEQ + j0 + bit;
                const u32x4 kv = *(const u32x4*)(AK + kt * 512 + lane * 8);
                const u32x4 vv = *(const u32x4*)(AV + kt * 512 + lane * 8);
                const unsigned kw[4] = {kv.x, kv.y, kv.z, kv.w}, vw[4] = {vv.x, vv.y, vv.z, vv.w};
                float dot = 0.f;
#pragma unroll
                for (int i = 0; i < 4; ++i) dot += q[2 * i] * __uint_as_float(kw[i] << 16) + q[2 * i + 1] * __uint_as_float(kw[i] & 0xffff0000u);
                dot += __shfl_xor(dot, 1); dot += __shfl_xor(dot, 2); dot += __shfl_xor(dot, 4);
                const float mn = fmaxf(mrun, dot);
                const float scl = exp2f(mrun - mn), pr = exp2f(dot - mn);
                lsum = lsum * scl + pr;
#pragma unroll
                for (int i = 0; i < 4; ++i) {
                    o[2 * i] = o[2 * i] * scl + pr * __uint_as_float(vw[i] << 16);
                    o[2 * i + 1] = o[2 * i + 1] * scl + pr * __uint_as_float(vw[i] & 0xffff0000u);
                }
                mrun = mn;
            }
        }
        const float inv = 1.0f / lsum;
        u32x4 w; w.x = pk2(o[0] * inv, o[1] * inv); w.y = pk2(o[2] * inv, o[3] * inv); w.z = pk2(o[4] * inv, o[5] * inv); w.w = pk2(o[6] * inv, o[7] * inv);
#ifdef CHECK_YA
        {   const u32x4 y = *(const u32x4*)(YA + tok * 512 + lane * 8); const unsigned yw[4] = {y.x, y.y, y.z, y.w}; float dmax = 0.f;
#pragma unroll
            for (int i = 0; i < 4; ++i) { dmax = fmaxf(dmax, fabsf(o[2 * i] * inv - __uint_as_float(yw[i] << 16))); dmax = fmaxf(dmax, fabsf(o[2 * i + 1] * inv - __uint_as_float(yw[i] & 0xffff0000u))); }
            dmax = wave_max(dmax);
            if (lane == 0) atomicMax((unsigned*)(p.ws + WS_CTL) + CW_MISMATCH, __float_as_uint(dmax)); }
#else
        *(u32x4*)(YA + tok * 512 + lane * 8) = w;
#endif
    }
}

__global__ void __launch_bounds__(256) k_attn_simple(Params p) {
    extern __shared__ __attribute__((aligned(16))) unsigned char lds_raw[];
    const int tid = threadIdx.x, lane = tid & 63, wave = tid >> 6;
    attn_simple_body(p, (unsigned*)(lds_raw + wave * 32768), (float*)(lds_raw + 131072 + wave * 1024), blockIdx.x * 4 + wave, gridDim.x * 4, lane);
}

constexpr int LQ = 72, LS = 136;

__device__ __forceinline__ f32x4 mfma16(const LAS bf16* Arow, const LAS bf16* Brow, f32x4 acc) {
    const bf16x8 a = *(const LAS bf16x8*)Arow, b = *(const LAS bf16x8*)Brow;
    return __builtin_amdgcn_mfma_f32_16x16x32_bf16(a, b, acc, 0, 0, 0);
}

struct ConvRegs { u32x4 x[5]; };
__device__ __forceinline__ void conv_load(ConvRegs& R, int tid, const bf16* src, int b, int c, int h) {
    const int rp = tid >> 3, ch = tid & 7;
    const int t = c * 128 + 2 * rp;
    const bf16* base = src + ((size_t)b * SEQ) * 512 + h * 64 + ch * 8;
#pragma unroll
    for (int j = 0; j < 5; ++j) { const int tt = t - 3 + j; R.x[j] = (tt >= 0) ? *(const u32x4*)(base + (size_t)tt * 512) : (u32x4){0u, 0u, 0u, 0u}; }
}
template <class F>
__device__ __forceinline__ void conv_emit(const ConvRegs& R, int tid, const float* convw, int chbase, int h, F emit) {
    const int rp = tid >> 3, ch = tid & 7;
    const float* wp = convw + chbase + h * 64 + ch * 8;
    f32x4 wa[4], wb[4];
#pragma unroll
    for (int j = 0; j < 4; ++j) { wa[j] = *(const f32x4*)(wp + j * 1024); wb[j] = *(const f32x4*)(wp + j * 1024 + 4); }
#pragma unroll
    for (int k = 0; k < 2; ++k) {
        float y[8];
#pragma unroll
        for (int e = 0; e < 8; ++e) y[e] = 0.f;
#pragma unroll
        for (int j = 0; j < 4; ++j) {
            const unsigned xw[4] = {R.x[k + j].x, R.x[k + j].y, R.x[k + j].z, R.x[k + j].w};
            y[0] += wa[j][0] * __uint_as_float(xw[0] << 16); y[1] += wa[j][1] * __uint_as_float(xw[0] & 0xffff0000u);
            y[2] += wa[j][2] * __uint_as_float(xw[1] << 16); y[3] += wa[j][3] * __uint_as_float(xw[1] & 0xffff0000u);
            y[4] += wb[j][0] * __uint_as_float(xw[2] << 16); y[5] += wb[j][1] * __uint_as_float(xw[2] & 0xffff0000u);
            y[6] += wb[j][2] * __uint_as_float(xw[3] << 16); y[7] += wb[j][3] * __uint_as_float(xw[3] & 0xffff0000u);
        }
        const f32x4 ya = {siluf_(y[0]), siluf_(y[1]), siluf_(y[2]), siluf_(y[3])}, yb = {siluf_(y[4]), siluf_(y[5]), siluf_(y[6]), siluf_(y[7])};
        emit(2 * rp + k, ch, ya, yb);
    }
}
__device__ __forceinline__ int tsw(int v, int s) { return v * LS + ((((s >> 3) ^ (v >> 3)) & 15) << 3) + (s & 7); }
__device__ __forceinline__ int tswb(int v, int cb) { return v * LS + (((cb ^ (v >> 3)) & 15) << 3); }
struct VRegs { u32x4 x[4]; };
__device__ __forceinline__ void v_load(VRegs& R, int tid, const bf16* MV, int b, int c, int h) {
    const bf16* base = MV + ((size_t)b * SEQ + c * 128) * 1024 + h * 128;
#pragma unroll
    for (int k = 0; k < 4; ++k) { const int task = tid + 512 * k, s = task >> 4, ch = task & 15; R.x[k] = LD_NT3((const u32x4*)(base + (size_t)s * 1024 + ch * 8)); }
}
__device__ __forceinline__ void v_store_t(const VRegs& R, int tid, LAS bf16* VT) {
#pragma unroll
    for (int k = 0; k < 4; ++k) {
        const int task = tid + 512 * k, s = task >> 4, ch = task & 15;
        const unsigned w[4] = {R.x[k].x, R.x[k].y, R.x[k].z, R.x[k].w};
#pragma unroll
        for (int i = 0; i < 4; ++i) { VT[tsw(ch * 8 + 2 * i, s)] = (bf16)(w[i] & 0xffffu); VT[tsw(ch * 8 + 2 * i + 1, s)] = (bf16)(w[i] >> 16); }
    }
    for (int i = tid; i < 16 * 128; i += 512) { const int r = 128 + (i >> 7), s = i & 127; VT[r * LS + s] = (r == 128) ? (bf16)0x3F80 : (bf16)0; }
}
__device__ __forceinline__ void scan_add2(float x0, float x1, int lane, float& i0, float& i1) {
    float incl = x0 + x1;
#pragma unroll
    for (int o = 1; o < 64; o <<= 1) { const float v = __shfl_up(incl, o); if (lane >= o) incl += v; }
    i1 = incl; i0 = incl - x1;
}
__device__ __forceinline__ void scan_max2(float x0, float x1, int lane, float& i0, float& i1) {
    float incl = fmaxf(x0, x1);
#pragma unroll
    for (int o = 1; o < 64; o <<= 1) { const float v = __shfl_up(incl, o); if (lane >= o) incl = fmaxf(incl, v); }
    const float prev = __shfl_up(incl, 1);
    i1 = incl; i0 = (lane == 0) ? x0 : fmaxf(prev, x0);
}

struct KvRegs { ConvRegs KR; VRegs VR; float f0, f1, i0, i1; };
__device__ __forceinline__ void mlstm_kv_load(const Params& p, KvRegs& R, int tid, int lane, int u) {
    const int c = u & 63, h = (u >> 6) & 7, b = u >> 9;
    const float* MI = (const float*)(p.ws + WS_MI); const float* MF = (const float*)(p.ws + WS_MF);
    const size_t tok0 = (size_t)b * SEQ + c * 128;
    conv_load(R.KR, tid, (const bf16*)(p.ws + WS_MK), b, c, h);
    v_load(R.VR, tid, (const bf16*)(p.ws + WS_MV), b, c, h);
    R.f0 = MF[(tok0 + 2 * lane) * 8 + h]; R.f1 = MF[(tok0 + 2 * lane + 1) * 8 + h];
    R.i0 = MI[(tok0 + 2 * lane) * 8 + h]; R.i1 = MI[(tok0 + 2 * lane + 1) * 8 + h];
}
__device__ __forceinline__ void mlstm_kv_phase(const Params& p, LAS unsigned char* lds) {
    int tid_ = threadIdx.x; asm volatile("" : "+v"(tid_));
    const int tid = tid_, lane = tid & 63, wave = __builtin_amdgcn_readfirstlane(tid >> 6), fr = lane & 15, fq = lane >> 4;
    LAS bf16* VT = (LAS bf16*)lds;
    LAS bf16* WKT = VT + 144 * LS;
    LAS float* wg = (LAS float*)(WKT + 64 * LS);
    KvRegs R;
    int u = blockIdx.x;
    if (u < NUNIT_M) mlstm_kv_load(p, R, tid, lane, u);
#pragma unroll 1
    for (; u < NUNIT_M; u += gridDim.x) {
        const int h = (u >> 6) & 7;
        if (wave == 0) {
            const float lf0 = logsigmoidf_(R.f0), lf1 = logsigmoidf_(R.f1);
            const float i0 = R.i0, i1 = R.i1;
            float b0, b1; scan_add2(lf0, lf1, lane, b0, b1);
            const float blast = __shfl(b1, 63);
            const float g0 = blast - b0 + i0, g1 = blast - b1 + i1;
            const float gmax = wave_max(fmaxf(g0, g1));
            wg[2 * lane] = __expf(g0 - gmax); wg[2 * lane + 1] = __expf(g1 - gmax);
            if (lane == 0) { float* dsc = (float*)(p.ws + WS_DSC) + (size_t)u * 2; dsc[0] = blast; dsc[1] = gmax; }
        }
        __syncthreads();
        conv_emit(R.KR, tid, p.in[3], 512, h, [&](int r, int ch, f32x4 ya, f32x4 yb) { const float w = wg[r];
#pragma unroll
            for (int e = 0; e < 4; ++e) { WKT[tsw(ch * 8 + e, r)] = (bf16)f2bf(ya[e] * w); WKT[tsw(ch * 8 + 4 + e, r)] = (bf16)f2bf(yb[e] * w); } });
        v_store_t(R.VR, tid, VT);
        __syncthreads();
        if (u + (int)gridDim.x < NUNIT_M) { int tl_ = tid; asm volatile("" : "+v"(tl_));
            mlstm_kv_load(p, R, tl_, tl_ & 63, u + gridDim.x); }
        bf16* DC = (bf16*)((unsigned char*)p.out + DO_DC) + (size_t)u * 128 * 64;
        float* DN = (float*)(p.ws + WS_DN) + (size_t)u * 64;
#ifdef MKV_SGB
        {
#pragma unroll
            for (int ct = 0; ct < 4; ++ct) {
                f32x4 acc = {0.f, 0.f, 0.f, 0.f};
#pragma unroll
                for (int kk = 0; kk < 4; ++kk) acc = mfma16(WKT + tswb(ct * 16 + fr, kk * 4 + fq), VT + tswb(wave * 16 + fr, kk * 4 + fq), acc);
                *(u32x2*)(DC + (size_t)(wave * 16 + fr) * 64 + ct * 16 + 4 * fq) = (u32x2){pk2(acc[0], acc[1]), pk2(acc[2], acc[3])};
            }
            __builtin_amdgcn_sched_group_barrier(0x100, 4 + MKV_SGB, 0);
#pragma unroll
            for (int g = 0; g < 16; ++g) { __builtin_amdgcn_sched_group_barrier(0x8, 1, 0); __builtin_amdgcn_sched_group_barrier(0x100, 1, 0); }
        }
#elif defined(MKV_BATCH)
        {
            bf16x8 bv[4], av[4][4];
#pragma unroll
            for (int kk = 0; kk < 4; ++kk) bv[kk] = *(const LAS bf16x8*)(VT + tswb(wave * 16 + fr, kk * 4 + fq));
#pragma unroll
            for (int ct = 0; ct < 4; ++ct)
#pragma unroll
                for (int kk = 0; kk < 4; ++kk) av[ct][kk] = *(const LAS bf16x8*)(WKT + tswb(ct * 16 + fr, kk * 4 + fq));
#pragma unroll
            for (int ct = 0; ct < 4; ++ct) {
                f32x4 acc = {0.f, 0.f, 0.f, 0.f};
#pragma unroll
                for (int kk = 0; kk < 4; ++kk) acc = __builtin_amdgcn_mfma_f32_16x16x32_bf16(av[ct][kk], bv[kk], acc, 0, 0, 0);
                *(u32x2*)(DC + (size_t)(wave * 16 + fr) * 64 + ct * 16 + 4 * fq) = (u32x2){pk2(acc[0], acc[1]), pk2(acc[2], acc[3])};
            }
        }
#else
#pragma unroll
        for (int ct = 0; ct < 4; ++ct) {
            f32x4 acc = {0.f, 0.f, 0.f, 0.f};
#pragma unroll
            for (int kk = 0; kk < 4; ++kk) acc = mfma16(WKT + tswb(ct * 16 + fr, kk * 4 + fq), VT + tswb(wave * 16 + fr, kk * 4 + fq), acc);
            *(u32x2*)(DC + (size_t)(wave * 16 + fr) * 64 + ct * 16 + 4 * fq) = (u32x2){pk2(acc[0], acc[1]), pk2(acc[2], acc[3])};
        }
#endif
        if (wave == 0) {
#pragma unroll
            for (int ct = 0; ct < 4; ++ct) {
                f32x4 acc = {0.f, 0.f, 0.f, 0.f};
#pragma unroll
                for (int kk = 0; kk < 4; ++kk) acc = mfma16(WKT + tswb(ct * 16 + fr, kk * 4 + fq), VT + (128 + fr) * LS + kk * 32 + 8 * fq, acc);
                if (fr == 0) *(f32x4*)(DN + ct * 16 + 4 * fq) = acc;
            }
        }
        __syncthreads();
    }
}

__device__ __forceinline__ void mlstm_scan(const Params& p) {
    int tid_ = threadIdx.x; asm volatile("" : "+v"(tid_));
    const int tid = tid_;
    for (int w = blockIdx.x; w < NB * 8 * 8; w += gridDim.x) {
        const int bh = w >> 3, part = w & 7;
        const unsigned* DC = (const unsigned*)((unsigned char*)p.out + DO_DC);
        const float* DN = (const float*)(p.ws + WS_DN);
        const float* DSC = (const float*)(p.ws + WS_DSC);
        bf16* CST = (bf16*)(p.ws + WS_CST);
        float* MC = (float*)(p.ws + WS_MC);
        const int e0 = part * 1024 + 2 * tid, e1 = e0 + 1;
        const bool hasn = (part == 0 && tid < 64);
        float c0 = 0.f, c1 = 0.f, nn = 0.f, m = 0.f;
        float d0n[8], d1n[8], dnn[8], bln[8], gmn[8];
#pragma unroll
        for (int k = 0; k < 8; ++k) {
            const size_t u = (size_t)bh * 64 + k;
            { const unsigned w_ = LD_NT2(DC + ((u * 8192 + e0) >> 1)); d0n[k] = __uint_as_float(w_ << 16); d1n[k] = __uint_as_float(w_ & 0xffff0000u); } dnn[k] = hasn ? DN[u * 64 + tid] : 0.f;
            bln[k] = DSC[u * 2]; gmn[k] = DSC[u * 2 + 1];
        }
#pragma unroll 1
        for (int cb = 0; cb < NCHUNK; cb += 8) {
            float d0[8], d1[8], dn[8], bl[8], gm[8];
#pragma unroll
            for (int k = 0; k < 8; ++k) { d0[k] = d0n[k]; d1[k] = d1n[k]; dn[k] = dnn[k]; bl[k] = bln[k]; gm[k] = gmn[k]; }
            if (cb + 8 < NCHUNK) {
#pragma unroll
                for (int k = 0; k < 8; ++k) {
                    const size_t u = (size_t)bh * 64 + cb + 8 + k;
                    { const unsigned w_ = LD_NT2(DC + ((u * 8192 + e0) >> 1)); d0n[k] = __uint_as_float(w_ << 16); d1n[k] = __uint_as_float(w_ & 0xffff0000u); } dnn[k] = hasn ? DN[u * 64 + tid] : 0.f;
                    bln[k] = DSC[u * 2]; gmn[k] = DSC[u * 2 + 1];
                }
            }
#pragma unroll
            for (int k = 0; k < 8; ++k) {
                const size_t u = (size_t)bh * 64 + cb + k;
                bf16* cs = CST + u * 144 * 64;
                *(unsigned*)(cs + e0) = pk2(c0, c1); (void)e1;
                if (hasn) cs[128 * 64 + tid] = (bf16)f2bf(nn);
                if (part == 0 && tid == 0) MC[u] = m;
                const float mn = fmaxf(bl[k] + m, gm[k]);
                const float a = __expf(bl[k] + m - mn), s = __expf(gm[k] - mn);
                c0 = a * c0 + s * d0[k]; c1 = a * c1 + s * d1[k]; nn = a * nn + s * dn[k];
                m = mn;
            }
        }
    }
}

struct OutRegs { ConvRegs QR, KR; VRegs VR; u32x4 cst[3]; float lf0, lf1, i0, i1, mc, cw; };
__device__ __forceinline__ void mlstm_out_load(const Params& p, OutRegs& R, int tid, int lane, int u) {
    const int c = u & 63, h = (u >> 6) & 7, b = u >> 9;
    const float* MI = (const float*)(p.ws + WS_MI); const float* MF = (const float*)(p.ws + WS_MF);
    const size_t tok0 = (size_t)b * SEQ + c * 128;
    conv_load(R.QR, tid, (const bf16*)(p.ws + WS_MQ), b, c, h);
    conv_load(R.KR, tid, (const bf16*)(p.ws + WS_MK), b, c, h);
    v_load(R.VR, tid, (const bf16*)(p.ws + WS_MV), b, c, h);
    const bf16* cs = (const bf16*)(p.ws + WS_CST) + (size_t)u * 144 * 64;
#pragma unroll
    for (int k = 0; k < 3; ++k) { const int i = tid + 512 * k; R.cst[k] = (i < 129 * 8) ? LD_NT2((const u32x4*)(cs + (size_t)i * 8)) : (u32x4){0u, 0u, 0u, 0u}; }
    R.lf0 = MF[(tok0 + 2 * lane) * 8 + h]; R.lf1 = MF[(tok0 + 2 * lane + 1) * 8 + h];
    R.i0 = MI[(tok0 + 2 * lane) * 8 + h]; R.i1 = MI[(tok0 + 2 * lane + 1) * 8 + h];
    R.mc = ((const float*)(p.ws + WS_MC))[u];
    { const int cc = tid & 127; R.cw = p.in[3][(tid >> 7) * 1024 + ((cc < 64) ? (h * 64 + cc) : (512 + h * 64 + cc - 64))]; }
}
template <class F>
__device__ __forceinline__ void conv_emit_lds(const ConvRegs& R, int tid, const LAS float* cwl, int kofs, F emit) {
    const int rp = tid >> 3, ch = tid & 7;
    f32x4 wa[4], wb[4];
#pragma unroll
    for (int j = 0; j < 4; ++j) { wa[j] = *(const LAS f32x4*)(cwl + j * 128 + kofs + ch * 8); wb[j] = *(const LAS f32x4*)(cwl + j * 128 + kofs + ch * 8 + 4); }
#pragma unroll
    for (int k = 0; k < 2; ++k) {
        float y[8];
#pragma unroll
        for (int e = 0; e < 8; ++e) y[e] = 0.f;
#pragma unroll
        for (int j = 0; j < 4; ++j) {
            const unsigned xw[4] = {R.x[k + j].x, R.x[k + j].y, R.x[k + j].z, R.x[k + j].w};
            y[0] += wa[j][0] * __uint_as_float(xw[0] << 16); y[1] += wa[j][1] * __uint_as_float(xw[0] & 0xffff0000u);
            y[2] += wa[j][2] * __uint_as_float(xw[1] << 16); y[3] += wa[j][3] * __uint_as_float(xw[1] & 0xffff0000u);
            y[4] += wb[j][0] * __uint_as_float(xw[2] << 16); y[5] += wb[j][1] * __uint_as_float(xw[2] & 0xffff0000u);
            y[6] += wb[j][2] * __uint_as_float(xw[3] << 16); y[7] += wb[j][3] * __uint_as_float(xw[3] & 0xffff0000u);
        }
        const f32x4 ya = {siluf_(y[0]), siluf_(y[1]), siluf_(y[2]), siluf_(y[3])}, yb = {siluf_(y[4]), siluf_(y[5]), siluf_(y[6]), siluf_(y[7])};
        emit(2 * rp + k, ch, ya, yb);
    }
}
__device__ __forceinline__ void mlstm_out_phase(const Params& p, LAS unsigned char* lds) {
    int tid_ = threadIdx.x; asm volatile("" : "+v"(tid_));
    const int tid = tid_, lane = tid & 63, wave = __builtin_amdgcn_readfirstlane(tid >> 6), fr = lane & 15, fq = lane >> 4;
    LAS bf16* Qs = (LAS bf16*)lds;
    LAS bf16* Ks = Qs + 128 * LQ;
    LAS bf16* VT = Ks + 128 * LQ;
    LAS bf16* Pm = VT + 144 * LS;
    LAS bf16* CT = Pm + 128 * LS;
    LAS float* fs = (LAS float*)(CT + 144 * LQ);
    LAS float* as_ = fs, *bsm = fs + 128, *wint = fs + 256, *nfl = fs + 384;
    LAS float* cwl = fs + 512;
    OutRegs R;
#ifdef MOU_DB
    OutRegs RN;
#endif
    int u = blockIdx.x;
    if (u < NUNIT_M) mlstm_out_load(p, R, tid, lane, u);
#ifdef MOU_STAGGER
    if (blockIdx.x & 1) { for (int i_ = 0; i_ < MOU_STAGGER; ++i_) __builtin_amdgcn_s_sleep(127); }
#endif
#pragma unroll 1
    for (; u < NUNIT_M; u += gridDim.x) {
        const int c = u & 63, h = (u >> 6) & 7, b = u >> 9;
        const size_t tok0 = (size_t)b * SEQ + c * 128;
#ifdef MOU_DB
        if (u + (int)gridDim.x < NUNIT_M) { int tl_ = tid; asm volatile("" : "+v"(tl_));
            mlstm_out_load(p, RN, tl_, tl_ & 63, u + gridDim.x); }
#endif
        if (wave == 0) {
            const float mc = R.mc;
            const float lf0 = logsigmoidf_(R.lf0), lf1 = logsigmoidf_(R.lf1);
            const float i0 = R.i0, i1 = R.i1;
            float b0, b1; scan_add2(lf0, lf1, lane, b0, b1);
            const float a0 = i0 - b0, a1 = i1 - b1;
            float pm0, pm1; scan_max2(a0, a1, lane, pm0, pm1);
            const float mt0 = fmaxf(b0 + mc, b0 + pm0), mt1 = fmaxf(b1 + mc, b1 + pm1);
            as_[2 * lane] = a0; as_[2 * lane + 1] = a1;
            bsm[2 * lane] = b0 - mt0; bsm[2 * lane + 1] = b1 - mt1;
            wint[2 * lane] = __expf(b0 + mc - mt0); wint[2 * lane + 1] = __expf(b1 + mc - mt1);
            nfl[2 * lane] = __expf(-mt0); nfl[2 * lane + 1] = __expf(-mt1);
        }
#ifdef MOU_CWL
        cwl[tid] = R.cw;
        __syncthreads();
        conv_emit_lds(R.QR, tid, cwl, 0, [&](int r, int ch, f32x4 ya, f32x4 yb) { ya = ya * 0.125f; yb = yb * 0.125f;
            *(LAS u32x4*)(Qs + r * LQ + ch * 8) = (u32x4){pk2(ya[0], ya[1]), pk2(ya[2], ya[3]), pk2(yb[0], yb[1]), pk2(yb[2], yb[3])}; });
        conv_emit_lds(R.KR, tid, cwl, 64, [&](int r, int ch, f32x4 ya, f32x4 yb) {
            *(LAS u32x4*)(Ks + r * LQ + ch * 8) = (u32x4){pk2(ya[0], ya[1]), pk2(ya[2], ya[3]), pk2(yb[0], yb[1]), pk2(yb[2], yb[3])}; });
#else
        conv_emit(R.QR, tid, p.in[3], 0, h, [&](int r, int ch, f32x4 ya, f32x4 yb) { ya = ya * 0.125f; yb = yb * 0.125f;
            *(LAS u32x4*)(Qs + r * LQ + ch * 8) = (u32x4){pk2(ya[0], ya[1]), pk2(ya[2], ya[3]), pk2(yb[0], yb[1]), pk2(yb[2], yb[3])}; });
        conv_emit(R.KR, tid, p.in[3], 512, h, [&](int r, int ch, f32x4 ya, f32x4 yb) {
            *(LAS u32x4*)(Ks + r * LQ + ch * 8) = (u32x4){pk2(ya[0], ya[1]), pk2(ya[2], ya[3]), pk2(yb[0], yb[1]), pk2(yb[2], yb[3])}; });
#endif
        v_store_t(R.VR, tid, VT);
#pragma unroll
        for (int k = 0; k < 3; ++k) { const int i = tid + 512 * k; if (i < 144 * 8) { const int r = i >> 3, ch = i & 7; *(LAS u32x4*)(CT + r * LQ + ch * 8) = R.cst[k]; } }
        __syncthreads();
#ifndef MOU_DB
        if (u + (int)gridDim.x < NUNIT_M) { int tl_ = tid; asm volatile("" : "+v"(tl_));
            mlstm_out_load(p, R, tl_, tl_ & 63, u + gridDim.x); }
#endif
        const int j = wave * 16 + fr;
        const float bsmj = bsm[j];
#ifdef MOU_UNROLL
#pragma unroll MOU_UNROLL
#else
#pragma unroll 1
#endif
        for (int ct = 0; ct < 8; ++ct) {
            f32x4 acc = {0.f, 0.f, 0.f, 0.f};
#ifdef MOU_NOBR
            {
#else
            if (ct <= wave) {
#endif
#pragma unroll
                for (int kk = 0; kk < 2; ++kk) acc = mfma16(Ks + (ct * 16 + fr) * LQ + kk * 32 + 8 * fq, Qs + (wave * 16 + fr) * LQ + kk * 32 + 8 * fq, acc);
            }
            const int s0 = ct * 16 + 4 * fq; const f32x4 a4 = *(const LAS f32x4*)(as_ + s0);
            float v[4];
#pragma unroll
            for (int r = 0; r < 4; ++r) v[r] = (s0 + r <= j) ? acc[r] * __expf(bsmj + a4[r]) : 0.f;
            *(LAS u32x2*)(Pm + j * LS + s0) = (u32x2){pk2(v[0], v[1]), pk2(v[2], v[3])};
        }
        asm volatile("s_waitcnt lgkmcnt(0)" ::: "memory");
        const float wj = wint[j];
        const bf16* MO = (const bf16*)(p.ws + WS_MO); bf16* YM = (bf16*)((unsigned char*)p.out + DO_YM);
        const size_t rowoff = (tok0 + j) * 1024 + h * 128 + 4 * fq;
#ifdef MOU_MOPF
        u32x2 mov[8];
#pragma unroll
        for (int ct = 0; ct < 8; ++ct) mov[ct] = LD_NT3((const u32x2*)(MO + rowoff + ct * 16));
#endif
        f32x4 o[9];
#ifndef MOU_SB
#define MOU_SB __builtin_amdgcn_sched_barrier(0)
#endif
#ifdef MOU_SGB
        {
#pragma unroll
            for (int ct = 0; ct < 9; ++ct) {
                f32x4 acc = {0.f, 0.f, 0.f, 0.f};
#pragma unroll
                for (int kk = 0; kk < 2; ++kk) acc = mfma16(CT + (ct * 16 + fr) * LQ + kk * 32 + 8 * fq, Qs + (wave * 16 + fr) * LQ + kk * 32 + 8 * fq, acc);
                acc = acc * wj;
#pragma unroll
                for (int kk = 0; kk < 4; ++kk) acc = mfma16(VT + (ct < 8 ? tswb(ct * 16 + fr, kk * 4 + fq) : (128 + fr) * LS + kk * 32 + 8 * fq), Pm + (wave * 16 + fr) * LS + kk * 32 + 8 * fq, acc);
                o[ct] = acc;
            }
            __builtin_amdgcn_sched_group_barrier(0x100, 6 + MOU_SGB, 0);
#pragma unroll
            for (int g = 0; g < 54; ++g) { __builtin_amdgcn_sched_group_barrier(0x8, 1, 0); __builtin_amdgcn_sched_group_barrier(0x100, 1, 0); }
        }
#elif defined(MOU_BATCH)
        {
            bf16x8 bq[2], bp[4];
#pragma unroll
            for (int kk = 0; kk < 2; ++kk) bq[kk] = *(const LAS bf16x8*)(Qs + (wave * 16 + fr) * LQ + kk * 32 + 8 * fq);
#pragma unroll
            for (int kk = 0; kk < 4; ++kk) bp[kk] = *(const LAS bf16x8*)(Pm + (wave * 16 + fr) * LS + kk * 32 + 8 * fq);
#if MOU_BATCH == 2
#define MOU_LDA(ct_, A_) do { _Pragma("unroll") for (int kk = 0; kk < 2; ++kk) A_[kk] = *(const LAS bf16x8*)(CT + ((ct_) * 16 + fr) * LQ + kk * 32 + 8 * fq); \
                _Pragma("unroll") for (int kk = 0; kk < 4; ++kk) A_[2 + kk] = *(const LAS bf16x8*)(VT + ((ct_) < 8 ? tswb((ct_) * 16 + fr, kk * 4 + fq) : (128 + fr) * LS + kk * 32 + 8 * fq)); } while (0)
            bf16x8 an[6];
            MOU_LDA(0, an);
#pragma unroll
            for (int ct = 0; ct < 9; ++ct) {
                bf16x8 a[6];
#pragma unroll
                for (int i = 0; i < 6; ++i) a[i] = an[i];
                if (ct < 8) MOU_LDA(ct + 1, an);
                f32x4 acc = {0.f, 0.f, 0.f, 0.f};
#pragma unroll
                for (int kk = 0; kk < 2; ++kk) acc = __builtin_amdgcn_mfma_f32_16x16x32_bf16(a[kk], bq[kk], acc, 0, 0, 0);
                acc = acc * wj;
#pragma unroll
                for (int kk = 0; kk < 4; ++kk) acc = __builtin_amdgcn_mfma_f32_16x16x32_bf16(a[2 + kk], bp[kk], acc, 0, 0, 0);
                o[ct] = acc;
                MOU_SB;
            }
#undef MOU_LDA
#else
#pragma unroll
            for (int ct = 0; ct < 9; ++ct) {
                bf16x8 a[3];
#pragma unroll
                for (int kk = 0; kk < 2; ++kk) a[kk] = *(const LAS bf16x8*)(CT + (ct * 16 + fr) * LQ + kk * 32 + 8 * fq);
                a[2] = *(const LAS bf16x8*)(VT + (ct < 8 ? tswb(ct * 16 + fr, fq) : (128 + fr) * LS + 8 * fq));
                MOU_SB;
                f32x4 acc = {0.f, 0.f, 0.f, 0.f};
#pragma unroll
                for (int kk = 0; kk < 2; ++kk) acc = __builtin_amdgcn_mfma_f32_16x16x32_bf16(a[kk], bq[kk], acc, 0, 0, 0);
                acc = acc * wj;
                acc = __builtin_amdgcn_mfma_f32_16x16x32_bf16(a[2], bp[0], acc, 0, 0, 0);
#pragma unroll
                for (int kk = 1; kk < 4; ++kk) a[kk - 1] = *(const LAS bf16x8*)(VT + (ct < 8 ? tswb(ct * 16 + fr, kk * 4 + fq) : (128 + fr) * LS + kk * 32 + 8 * fq));
                MOU_SB;
#pragma unroll
                for (int kk = 1; kk < 4; ++kk) acc = __builtin_amdgcn_mfma_f32_16x16x32_bf16(a[kk - 1], bp[kk], acc, 0, 0, 0);
                o[ct] = acc;
            }
#endif
        }
#else
#pragma unroll
        for (int ct = 0; ct < 9; ++ct) {
            f32x4 acc = {0.f, 0.f, 0.f, 0.f};
#pragma unroll
            for (int kk = 0; kk < 2; ++kk) acc = mfma16(CT + (ct * 16 + fr) * LQ + kk * 32 + 8 * fq, Qs + (wave * 16 + fr) * LQ + kk * 32 + 8 * fq, acc);
            acc = acc * wj;
#pragma unroll
            for (int kk = 0; kk < 4; ++kk) acc = mfma16(VT + (ct < 8 ? tswb(ct * 16 + fr, kk * 4 + fq) : (128 + fr) * LS + kk * 32 + 8 * fq), Pm + (wave * 16 + fr) * LS + kk * 32 + 8 * fq, acc);
            o[ct] = acc;
        }
#endif
        const float den = __shfl(o[8][0], fr);
        const float rden = rcpf_(fmaxf(fabsf(den), nfl[j]));
        float s = 0.f;
#pragma unroll
        for (int ct = 0; ct < 8; ++ct) { o[ct] = o[ct] * rden; s += (o[ct][0] + o[ct][1]) + (o[ct][2] + o[ct][3]); }
        s += __shfl_xor(s, 16); s += __shfl_xor(s, 32);
        const float mean = s * (1.0f / 128.0f);
        float q = 0.f;
#pragma unroll
        for (int ct = 0; ct < 8; ++ct) { const f32x4 d = o[ct] - mean; q += (d[0] * d[0] + d[1] * d[1]) + (d[2] * d[2] + d[3] * d[3]); }
        q += __shfl_xor(q, 16); q += __shfl_xor(q, 32);
        const float rstd = rsqrtf(q * (1.0f / 128.0f) + GN_EPS);
        const float* gain = p.in[4];
#pragma unroll
        for (int ct = 0; ct < 8; ++ct) {
            const f32x4 g4 = *(const f32x4*)(gain + h * 128 + ct * 16 + 4 * fq);
#ifdef MOU_MOPF
            const u32x2 mo = mov[ct];
#else
            const u32x2 mo = *(const u32x2*)(MO + rowoff + ct * 16);
#endif
            const f32x4 y = (o[ct] - mean) * rstd * g4;
            u32x2 w; w.x = pk2(y[0] * __uint_as_float(mo.x << 16), y[1] * __uint_as_float(mo.x & 0xffff0000u));
            w.y = pk2(y[2] * __uint_as_float(mo.y << 16), y[3] * __uint_as_float(mo.y & 0xffff0000u));
#ifdef SC1_YM
            st_sc1_8(YM + rowoff + ct * 16, w);
#else
            ST_NT3((u32x2*)(YM + rowoff + ct * 16), w);
#endif
        }
#ifdef MOU_DB
        R = RN;
#endif
        __syncthreads();
    }
}

#ifdef EPI_BATCH
struct EpiGate {
    static constexpr bool PERM = true, AFTER_DRAIN = false;
    const bf16* gate; bf16* out; int add;
    __device__ __forceinline__ void operator()(const f32x4 (&acc)[2][2][4][2], const pg8::Unit& u, int wr, int wc, int fr, int fq) const {
        const int row0 = u.pm * 256 + wr * 64 + fr, col0 = u.pn * 256 + wc * 32 + 8 * fq;
#pragma unroll
        for (int ai = 0; ai < 2; ++ai) {
            u32x4 gv[4][2], ov[4][2];
#pragma unroll
            for (int m = 0; m < 4; ++m)
#pragma unroll
                for (int bj = 0; bj < 2; ++bj) {
                    const size_t idx = (size_t)(row0 + ai * 128 + m * 16) * 1024 + col0 + bj * 128;
                    gv[m][bj] = LD_NT_GATE((const u32x4*)(gate + idx));
                    ov[m][bj] = add ? *(const u32x4*)(out + idx) : (u32x4){0u, 0u, 0u, 0u};
                }
            __builtin_amdgcn_sched_barrier(0);
#pragma unroll
            for (int m = 0; m < 4; ++m)
#pragma unroll
                for (int bj = 0; bj < 2; ++bj) {
                    const size_t idx = (size_t)(row0 + ai * 128 + m * 16) * 1024 + col0 + bj * 128;
                    const unsigned gw[4] = {gv[m][bj].x, gv[m][bj].y, gv[m][bj].z, gv[m][bj].w}, ow[4] = {ov[m][bj].x, ov[m][bj].y, ov[m][bj].z, ov[m][bj].w};
                    const f32x4 v0 = acc[ai][bj][m][0], v1 = acc[ai][bj][m][1];
                    float r[8] = {v0[0], v0[1], v0[2], v0[3], v1[0], v1[1], v1[2], v1[3]};
#pragma unroll
                    for (int i = 0; i < 4; ++i) { r[2 * i] = r[2 * i] * __uint_as_float(gw[i] << 16) + __uint_as_float(ow[i] << 16); r[2 * i + 1] = r[2 * i + 1] * __uint_as_float(gw[i] & 0xffff0000u) + __uint_as_float(ow[i] & 0xffff0000u); }
                    u32x4 w; w.x = pk2(r[0], r[1]); w.y = pk2(r[2], r[3]); w.z = pk2(r[4], r[5]); w.w = pk2(r[6], r[7]);
                    *(u32x4*)(out + idx) = w;
                }
        }
    }
};
#else
struct EpiGate {
    static constexpr bool PERM = true, AFTER_DRAIN = false;
    const bf16* gate; bf16* out; int add;
    __device__ __forceinline__ void operator()(const f32x4 (&acc)[2][2][4][2], const pg8::Unit& u, int wr, int wc, int fr, int fq) const {
        const int row0 = u.pm * 256 + wr * 64 + fr, col0 = u.pn * 256 + wc * 32 + 8 * fq;
#pragma unroll
        for (int ai = 0; ai < 2; ++ai)
#pragma unroll
            for (int m = 0; m < 4; ++m)
#pragma unroll
                for (int bj = 0; bj < 2; ++bj) {
                    const size_t idx = (size_t)(row0 + ai * 128 + m * 16) * 1024 + col0 + bj * 128;
                    const u32x4 gv = LD_NT_GATE((const u32x4*)(gate + idx));
                    const unsigned gw[4] = {gv.x, gv.y, gv.z, gv.w};
                    const f32x4 v0 = acc[ai][bj][m][0], v1 = acc[ai][bj][m][1];
                    float r[8] = {v0[0], v0[1], v0[2], v0[3], v1[0], v1[1], v1[2], v1[3]};
#pragma unroll
                    for (int i = 0; i < 4; ++i) { r[2 * i] *= __uint_as_float(gw[i] << 16); r[2 * i + 1] *= __uint_as_float(gw[i] & 0xffff0000u); }
                    if (add) {
                        const u32x4 ov = *(const u32x4*)(out + idx); const unsigned ow[4] = {ov.x, ov.y, ov.z, ov.w};
#pragma unroll
                        for (int i = 0; i < 4; ++i) { r[2 * i] += __uint_as_float(ow[i] << 16); r[2 * i + 1] += __uint_as_float(ow[i] & 0xffff0000u); }
                    }
                    u32x4 w; w.x = pk2(r[0], r[1]); w.y = pk2(r[2], r[3]); w.z = pk2(r[4], r[5]); w.w = pk2(r[6], r[7]);
#ifdef NT_MERGED
                    if (add) __builtin_nontemporal_store(w, (u32x4*)(out + idx)); else *(u32x4*)(out + idx) = w;
#else
                    *(u32x4*)(out + idx) = w;
#endif
                }
    }
};
#endif
__device__ __forceinline__ void phase_merge(const Params& p, LAS unsigned char* lds) {
    bf16* merged = (bf16*)(p.ws + WS_MERGED);
    pg8::StaticOrder S; S.init(T, 1024, gridDim.x, (int)blockIdx.x);
    { pg8::Gemm g{(const bf16*)(p.ws + WS_YA), (const bf16*)(p.ws + WS_WBA), T, 1024, 512};
      EpiGate E{(const bf16*)(p.ws + WS_GA), merged, 0};
      pg8::gemm_phase<EpiGate, pg8::StaticOrder, true, true>(lds, g, S, E); }
    __syncthreads();
    { pg8::Gemm g{(const bf16*)((unsigned char*)p.out + DO_YM), (const bf16*)(p.ws + WS_WBM), T, 1024, 1024};
      EpiGate E{(const bf16*)((unsigned char*)p.out + DO_GM), merged, 1};
      pg8::gemm_phase<EpiGate, pg8::StaticOrder, true, true>(lds, g, S, E); }
}

#ifdef EPI_BATCH
struct EpiOutRes {
    static constexpr bool PERM = true, AFTER_DRAIN = false;
    const float* x; bf16* out;
    __device__ __forceinline__ void operator()(const f32x4 (&acc)[2][2][4][2], const pg8::Unit& u, int wr, int wc, int fr, int fq) const {
        const int row0 = u.pm * 256 + wr * 64 + fr, col0 = u.pn * 256 + wc * 32 + 8 * fq;
#pragma unroll
        for (int ai = 0; ai < 2; ++ai) {
            f32x4 xa[4][2], xb[4][2];
#pragma unroll
            for (int m = 0; m < 4; ++m)
#pragma unroll
                for (int bj = 0; bj < 2; ++bj) {
                    const size_t idx = (size_t)(row0 + ai * 128 + m * 16) * 1024 + col0 + bj * 128;
                    xa[m][bj] = LD_NT_X((const f32x4*)(x + idx)); xb[m][bj] = LD_NT_X((const f32x4*)(x + idx + 4));
                }
            __builtin_amdgcn_sched_barrier(0);
#pragma unroll
            for (int m = 0; m < 4; ++m)
#pragma unroll
                for (int bj = 0; bj < 2; ++bj) {
                    const size_t idx = (size_t)(row0 + ai * 128 + m * 16) * 1024 + col0 + bj * 128;
                    const f32x4 v0 = xa[m][bj] * ALPHA + acc[ai][bj][m][0], v1 = xb[m][bj] * ALPHA + acc[ai][bj][m][1];
                    u32x4 w; w.x = pk2(v0[0], v0[1]); w.y = pk2(v0[2], v0[3]); w.z = pk2(v1[0], v1[1]); w.w = pk2(v1[2], v1[3]);
                    *(u32x4*)(out + idx) = w;
                }
        }
    }
};
#else
struct EpiOutRes {
    static constexpr bool PERM = true, AFTER_DRAIN = false;
    const float* x; bf16* out;
    __device__ __forceinline__ void operator()(const f32x4 (&acc)[2][2][4][2], const pg8::Unit& u, int wr, int wc, int fr, int fq) const {
        const int row0 = u.pm * 256 + wr * 64 + fr, col0 = u.pn * 256 + wc * 32 + 8 * fq;
#pragma unroll
        for (int ai = 0; ai < 2; ++ai)
#pragma unroll
            for (int m = 0; m < 4; ++m)
#pragma unroll
                for (int bj = 0; bj < 2; ++bj) {
                    const size_t idx = (size_t)(row0 + ai * 128 + m * 16) * 1024 + col0 + bj * 128;
                    const f32x4 x0 = LD_NT_X((const f32x4*)(x + idx)), x1 = LD_NT_X((const f32x4*)(x + idx + 4));
                    const f32x4 v0 = x0 * ALPHA + acc[ai][bj][m][0], v1 = x1 * ALPHA + acc[ai][bj][m][1];
                    u32x4 w; w.x = pk2(v0[0], v0[1]); w.y = pk2(v0[2], v0[3]); w.z = pk2(v1[0], v1[1]); w.w = pk2(v1[2], v1[3]);
#ifdef SC1_OUTRES
                    st_sc1_16(out + idx, w);
#elif defined(NT_OUTRES)
                    __builtin_nontemporal_store(w, (u32x4*)(out + idx));
#else
                    *(u32x4*)(out + idx) = w;
#endif
                }
    }
};
#endif
__device__ __forceinline__ void phase_outproj(const Params& p, LAS unsigned char* lds) {
    pg8::Gemm g{(const bf16*)(p.ws + WS_MERGED), (const bf16*)(p.ws + WS_WOUT), T, 1024, 1024};
    pg8::StaticOrder S; S.init(T, 1024, gridDim.x, (int)blockIdx.x);
    EpiOutRes E{p.in[0], (bf16*)p.out};
    pg8::gemm_phase<EpiOutRes, pg8::StaticOrder, true, true>(lds, g, S, E);
}

__device__ __forceinline__ void phase_ln1_route(const Params& p, LAS unsigned char* lds) {
    int tid_ = threadIdx.x; asm volatile("" : "+v"(tid_));
    const int tid = tid_, lane = tid & 63, wave = __builtin_amdgcn_readfirstlane(tid >> 6);
    LAS int* cnt = (LAS int*)lds;
    LAS int* base = cnt + 16;
    LAS int* info = base + 16;
    LAS float* infw = (LAS float*)(info + 512);
    const float* gain = p.in[8]; const float* bias = p.in[9];
    const float* Wg = p.in[10]; const float* bg = p.in[11]; const float* We = p.in[12]; const float* be = p.in[13];
    unsigned* cursor = (unsigned*)(p.ws + WS_CTL) + CW_CURSOR;
    for (int blk = blockIdx.x; blk < T / 128; blk += gridDim.x) {
        if (tid < 16) cnt[tid] = 0;
        __syncthreads();
        u32x2 rwn[4];
        { const u32x2* row = (const u32x2*)((const bf16*)p.out + ((size_t)blk * 128 + wave * 16) * 1024) + lane;
#pragma unroll
          for (int j = 0; j < 4; ++j) rwn[j] = LD_NT2(row + 64 * j); }
#pragma unroll 1
        for (int i = 0; i < 16; ++i) {
            const int tl = wave * 16 + i; const size_t tok = (size_t)blk * 128 + tl;
            u32x2 rwc[4];
#ifndef LN1_PF
            { const u32x2* row = (const u32x2*)((const bf16*)p.out + tok * 1024) + lane;
#pragma unroll
              for (int j = 0; j < 4; ++j) rwn[j] = LD_NT2(row + 64 * j); }
#endif
#pragma unroll
            for (int j = 0; j < 4; ++j) rwc[j] = rwn[j];
#ifdef LN1_PF
            { const u32x2* row = (const u32x2*)((const bf16*)p.out + ((size_t)blk * 128 + wave * 16 + min(i + 1, 15)) * 1024) + lane;
#pragma unroll
              for (int j = 0; j < 4; ++j) rwn[j] = LD_NT2(row + 64 * j); }
#endif
            f32x4 v[4]; float s = 0.f;
#pragma unroll
            for (int j = 0; j < 4; ++j) { const u32x2 rw = rwc[j];
                v[j] = (f32x4){__uint_as_float(rw.x << 16), __uint_as_float(rw.x & 0xffff0000u), __uint_as_float(rw.y << 16), __uint_as_float(rw.y & 0xffff0000u)};
                s += (v[j].x + v[j].y) + (v[j].z + v[j].w); }
            const float mean = wave_sum(s) * (1.f / 1024.f); float s2 = 0.f;
#pragma unroll
            for (int j = 0; j < 4; ++j) { v[j] = v[j] - mean; s2 += (v[j].x * v[j].x + v[j].y * v[j].y) + (v[j].z * v[j].z + v[j].w * v[j].w); }
            const float rstd = rsqrtf(wave_sum(s2) * (1.f / 1024.f) + LN_EPS);
            float lg[4] = {0.f, 0.f, 0.f, 0.f};
#pragma unroll
            for (int j = 0; j < 4; ++j) {
                const int e0 = (lane + 64 * j) * 4;
                const f32x4 g4 = *(const f32x4*)(gain + e0), b4 = *(const f32x4*)(bias + e0);
                v[j] = v[j] * rstd * g4 + b4;
#ifdef NT_X1B
                __builtin_nontemporal_store((u32x2){pk2(v[j].x, v[j].y), pk2(v[j].z, v[j].w)}, (u32x2*)((bf16*)(p.ws + WS_X1B) + tok * 1024) + lane + 64 * j);
#elif defined(SC1_X1B)
                st_sc1_8((unsigned long long*)((bf16*)(p.ws + WS_X1B) + tok * 1024) + lane + 64 * j, (u32x2){pk2(v[j].x, v[j].y), pk2(v[j].z, v[j].w)});
#else
                ((unsigned long long*)((bf16*)(p.ws + WS_X1B) + tok * 1024))[lane + 64 * j] = (unsigned long long)pk2(v[j].x, v[j].y) | ((unsigned long long)pk2(v[j].z, v[j].w) << 32);
#endif
                const float* wgj = Wg + (size_t)e0 * 4;
#pragma unroll
                for (int q = 0; q < 4; ++q) { const float xv = v[j][q]; const f32x4 wg4 = *(const f32x4*)(wgj + q * 4);
                    lg[0] += xv * wg4[0]; lg[1] += xv * wg4[1]; lg[2] += xv * wg4[2]; lg[3] += xv * wg4[3]; }
            }
#pragma unroll
            for (int k = 0; k < 4; ++k) lg[k] = wave_sum(lg[k]) + bg[k];
            int gs = 0; float gm = lg[0];
#pragma unroll
            for (int k = 1; k < 4; ++k) if (lg[k] > gm) { gm = lg[k]; gs = k; }
            float gsum = 0.f;
#pragma unroll
            for (int k = 0; k < 4; ++k) gsum += __expf(lg[k] - gm);
            const float gw = 1.0f / gsum;
            gs = __builtin_amdgcn_readfirstlane(gs);
            float el[4] = {0.f, 0.f, 0.f, 0.f};
#pragma unroll
            for (int j = 0; j < 4; ++j) {
                const float* wej = We + (size_t)(lane + 64 * j) * 64 + gs * 4;
#pragma unroll
                for (int q = 0; q < 4; ++q) { const float xv = v[j][q]; const f32x4 we4 = *(const f32x4*)(wej + q * 16);
                    el[0] += xv * we4[0]; el[1] += xv * we4[1]; el[2] += xv * we4[2]; el[3] += xv * we4[3]; }
            }
            { const f32x4 be4 = *(const f32x4*)(be + gs * 4);
#pragma unroll
              for (int k = 0; k < 4; ++k) el[k] = wave_sum(el[k]) + be4[k]; }
            int i0 = 0; float v0 = el[0];
#pragma unroll
            for (int k = 1; k < 4; ++k) if (el[k] > v0) { v0 = el[k]; i0 = k; }
            int i1 = -1; float v1 = -INFINITY;
#pragma unroll
            for (int k = 0; k < 4; ++k) if (k != i0 && el[k] > v1) { v1 = el[k]; i1 = k; }
            const float p1 = __expf(v1 - v0); const float w0 = gw / (1.f + p1), w1 = gw * p1 / (1.f + p1);
            if (lane == 0) {
                const int e0 = gs * 4 + i0, e1 = gs * 4 + i1;
                const int r0 = atomicAdd((int*)&cnt[e0], 1), r1 = atomicAdd((int*)&cnt[e1], 1);
                info[tl * 4 + 0] = e0; info[tl * 4 + 1] = r0; info[tl * 4 + 2] = e1; info[tl * 4 + 3] = r1;
                infw[tl * 2 + 0] = w0; infw[tl * 2 + 1] = w1;
            }
        }
        __syncthreads();
        if (tid < 16) base[tid] = (int)atomicAdd(&cursor[tid], (unsigned)cnt[tid]);
        __syncthreads();
        if (tid < 128) {
            const size_t tok = (size_t)blk * 128 + tid;
            int* te = (int*)(p.ws + WS_TE) + tok * 4; float* tw = (float*)(p.ws + WS_TW) + tok * 2;
            const int e0 = info[tid * 4 + 0], e1 = info[tid * 4 + 2];
            const int p0 = base[e0] + info[tid * 4 + 1], p1 = base[e1] + info[tid * 4 + 3];
            te[0] = e0; te[1] = p0; te[2] = e1; te[3] = p1;
            int* inv = (int*)(p.ws + WS_INV); inv[(size_t)e0 * T + p0] = (int)tok; inv[(size_t)e1 * T + p1] = (int)tok;
            tw[0] = infw[tid * 2 + 0]; tw[1] = infw[tid * 2 + 1];
        }
        __syncthreads();
    }
}

struct Segs {
    int st[17];
    __device__ __forceinline__ void init(const unsigned* cursor) {
        int a = 0;
#pragma unroll
        for (int e = 0; e < 16; ++e) { st[e] = a; a += ((int)cursor[e] + 255) & ~255; }
        st[16] = a;
    }
    __device__ __forceinline__ int start(int e) const {
        int r = 0;
#pragma unroll
        for (int k = 0; k < 16; ++k) r = (k == e) ? st[k] : r;
        return r;
    }
};

struct MoeOrder {
    Segs sg; int ntiles, R, x, slot;
    __device__ __forceinline__ void init(const unsigned* cursor, int G_, int c_) { sg.init(cursor); ntiles = sg.st[16] >> 8; R = (ntiles + 7) >> 3; x = c_ & 7; slot = c_ >> 3; (void)G_; }
    __device__ __forceinline__ bool next(int i, pg8::Unit& u) const {
        const int lu = i * 32 + slot;
        const int pm = x * R + (lu >> 2), j = lu & 3;
        if ((lu >> 2) >= R || pm >= ntiles) return false;
        int e = 0;
#pragma unroll
        for (int k = 1; k < 16; ++k) e += (sg.st[k] <= pm * 256) ? 1 : 0;
        u.pm = pm; u.pn = e * 4 + j; return true;
    }
    __device__ __forceinline__ void a_ready(const pg8::Unit&) const {}
    __device__ __forceinline__ void done(const pg8::Unit&) const {}
};
struct EpiSwiGLU {
    static constexpr bool PERM = true, AFTER_DRAIN = false;
    bf16* H;
    __device__ __forceinline__ void operator()(const f32x4 (&acc)[2][2][4][2], const pg8::Unit& u, int wr, int wc, int fr, int fq) const {
        const int row0 = u.pm * 256 + wr * 64 + fr, col0 = (u.pn & 3) * 128 + wc * 32 + 8 * fq;
#pragma unroll
        for (int ai = 0; ai < 2; ++ai)
#pragma unroll
            for (int m = 0; m < 4; ++m) {
                const f32x4 g0 = acc[ai][0][m][0], g1 = acc[ai][0][m][1], u0 = acc[ai][1][m][0], u1 = acc[ai][1][m][1];
                u32x4 w;
                w.x = pk2(siluf_(g0[0]) * u0[0], siluf_(g0[1]) * u0[1]); w.y = pk2(siluf_(g0[2]) * u0[2], siluf_(g0[3]) * u0[3]);
                w.z = pk2(siluf_(g1[0]) * u1[0], siluf_(g1[1]) * u1[1]); w.w = pk2(siluf_(g1[2]) * u1[2], siluf_(g1[3]) * u1[3]);
#ifdef NT_H
                __builtin_nontemporal_store(w, (u32x4*)(H + (size_t)(row0 + ai * 128 + m * 16) * 512 + col0));
#else
                *(u32x4*)(H + (size_t)(row0 + ai * 128 + m * 16) * 512 + col0) = w;
#endif
            }
    }
};
struct EpiPlain {
    static constexpr bool PERM = true, AFTER_DRAIN = false;
    bf16* Y;
    __device__ __forceinline__ void operator()(const f32x4 (&acc)[2][2][4][2], const pg8::Unit& u, int wr, int wc, int fr, int fq) const {
        const int row0 = u.pm * 256 + wr * 64 + fr, col0 = (u.pn & 3) * 256 + wc * 32 + 8 * fq;
#pragma unroll
        for (int ai = 0; ai < 2; ++ai)
#pragma unroll
            for (int m = 0; m < 4; ++m)
#pragma unroll
                for (int bj = 0; bj < 2; ++bj) {
                    const f32x4 v0 = acc[ai][bj][m][0], v1 = acc[ai][bj][m][1];
                    u32x4 w; w.x = pk2(v0[0], v0[1]); w.y = pk2(v0[2], v0[3]); w.z = pk2(v1[0], v1[1]); w.w = pk2(v1[2], v1[3]);
#ifdef Y_DEFAULT
                    *(u32x4*)(Y + (size_t)(row0 + ai * 128 + m * 16) * 1024 + col0 + bj * 128) = w;
#else
                    ST_NT2((u32x4*)(Y + (size_t)(row0 + ai * 128 + m * 16) * 1024 + col0 + bj * 128), w);
#endif
                }
    }
};
constexpr int MOE_TOKL = 131072;
__device__ __forceinline__ void phase_moe_up(const Params& p, LAS unsigned char* lds) {
    int tid_ = threadIdx.x; asm volatile("" : "+v"(tid_));
    MoeOrder S; S.init((const unsigned*)(p.ws + WS_CTL) + CW_CURSOR, gridDim.x, (int)blockIdx.x);
    LAS int* tokL = (LAS int*)(lds + MOE_TOKL);
    {
        const unsigned* cursor = (const unsigned*)(p.ws + WS_CTL) + CW_CURSOR; const int* inv = (const int*)(p.ws + WS_INV);
        pg8::Unit u;
        for (int i = 0; i < 8 && S.next(i, u); ++i) {
            const int e = u.pn >> 2, st = S.sg.start(e), cnt = (int)cursor[e];
            if (tid_ < 256) { const int slot = u.pm * 256 + tid_ - st; tokL[i * 256 + tid_] = (slot < cnt) ? inv[(size_t)e * T + slot] : 0; }
        }
        __syncthreads();
    }
    pg8::Gemm g{(const bf16*)(p.ws + WS_X1B), (const bf16*)(p.ws + WS_WGU), T, 16 * 1024, 1024};
    EpiSwiGLU E{(bf16*)(p.ws + WS_H)};
    pg8::gemm_phase<EpiSwiGLU, MoeOrder, true, true, true>(lds, g, S, E, tokL);
}
__device__ __forceinline__ void phase_moe_down(const Params& p, LAS unsigned char* lds) {
    pg8::Gemm g{(const bf16*)(p.ws + WS_H), (const bf16*)(p.ws + WS_WD), MOE_MAXROWS, 16 * 1024, 512};
    MoeOrder S; S.init((const unsigned*)(p.ws + WS_CTL) + CW_CURSOR, gridDim.x, (int)blockIdx.x);
    EpiPlain E{(bf16*)(p.ws + WS_Y)};
    pg8::gemm_phase<EpiPlain, MoeOrder, true, true>(lds, g, S, E);
}

__device__ __forceinline__ void phase_final(const Params& p) {
    int tid_ = threadIdx.x; asm volatile("" : "+v"(tid_));
    const int tid = tid_, lane = tid & 63, wave = tid >> 6;
    const float* gain = p.in[17]; const float* bias = p.in[18];
    const bf16* Y = (const bf16*)(p.ws + WS_Y);
    Segs sg; sg.init((const unsigned*)(p.ws + WS_CTL) + CW_CURSOR);
#if defined(CHECK_YA)
    const bool poison = __uint_as_float(__hip_atomic_load((unsigned*)(p.ws + WS_CTL) + CW_MISMATCH, __ATOMIC_RELAXED, __HIP_MEMORY_SCOPE_AGENT)) > CHECK_YA;
#elif defined(CHECK_MASK)
    const bool poison = __hip_atomic_load((unsigned*)(p.ws + WS_CTL) + CW_MISMATCH, __ATOMIC_RELAXED, __HIP_MEMORY_SCOPE_AGENT) > (unsigned)CHECK_MASK;
#else
    const bool poison = false;
#endif
    const int step = gridDim.x * 8, tok0 = blockIdx.x * 8 + wave;
    const int* TE = (const int*)(p.ws + WS_TE); const float* TW = (const float*)(p.ws + WS_TW);
    const bf16* X1 = (const bf16*)(p.ws + WS_X1B);
#define FIN_TE(t_, E_, W_) do { const int tc_ = min((t_), T - 1); E_ = *(const u32x4*)(TE + (size_t)tc_ * 4); W_ = *(const f32x2*)(TW + (size_t)tc_ * 2); } while (0)
#ifdef FIN_WIDE
#define FIN_ROWS(t_, E_, XW_, YA_, YB_) do { const int tc_ = min((t_), T - 1); \
        const int g0_ = sg.start((int)E_.x) + (int)E_.y, g1_ = sg.start((int)E_.z) + (int)E_.w; \
        const u32x4* xr_ = (const u32x4*)(X1 + (size_t)tc_ * 1024) + lane; \
        const u32x4* y0_ = (const u32x4*)(Y + (size_t)g0_ * 1024) + lane; const u32x4* y1_ = (const u32x4*)(Y + (size_t)g1_ * 1024) + lane; \
        _Pragma("unroll") for (int j = 0; j < 2; ++j) { XW_[j] = LD_NT_FIN(xr_ + 64 * j); YA_[j] = LD_NT_FIN(y0_ + 64 * j); YB_[j] = LD_NT_FIN(y1_ + 64 * j); } } while (0)
    u32x4 e_cur, e_nxt; f32x2 w_cur, w_nxt;
    u32x4 xw[2], ya[2], yb[2];
    FIN_TE(tok0, e_cur, w_cur);
    FIN_TE(tok0 + step, e_nxt, w_nxt);
    FIN_ROWS(tok0, e_cur, xw, ya, yb);
#pragma unroll 1
    for (int tok = tok0; tok < T; tok += step) {
        u32x4 e_n2; f32x2 w_n2; FIN_TE(tok + 2 * step, e_n2, w_n2);
        u32x4 xn[2], yan[2], ybn[2]; FIN_ROWS(tok + step, e_nxt, xn, yan, ybn);
        const float w0 = w_cur[0], w1 = w_cur[1];
        f32x4* row = (f32x4*)(p.out + (size_t)tok * 1024);
        f32x4 v[4]; float s = 0.f;
#pragma unroll
        for (int j = 0; j < 2; ++j) {
            const unsigned xa[4] = {xw[j].x, xw[j].y, xw[j].z, xw[j].w}, aa[4] = {ya[j].x, ya[j].y, ya[j].z, ya[j].w}, ba[4] = {yb[j].x, yb[j].y, yb[j].z, yb[j].w};
#pragma unroll
            for (int hq = 0; hq < 2; ++hq) {
                f32x4 o;
                o.x = __uint_as_float(xa[2 * hq] << 16) * ALPHA + (w0 * __uint_as_float(aa[2 * hq] << 16) + w1 * __uint_as_float(ba[2 * hq] << 16));
                o.y = __uint_as_float(xa[2 * hq] & 0xffff0000u) * ALPHA + (w0 * __uint_as_float(aa[2 * hq] & 0xffff0000u) + w1 * __uint_as_float(ba[2 * hq] & 0xffff0000u));
                o.z = __uint_as_float(xa[2 * hq + 1] << 16) * ALPHA + (w0 * __uint_as_float(aa[2 * hq + 1] << 16) + w1 * __uint_as_float(ba[2 * hq + 1] << 16));
                o.w = __uint_as_float(xa[2 * hq + 1] & 0xffff0000u) * ALPHA + (w0 * __uint_as_float(aa[2 * hq + 1] & 0xffff0000u) + w1 * __uint_as_float(ba[2 * hq + 1] & 0xffff0000u));
                v[2 * j + hq] = o; s += (o.x + o.y) + (o.z + o.w);
            }
        }
        const float mean = wave_sum(s) * (1.f / 1024.f); float s2 = 0.f;
#pragma unroll
        for (int k = 0; k < 4; ++k) { v[k] = v[k] - mean; s2 += (v[k].x * v[k].x + v[k].y * v[k].y) + (v[k].z * v[k].z + v[k].w * v[k].w); }
        const float rstd = rsqrtf(wave_sum(s2) * (1.f / 1024.f) + LN_EPS);
#pragma unroll
        for (int k = 0; k < 4; ++k) { const int e0 = 8 * (lane + 64 * (k >> 1)) + 4 * (k & 1); f32x4 o = v[k] * rstd * (*(const f32x4*)(gain + e0)) + (*(const f32x4*)(bias + e0)); if (poison) o = o * 3.0f; ST_NT2(row + (e0 >> 2), o); }
        e_cur = e_nxt; w_cur = w_nxt; e_nxt = e_n2; w_nxt = w_n2;
#pragma unroll
        for (int j = 0; j < 2; ++j) { xw[j] = xn[j]; ya[j] = yan[j]; yb[j] = ybn[j]; }
    }
#else
#define FIN_ROWS(t_, E_, XW_, YA_, YB_) do { const int tc_ = min((t_), T - 1); \
        const int g0_ = sg.start((int)E_.x) + (int)E_.y, g1_ = sg.start((int)E_.z) + (int)E_.w; \
        const u32x2* xr_ = (const u32x2*)(X1 + (size_t)tc_ * 1024) + lane; \
        const u32x2* y0_ = (const u32x2*)(Y + (size_t)g0_ * 1024) + lane; const u32x2* y1_ = (const u32x2*)(Y + (size_t)g1_ * 1024) + lane; \
        _Pragma("unroll") for (int j = 0; j < 4; ++j) { XW_[j] = LD_NT_FIN(xr_ + 64 * j); YA_[j] = LD_NT_FIN(y0_ + 64 * j); YB_[j] = LD_NT_FIN(y1_ + 64 * j); } } while (0)
    u32x4 e_cur, e_nxt; f32x2 w_cur, w_nxt;
    u32x2 xw[4], ya[4], yb[4];
    FIN_TE(tok0, e_cur, w_cur);
    FIN_TE(tok0 + step, e_nxt, w_nxt);
    FIN_ROWS(tok0, e_cur, xw, ya, yb);
#pragma unroll 1
    for (int tok = tok0; tok < T; tok += step) {
        u32x4 e_n2; f32x2 w_n2; FIN_TE(tok + 2 * step, e_n2, w_n2);
        u32x2 xn[4], yan[4], ybn[4]; FIN_ROWS(tok + step, e_nxt, xn, yan, ybn);
        const float w0 = w_cur[0], w1 = w_cur[1];
        f32x4* row = (f32x4*)(p.out + (size_t)tok * 1024) + lane;
        f32x4 v[4]; float s = 0.f;
#pragma unroll
        for (int j = 0; j < 4; ++j) {
            const unsigned a0 = ya[j].x, a1 = ya[j].y, b0 = yb[j].x, b1 = yb[j].y;
            const f32x4 xv = {__uint_as_float(xw[j].x << 16), __uint_as_float(xw[j].x & 0xffff0000u), __uint_as_float(xw[j].y << 16), __uint_as_float(xw[j].y & 0xffff0000u)};
            f32x4 mo;
            mo.x = w0 * __uint_as_float(a0 << 16) + w1 * __uint_as_float(b0 << 16);
            mo.y = w0 * __uint_as_float(a0 & 0xffff0000u) + w1 * __uint_as_float(b0 & 0xffff0000u);
            mo.z = w0 * __uint_as_float(a1 << 16) + w1 * __uint_as_float(b1 << 16);
            mo.w = w0 * __uint_as_float(a1 & 0xffff0000u) + w1 * __uint_as_float(b1 & 0xffff0000u);
            v[j] = xv * ALPHA + mo; s += (v[j].x + v[j].y) + (v[j].z + v[j].w);
        }
        const float mean = wave_sum(s) * (1.f / 1024.f); float s2 = 0.f;
#pragma unroll
        for (int j = 0; j < 4; ++j) { v[j] = v[j] - mean; s2 += (v[j].x * v[j].x + v[j].y * v[j].y) + (v[j].z * v[j].z + v[j].w * v[j].w); }
        const float rstd = rsqrtf(wave_sum(s2) * (1.f / 1024.f) + LN_EPS);
#pragma unroll
        for (int j = 0; j < 4; ++j) { const int e0 = (lane + 64 * j) * 4; f32x4 o = v[j] * rstd * (*(const f32x4*)(gain + e0)) + (*(const f32x4*)(bias + e0)); if (poison) o = o * 3.0f; ST_NT2(row + 64 * j, o); }
        e_cur = e_nxt; w_cur = w_nxt; e_nxt = e_n2; w_nxt = w_n2;
#pragma unroll
        for (int j = 0; j < 4; ++j) { xw[j] = xn[j]; ya[j] = yan[j]; yb[j] = ybn[j]; }
    }
#endif
#undef FIN_TE
#undef FIN_ROWS
}

constexpr int LDS_BYTES = 147456;
constexpr int MISC_OFF = LDS_BYTES - 64;
constexpr int CW_BAR = 4096;
constexpr size_t CTL_ZERO_BYTES = 65536;

#ifndef REP_PRO
#define REP_PRO 1
#endif
#ifndef REP_INP
#define REP_INP 1
#endif
#ifndef REP_IDX
#define REP_IDX 1
#endif
#ifndef REP_ATT
#define REP_ATT 1
#endif
#ifndef REP_MKV
#define REP_MKV 1
#endif
#ifndef REP_MSC
#define REP_MSC 1
#endif
#ifndef REP_MOU
#define REP_MOU 1
#endif
#ifndef REP_MRG
#define REP_MRG 1
#endif
#ifndef REP_OUT
#define REP_OUT 1
#endif
#ifndef REP_MOE
#define REP_MOE 1
#endif
#ifndef ATT_THRL
#define ATT_THRL 8
#endif
#ifndef REP_EXW
#define REP_EXW 1
#endif
#ifndef REP_GAT
#define REP_GAT 1
#endif
#ifndef MEGA_MINB
#define MEGA_MINB 2
#endif
__global__ void __launch_bounds__(512, MEGA_MINB) k_mega(Params p) {
    extern __shared__ __attribute__((aligned(16))) unsigned char lds_raw[];
    LAS unsigned char* lds = (LAS unsigned char*)lds_raw;
    const int tid = threadIdx.x;
    volatile LAS unsigned* MISC = (volatile LAS unsigned*)(lds + MISC_OFF);
    if (tid < 16) MISC[tid] = 0u;
    __syncthreads();
    XcdBarrier bar = xcd_barrier_post((unsigned*)(p.ws + WS_CTL) + CW_BAR, MISC + 8);
    for (int rep_ = 0; rep_ < REP_PRO; ++rep_) { phase_prologue(p, lds); __syncthreads(); }
    xcd_barrier(bar);
    for (int rep_ = 0; rep_ < REP_INP; ++rep_) phase_inproj(p, lds);
#ifdef REP_INP_DUMMY
    phase_inproj_dummy(p, lds);
#endif
    xcd_barrier(bar);
#if defined(STAGGER_W2) && defined(FAST_ATTN) && !defined(CHECK_MASK)
    {
        const bool kvfirst = (blockIdx.x & STAGGER_W2) != 0;
        if (kvfirst) { mlstm_kv_phase(p, lds); __syncthreads(); }
        phase_indexer(p, lds);
        __syncthreads();
        if (!kvfirst) mlstm_kv_phase(p, lds);
    }
#else
#if defined(CHECK_MASK) || defined(FAST_ATTN)
    for (int rep_ = 0; rep_ < REP_IDX; ++rep_) phase_indexer(p, lds);
#endif
#ifdef CHECK_MASK
    xcd_barrier(bar);
#endif
#ifndef FAST_ATTN
    { const int lane = tid & 63, wave = tid >> 6;
      if (wave < 4) attn_simple_body(p, (unsigned*)(lds_raw + wave * 32768), (float*)(lds_raw + 131072 + wave * 1024), blockIdx.x * 4 + wave, gridDim.x * 4, lane);
      __syncthreads(); }
#endif
    for (int rep_ = 0; rep_ < REP_MKV; ++rep_) mlstm_kv_phase(p, lds);
#endif
    xcd_barrier(bar);
#ifdef FAST_ATTN
    {
        const attn_body::AttnTensors AT{(const attn_body::bf16*)(p.ws + WS_AQ), (const attn_body::bf16*)(p.ws + WS_AK), (const attn_body::bf16*)(p.ws + WS_AV),
                                        (attn_body::bf16*)(p.ws + WS_YA), (const unsigned long long*)(p.ws + WS_MASK)};
        const attn_body::StaticOrder S((int)gridDim.x, (int)blockIdx.x);
        for (int rep_ = 0; rep_ < REP_ATT; ++rep_) attn_body::attn_phase<attn_body::StaticOrder, ATT_THRL>((char*)lds_raw, AT, S);
        __syncthreads();
    }
#endif
    for (int rep_ = 0; rep_ < REP_MSC; ++rep_) mlstm_scan(p);
    xcd_barrier(bar);
#ifdef CHECK_YA
    {
        const int lane = tid & 63, wave = tid >> 6;
        if (wave < 4) attn_simple_body(p, (unsigned*)(lds_raw + wave * 32768), (float*)(lds_raw + 131072 + wave * 1024), blockIdx.x * 4 + wave, gridDim.x * 4, lane);
        __syncthreads(); }
#endif
    for (int rep_ = 0; rep_ < REP_MOU; ++rep_) mlstm_out_phase(p, lds);
    xcd_barrier(bar);
#ifndef EXW_LATE
    for (int rep_ = 0; rep_ < REP_EXW; ++rep_) phase_expert_weights(p, lds);
    __syncthreads();
#endif
    for (int rep_ = 0; rep_ < REP_MRG; ++rep_) { phase_merge(p, lds); __syncthreads(); }
#if defined(EXW_LATE) && EXW_LATE == 1
    phase_expert_weights(p, lds);
    __syncthreads();
#endif
    xcd_barrier(bar);
    for (int rep_ = 0; rep_ < REP_OUT; ++rep_) phase_outproj(p, lds);
    xcd_barrier(bar);
    phase_ln1_route(p, lds);
#if defined(EXW_LATE) && EXW_LATE == 2
    __syncthreads();
    phase_expert_weights(p, lds);
    __syncthreads();
#endif
    xcd_barrier(bar);
#ifndef REP_MUP
#define REP_MUP REP_MOE
#endif
#ifndef REP_MDN
#define REP_MDN REP_MOE
#endif
    for (int rep_ = 0; rep_ < REP_MUP; ++rep_) phase_moe_up(p, lds);
    xcd_barrier(bar);
    for (int rep_ = 0; rep_ < REP_MDN; ++rep_) phase_moe_down(p, lds);
    xcd_barrier(bar);
#ifdef REP_BAR
    for (int rep_ = 0; rep_ < REP_BAR; ++rep_) xcd_barrier(bar);
#endif
    phase_final(p);
}

extern "C" void kernel_launch(void* const* d_in, const int* in_sizes, int n_in, void* d_out, int out_size, void* d_ws, size_t ws_size, hipStream_t stream) {
    static int grid = 0;
    if (grid == 0) {
        if (n_in != 19 || out_size != T * DM || ws_size < WS_END) { fprintf(stderr, "kernel_launch: unexpected shapes (n_in %d out %d ws %zu)\n", n_in, out_size, ws_size); grid = -1; return; }
        int dev = 0, cus = 0, per_cu = 0;
        if (hipGetDevice(&dev) != hipSuccess || hipDeviceGetAttribute(&cus, hipDeviceAttributeMultiprocessorCount, dev) != hipSuccess) { grid = -1; return; }
        if (hipFuncSetAttribute((const void*)k_mega, hipFuncAttributeMaxDynamicSharedMemorySize, LDS_BYTES) != hipSuccess) { fprintf(stderr, "kernel_launch: hipFuncSetAttribute failed\n"); grid = -1; return; }
        if (hipOccupancyMaxActiveBlocksPerMultiprocessor(&per_cu, (const void*)k_mega, 512, LDS_BYTES) != hipSuccess || per_cu < 1) fprintf(stderr, "kernel_launch: occupancy query says %d\n", per_cu);
        (void)hipGetLastError();
        grid = cus;
    }
    if (grid < 0) return;
    (void)hipMemsetAsync((char*)d_ws + WS_CTL, 0, CTL_ZERO_BYTES, stream);
    Params p{};
    for (int i = 0; i < 19; ++i) p.in[i] = (const float*)d_in[i];
    p.out = (float*)d_out; p.ws = (unsigned char*)d_ws;
    hipLaunchKernelGGL(k_mega, dim3(grid), dim3(512), LDS_BYTES, stream, p);
}
```
